# Optimizing an MI355X kernel written in HIP

```python
import math
import jax, jax.numpy as jnp
from jax import lax
import numpy as np

D_MODEL = 1024
BATCH = 4
SEQ = 4096
DEPTH = 1

CHUNK = 64
Q_BLOCK = 128
D_MIX = D_MODEL
RW_WIDTH = D_MIX // 2
RW_HEAD = 64
RW_HEADS = RW_WIDTH // RW_HEAD
RW_DECAY_RANK = 64
RW_A_RANK = 64
DA_WIDTH = D_MIX - RW_WIDTH
DA_HEADS = 4
DA_VDIM = DA_WIDTH // DA_HEADS
DA_QKDIM = DA_VDIM // 2
RW_SHIFTED = 3 * RW_WIDTH + RW_DECAY_RANK + RW_A_RANK
RW_COLS = RW_SHIFTED + RW_WIDTH
DA_COLS = 4 * DA_WIDTH
D_IN = RW_COLS + DA_COLS
RMS_EPS = 1e-6
GN_EPS = 64e-5
SUBLN_EPS = 1e-5

kernel_name = "hymba_rwkv7_diffattn_block"


def rms_norm(x, g, eps=RMS_EPS):
    xf = x.astype(jnp.float32)
    y = xf * lax.rsqrt(jnp.mean(xf * xf, axis=-1, keepdims=True) + eps)
    return (y * g.astype(jnp.float32)).astype(x.dtype)


def token_shift(u, mu):
    prev = jnp.pad(u, ((0, 0), (1, 0), (0, 0)))[:, :-1]
    return u + (prev - u) * mu


def rwkv7_branch(feat, gate, mu, w0, w_w2, a0, w_a2, k_k, k_a, r_k, lnx_w, lnx_b):
    B, S, _ = feat.shape
    H, N = RW_HEADS, RW_HEAD
    feat = token_shift(feat, mu).astype(jnp.float32)
    o1, o2, o3, o4 = RW_WIDTH, 2 * RW_WIDTH, 3 * RW_WIDTH, 3 * RW_WIDTH + RW_DECAY_RANK
    r, k, v = feat[..., :o1], feat[..., o1:o2], feat[..., o2:o3]
    w_lo, a_lo = feat[..., o3:o4], feat[..., o4:]
    w_log = -jax.nn.softplus(-(w0 + jnp.tanh(w_lo) @ w_w2)) - 0.5
    decay = jnp.exp(-jnp.exp(w_log))
    a = jax.nn.sigmoid(a0 + a_lo @ w_a2)
    kk = (k * k_k).reshape(B, S, H, N)
    kk = kk / jnp.maximum(jnp.linalg.norm(kk, axis=-1, keepdims=True), 1e-12)
    k = k * (1.0 + (a - 1.0) * k_a)
    hd = lambda t: t.reshape(B, S, H, N)
    r, k, v, decay, a = hd(r), hd(k), hd(v), hd(decay), hd(a)

    def step(state, inp):
        r_t, w_t, k_t, v_t, kk_t, a_t = inp
        s_kk = jnp.einsum('bhvk,bhk->bhv', state, kk_t)
        state = (state * w_t[:, :, None, :]
                 - s_kk[..., None] * (a_t * kk_t)[:, :, None, :]
                 + v_t[..., None] * k_t[:, :, None, :])
        return state, jnp.einsum('bhvk,bhk->bhv', state, r_t)

    tm = lambda t: jnp.swapaxes(t, 0, 1)
    s0 = jnp.zeros((B, H, N, N), jnp.float32)
    _, o = lax.scan(step, s0, (tm(r), tm(decay), tm(k), tm(v), tm(kk), tm(a)))
    o = tm(o)
    mean = jnp.mean(o, axis=-1, keepdims=True)
    var = jnp.mean(jnp.square(o - mean), axis=-1, keepdims=True)
    o = ((o - mean) * lax.rsqrt(var + GN_EPS)).reshape(B, S, RW_WIDTH) * lnx_w + lnx_b
    bonus = jnp.sum(r * k * r_k, axis=-1, keepdims=True) * v
    out = (o + bonus.reshape(B, S, RW_WIDTH)).astype(gate.dtype)
    return out * jax.nn.silu(gate)


def diff_attention_branch(q, k, v, gate, lam_q1, lam_k1, lam_q2, lam_k2, subln_w, lambda_init):
    B, S, _ = q.shape
    H, dqk, dv = DA_HEADS, DA_QKDIM, DA_VDIM
    q = q.reshape(B, S, H, 2, dqk)
    k = k.reshape(B, S, H, 2, dqk)
    v = v.reshape(B, S, H, dv)
    f32 = jnp.float32
    lam = (jnp.exp(jnp.sum(lam_q1.astype(f32) * lam_k1.astype(f32)))
           - jnp.exp(jnp.sum(lam_q2.astype(f32) * lam_k2.astype(f32))) + lambda_init)
    scale = 1.0 / math.sqrt(dqk)
    nb = S // Q_BLOCK
    qb = jnp.moveaxis(q.reshape(B, nb, Q_BLOCK, H, 2, dqk), 1, 0)
    k_chunk = jnp.arange(S) // CHUNK

    def block(args):
        q_blk, bi = args
        q_chunk = (bi * Q_BLOCK + jnp.arange(Q_BLOCK)) // CHUNK
        s = jnp.einsum('bqhcd,bkhcd->bhcqk', q_blk, k).astype(f32) * scale
        mask = q_chunk[:, None] >= k_chunk[None, :]
        p = jax.nn.softmax(jnp.where(mask, s, -jnp.inf), axis=-1)
        attn = p[:, :, 0] - lam * p[:, :, 1]
        return jnp.einsum('bhqk,bkhe->bqhe', attn.astype(v.dtype), v)

    o = lax.map(block, (qb, jnp.arange(nb)))
    o = jnp.moveaxis(o, 0, 1).reshape(B, S, H, dv)
    o = rms_norm(o, subln_w, SUBLN_EPS) * (1.0 - lambda_init)
    return o.reshape(B, S, DA_WIDTH) * jax.nn.silu(gate)


def setup_inputs(seed: int = 0) -> dict:
    key = jax.random.key(seed)
    ks = jax.random.split(key, 24)
    f32 = jnp.float32
    nrm = lambda k, shape, s: (jax.random.normal(k, shape, f32) * s)
    L = DEPTH
    return {
        "x": nrm(ks[0], (BATCH, SEQ, D_MODEL), 1.0),
        "c": nrm(ks[1], (BATCH, D_MODEL), 1.0),
        "w_ada": nrm(ks[2], (L, D_MODEL, 3 * D_MODEL), D_MODEL ** -0.5),
        "b_ada": nrm(ks[3], (L, 3 * D_MODEL), 0.02),
        "g_pre": 1.0 + nrm(ks[4], (L, D_MODEL), 0.02),
        "g_post": 1.0 + nrm(ks[5], (L, D_MODEL), 0.02),
        "w_in": nrm(ks[6], (L, D_MODEL, D_IN), D_MODEL ** -0.5),
        "w_out": nrm(ks[7], (L, D_MIX, D_MODEL), D_MIX ** -0.5),
        "rw_mu": jax.random.uniform(ks[8], (L, RW_SHIFTED), f32),
        "rw_w0": jax.random.uniform(ks[9], (L, RW_WIDTH), f32, -6.0, -1.0),
        "rw_w_w2": nrm(ks[10], (L, RW_DECAY_RANK, RW_WIDTH), 0.1 * RW_DECAY_RANK ** -0.5),
        "rw_a0": nrm(ks[11], (L, RW_WIDTH), 0.1),
        "rw_w_a2": nrm(ks[12], (L, RW_A_RANK, RW_WIDTH), 0.5 * RW_A_RANK ** -0.5),
        "rw_k_k": 0.85 + nrm(ks[13], (L, RW_WIDTH), 0.02),
        "rw_k_a": 1.0 + nrm(ks[14], (L, RW_WIDTH), 0.02),
        "rw_r_k": nrm(ks[15], (L, RW_HEADS, RW_HEAD), 0.1),
        "rw_lnx_w": 1.0 + nrm(ks[16], (L, RW_WIDTH), 0.02),
        "rw_lnx_b": nrm(ks[17], (L, RW_WIDTH), 0.02),
        "da_lam_q1": nrm(ks[18], (L, DA_QKDIM), 0.1),
        "da_lam_k1": nrm(ks[19], (L, DA_QKDIM), 0.1),
        "da_lam_q2": nrm(ks[20], (L, DA_QKDIM), 0.1),
        "da_lam_k2": nrm(ks[21], (L, DA_QKDIM), 0.1),
        "da_subln_w": 1.0 + nrm(ks[22], (L, DA_VDIM), 0.02),
    }


def reference(x, c, w_ada, b_ada, g_pre, g_post, w_in, w_out, rw_mu, rw_w0, rw_w_w2,
              rw_a0, rw_w_a2, rw_k_k, rw_k_a, rw_r_k, rw_lnx_w, rw_lnx_b,
              da_lam_q1, da_lam_k1, da_lam_q2, da_lam_k2, da_subln_w):
    for l in range(DEPTH):
        lambda_init = 0.8 - 0.6 * math.exp(-0.3 * l)
        mod = jax.nn.silu(c) @ w_ada[l] + b_ada[l]
        shift, scale, gate = jnp.split(mod, 3, axis=-1)
        h = rms_norm(x, g_pre[l]) * (1.0 + scale[:, None, :]) + shift[:, None, :]
        u = h @ w_in[l]
        rw_feat, rw_gate = u[..., :RW_SHIFTED], u[..., RW_SHIFTED:RW_COLS]
        d0 = RW_COLS
        dq = u[..., d0:d0 + DA_WIDTH]
        dk = u[..., d0 + DA_WIDTH:d0 + 2 * DA_WIDTH]
        dv = u[..., d0 + 2 * DA_WIDTH:d0 + 3 * DA_WIDTH]
        dg = u[..., d0 + 3 * DA_WIDTH:]
        y_rw = rwkv7_branch(rw_feat, rw_gate, rw_mu[l], rw_w0[l], rw_w_w2[l], rw_a0[l],
                            rw_w_a2[l], rw_k_k[l], rw_k_a[l], rw_r_k[l], rw_lnx_w[l], rw_lnx_b[l])
        y_da = diff_attention_branch(dq, dk, dv, dg, da_lam_q1[l], da_lam_k1[l], da_lam_q2[l],
                                     da_lam_k2[l], da_subln_w[l], lambda_init)
        y = jnp.concatenate([y_rw.astype(x.dtype), y_da.astype(x.dtype)], axis=-1) @ w_out[l]
        y = rms_norm(y, g_post[l])
        x = x + gate[:, None, :] * y
    return x
```

```cpp
#include <hip/hip_runtime.h>
#include <cstdio>
#include <cstdint>
namespace pg8 {
#define PG8_LAS __attribute__((address_space(3)))
typedef unsigned short bf16_t;
typedef short bf16x8 __attribute__((ext_vector_type(8)));
typedef float f32x4 __attribute__((ext_vector_type(4)));
typedef unsigned u32x4 __attribute__((ext_vector_type(4)));
constexpr int BM = 256, BK = 64, HALF = 128, HTB = HALF * BK * 2  , STAGE_BYTES = 8 * HTB, NXCD = 8, WGM = 8;

__host__ __device__ __forceinline__ int lds_byte(int r, int c) { const int st = (r >> 4) * 2 + (c >> 5), rr = r & 15, cc = c & 31, ob = rr * 64 + cc * 2; return st * 1024 + (ob ^ (((ob >> 9) & 1) << 5)); }
__host__ __device__ __forceinline__ void stage_rc(int b, int& R, int& C) { const int st = b / 1024, sb = b % 1024, swz = sb ^ (((sb >> 9) & 1) << 5); R = (st >> 1) * 16 + swz / 64; C = (st & 1) * 32 + (swz % 64) / 2; }
__host__ __device__ __forceinline__ int perm32(int rho) { const int n = rho >> 4, i = rho & 15; return 8 * (i >> 2) + 4 * n + (i & 3); }

struct Unit { int pm, pn; };
struct Gemm { const bf16_t* A; const bf16_t* Bt; int M, N, K; };

struct StaticOrder {
    int nM, nN, nwg, G, c;
    __host__ __device__ void init(int M, int N, int G_, int c_) { nM = M / BM; nN = N / BM; nwg = nM * nN; G = G_; c = c_; }
    __host__ __device__ bool next(int i, Unit& u) const {
        const long L = (long)i * G + c; if (L >= nwg) return false;
        int wgid = (int)L; { const int q = nwg / NXCD, r = nwg % NXCD, xcd = wgid % NXCD, off = wgid / NXCD; wgid = (xcd < r ? xcd * (q + 1) : r * (q + 1) + (xcd - r) * q) + off; }
        const int nig = WGM * nN, gid = wgid / nig, fm = gid * WGM, gsz = (nM - fm) < WGM ? (nM - fm) : WGM;
        u.pm = fm + ((wgid % nig) % gsz); u.pn = (wgid % nig) / gsz; return true;
    }
    __device__ __forceinline__ void a_ready(const Unit&) const {}
    __device__ __forceinline__ void done(const Unit&) const {}
};

__device__ __forceinline__ unsigned cvt_pk_bf16(float lo, float hi) { unsigned r; asm volatile("v_cvt_pk_bf16_f32 %0, %1, %2" : "=v"(r) : "v"(lo), "v"(hi)); return r; }
typedef float f32x2 __attribute__((ext_vector_type(2)));
struct EpiU {
    static constexpr bool PERM = true, AFTER_DRAIN = false;
    bf16_t* Urk; bf16_t* Uvg; bf16_t* Uqg; bf16_t* Kimg; bf16_t* Vimg; float qscale; int seq;
    __device__ __forceinline__ void operator()(const f32x4 (&acc)[2][2][4][2], const Unit& u, int wr, int wc, int fr, int fq) const {
        const int row0 = u.pm * BM + wr * 64 + fr;
        const float sc = (u.pn == 8 || u.pn == 9) ? qscale : 1.f;
        const bool img = (u.pn >= 10 && u.pn <= 13);
        bf16_t* base = (u.pn < 4) ? (Urk + u.pn * BM) : (u.pn < 8 ? (Uvg + (u.pn - 4) * BM) : (u.pn < 10 ? (Uqg + (u.pn - 8) * BM) : (Uqg + 512 + (u.pn - 14) * BM)));
        const int col0 = wc * 32 + 8 * fq;
#pragma unroll
        for (int ai = 0; ai < 2; ++ai)
#pragma unroll
            for (int m = 0; m < 4; ++m) { const int r = row0 + ai * HALF + m * 16; bf16_t* rowp = base + (size_t)r * 1024 + col0;
                const int bb = r / seq, t = r % seq;
#pragma unroll
                for (int bj = 0; bj < 2; ++bj) { f32x4 v0 = acc[ai][bj][m][0] * sc, v1 = acc[ai][bj][m][1] * sc;
                    u32x4 w; w.x = cvt_pk_bf16(v0[0], v0[1]); w.y = cvt_pk_bf16(v0[2], v0[3]); w.z = cvt_pk_bf16(v1[0], v1[1]); w.w = cvt_pk_bf16(v1[2], v1[3]);
                    if (!img) *(u32x4*)(rowp + bj * HALF) = w;
                    else if (u.pn < 12) { const int hh = 4 * (u.pn - 10) + 2 * bj + (wc >> 1), dch = 4 * (wc & 1) + fq;
                        *(u32x4*)((char*)Kimg + ((size_t)((bb * 8 + hh) * (seq / 64) + (t >> 6)) * 8192 + dch * 1024 + (t & 63) * 16)) = w; }
                    else { const int h = 2 * (u.pn - 12) + bj;
                        *(u32x4*)((char*)Vimg + ((size_t)((bb * 4 + h) * (seq / 64) + (t >> 6)) * 16384 + (wc * 4 + ((t & 63) >> 4)) * 1024 + ((t & 15) * 4 + fq) * 16)) = w; } } }
    }
};

struct PanelStats {
    unsigned* xbuf;
    unsigned* cnt;
    unsigned* tmo;
    int ntn; float eps;
    bool rms;
    unsigned code;
    __device__ __forceinline__ bool run(const f32x4 (&v)[2][2][4][2], const Unit& u, int wr, int wc, int fr, int fq, PG8_LAS unsigned char* lds, int wid, int lane) const {
        typedef float f32x2v __attribute__((ext_vector_type(2)));
        PG8_LAS f32x2v* P = (PG8_LAS f32x2v*)lds;
        PG8_LAS f32x2v* S = (PG8_LAS f32x2v*)(lds + 8192);
        PG8_LAS unsigned* flag = (PG8_LAS unsigned*)(lds + 8192 + 2048);
#pragma unroll
        for (int ai = 0; ai < 2; ++ai)
#pragma unroll
            for (int m = 0; m < 4; ++m) {
                float s = 0.f;
#pragma unroll
                for (int bj = 0; bj < 2; ++bj)
#pragma unroll
                    for (int n = 0; n < 2; ++n) { const f32x4 x = v[ai][bj][m][n]; s += (x[0] + x[1]) + (x[2] + x[3]); }
                s += __shfl_xor(s, 16); s += __shfl_xor(s, 32);
                const float mw = s * (1.0f / 64.0f); float q = 0.f;
#pragma unroll
                for (int bj = 0; bj < 2; ++bj)
#pragma unroll
                    for (int n = 0; n < 2; ++n) { const f32x4 d = v[ai][bj][m][n] - mw; q += (d[0] * d[0] + d[1] * d[1]) + (d[2] * d[2] + d[3] * d[3]); }
                q += __shfl_xor(q, 16); q += __shfl_xor(q, 32);
                if (fq == 0) P[(ai * HALF + wr * 64 + m * 16 + fr) * 4 + wc] = (f32x2v){mw, q};
            }
        asm volatile("s_waitcnt lgkmcnt(0)" ::: "memory"); __builtin_amdgcn_s_barrier(); asm volatile("" ::: "memory");
#if defined(BROKEN_EXCHANGE_NO_WAIT)
#warning BROKEN CONTROL BUILD: the row-statistics exchange does not wait; results are wrong by design
        if (blockIdx.x >= 64) { const long long t0_ = clock64(); while (clock64() - t0_ < 60000) __builtin_amdgcn_s_sleep(8); }
#endif
        const int row = wid * 32 + (lane & 31);
        if (lane < 32) {
            const f32x2v a = P[row * 4 + 0], b = P[row * 4 + 1], c = P[row * 4 + 2], d = P[row * 4 + 3];
            const float mt = (a.x + b.x + c.x + d.x) * 0.25f;
            const float da = a.x - mt, db = b.x - mt, dc = c.x - mt, dd = d.x - mt;
            const float m2 = (a.y + b.y) + (c.y + d.y) + 64.0f * ((da * da + db * db) + (dc * dc + dd * dd));
            unsigned long long* slot = (unsigned long long*)xbuf + ((size_t)(u.pm * BM + row) * 4 + u.pn);
            __hip_atomic_store(slot, ((unsigned long long)__float_as_uint(m2) << 32) | __float_as_uint(mt), __ATOMIC_RELAXED, __HIP_MEMORY_SCOPE_AGENT);
        }
        asm volatile("s_waitcnt vmcnt(0)" ::: "memory");
        if (lane == 0) __hip_atomic_fetch_add(cnt + 64 * u.pm, 1u, __ATOMIC_RELAXED, __HIP_MEMORY_SCOPE_AGENT);
        if (wid == 0) {
            bool dead = false; const unsigned long long t0 = __builtin_amdgcn_s_memrealtime(); const unsigned want = 8u * (unsigned)ntn;
            for (;;) {
#if defined(BROKEN_EXCHANGE_NO_WAIT)
                break;
#endif
                if ((unsigned)__builtin_amdgcn_readfirstlane(__hip_atomic_load(cnt + 64 * u.pm, __ATOMIC_RELAXED, __HIP_MEMORY_SCOPE_AGENT)) >= want) break;
                if (__builtin_amdgcn_s_memrealtime() - t0 > 2000000ull) {
                    if (lane == 0) { unsigned expect = 0u; __hip_atomic_compare_exchange_strong(tmo + 1, &expect, code | (unsigned)(u.pm & 0xff), __ATOMIC_RELAXED, __ATOMIC_RELAXED, __HIP_MEMORY_SCOPE_AGENT);
                                     __hip_atomic_store(tmo, 1u, __ATOMIC_RELAXED, __HIP_MEMORY_SCOPE_AGENT); }
                    dead = true; break; }
                __builtin_amdgcn_s_sleep(2);
            }
            __builtin_amdgcn_fence(__ATOMIC_ACQUIRE, "agent");
            if (lane == 0) flag[0] = dead ? 1u : 0u;
        }
        asm volatile("s_waitcnt vmcnt(0) lgkmcnt(0)" ::: "memory"); __builtin_amdgcn_s_barrier(); asm volatile("" ::: "memory");
        const bool bad = flag[0] != 0u;
        if (lane < 32) {
            const unsigned long long* slot = (const unsigned long long*)xbuf + (size_t)(u.pm * BM + row) * 4; float mt[4], m2[4]; float ms = 0.f;
#pragma unroll
            for (int t = 0; t < 4; ++t) { if (t < ntn) { const unsigned long long w = __hip_atomic_load(slot + t, __ATOMIC_RELAXED, __HIP_MEMORY_SCOPE_AGENT); mt[t] = __uint_as_float((unsigned)w); m2[t] = __uint_as_float((unsigned)(w >> 32)); } else { mt[t] = 0.f; m2[t] = 0.f; } ms += mt[t]; }
            const float mean = ms / (float)ntn; float q = 0.f;
#pragma unroll
            for (int t = 0; t < 4; ++t) if (t < ntn) { const float dm = mt[t] - mean; q += m2[t] + 256.0f * dm * dm; }
            S[row] = (f32x2v){mean, 1.0f / sqrtf(q / (256.0f * (float)ntn) + (rms ? mean * mean : 0.f) + eps)};
        }
        asm volatile("s_waitcnt lgkmcnt(0)" ::: "memory"); __builtin_amdgcn_s_barrier(); asm volatile("" ::: "memory");
        return bad;
    }
};
struct EpiRmsRes {
    static constexpr bool PERM = false, AFTER_DRAIN = true;
    const float* base; float* out; int ldc; const float* gate; int gate_pitch; int rows_per_batch; const float* gpost; PanelStats st; unsigned poison;
    __device__ __forceinline__ void fused(f32x4 (&acc)[2][2][4][2], const Unit& u, int wr, int wc, int fr, int fq, PG8_LAS unsigned char* lds, int wid, int lane) const {
        typedef float f32x2v __attribute__((ext_vector_type(2)));
        const PG8_LAS f32x2v* S = (const PG8_LAS f32x2v*)(lds + 8192);
        const int col0 = u.pn * BM + wc * 32 + 4 * fq;
        const float* grow = gate + (size_t)((u.pm * BM) / rows_per_batch) * gate_pitch;
        f32x4 cf[2][2];
#pragma unroll
        for (int bj = 0; bj < 2; ++bj)
#pragma unroll
            for (int n = 0; n < 2; ++n) cf[bj][n] = *(const f32x4*)(grow + col0 + bj * HALF + n * 16) * *(const f32x4*)(gpost + col0 + bj * HALF + n * 16);
        f32x4 pre[2][2][2];
#pragma unroll
        for (int m = 0; m < 2; ++m) { const size_t off = (size_t)(u.pm * BM + wr * 64 + m * 16 + fr) * ldc + col0;
#pragma unroll
            for (int bj = 0; bj < 2; ++bj)
#pragma unroll
                for (int n = 0; n < 2; ++n) pre[m][bj][n] = *(const f32x4*)(base + off + bj * HALF + n * 16); }
        const bool bad = st.run(acc, u, wr, wc, fr, fq, lds, wid, lane) || poison != 0u;
        const float qnan = __builtin_nanf("");
#pragma unroll
        for (int ai = 0; ai < 2; ++ai)
#pragma unroll
            for (int m = 0; m < 4; ++m) { const int r = ai * HALF + wr * 64 + m * 16 + fr; const f32x2v sr = S[r]; const size_t off = (size_t)(u.pm * BM + r) * ldc + col0;
#pragma unroll
                for (int bj = 0; bj < 2; ++bj)
#pragma unroll
                    for (int n = 0; n < 2; ++n) { const f32x4 bs = (ai == 0 && m < 2) ? pre[m & 1][bj][n] : *(const f32x4*)(base + off + bj * HALF + n * 16); f32x4 o = bs + acc[ai][bj][m][n] * sr.y * cf[bj][n];
                        if (bad) o = (f32x4){qnan, qnan, qnan, qnan}; *(f32x4*)(out + off + bj * HALF + n * 16) = o; }
                if (m & 1) asm volatile("" ::: "memory"); }
    }
};

template <class Epi, class Sched, bool ALIGN_EPI = false, bool SP2 = false>
__device__ __forceinline__ void gemm_phase(PG8_LAS unsigned char* lds, const Gemm g, const Sched& S, const Epi& E) {
    const int tid = threadIdx.x, wid = __builtin_amdgcn_readfirstlane(tid >> 6), lane = tid & 63, wr = wid >> 2, wc = wid & 3, fr = lane & 15, fq = lane >> 4;
    const int K = g.K, nt = K / BK;
    unsigned voffA[2], voffB[2];
#pragma unroll
    for (int i = 0; i < 2; ++i) { int R, C; stage_rc(tid * 16 + i * 8192, R, C); const int Rb = Epi::PERM ? ((R & ~31) + perm32(R & 31)) : R;
        voffA[i] = (unsigned)(R * K + C) * 2u; voffB[i] = (unsigned)(Rb * K + C) * 2u; }
    const size_t kstep = (size_t)(BK * 2);
    const size_t hstep = (size_t)HALF * K * 2;
    const size_t tstep = 2 * hstep;
    const unsigned ldsw = (unsigned)wid * 1024u;
    const int aoff = lds_byte(wr * 64 + fr, fq * 8), boff = lds_byte(wc * 32 + fr, fq * 8);
#define PG8_SA(b, h) (((b) * 2 + (h)) * HTB)
#define PG8_SB(b, h) ((4 + (b) * 2 + (h)) * HTB)
#define PG8_STAGE(bufoff, gbase, voff) do { _Pragma("unroll") for (int _i = 0; _i < 2; ++_i) \
        __builtin_amdgcn_global_load_lds((const unsigned*)((const char*)(gbase) + (voff)[_i]), (PG8_LAS unsigned*)(lds + (bufoff) + ldsw + _i * 8192), 16, 0, 0); } while (0)
#define PG8_LDA(dst, b, h) do { _Pragma("unroll") for (int m = 0; m < 4; ++m) _Pragma("unroll") for (int k = 0; k < 2; ++k) dst[m][k] = *(const PG8_LAS bf16x8*)(lds + PG8_SA(b, h) + aoff + m * 2048 + k * 1024); } while (0)
#define PG8_LDB(dst, b, h) do { _Pragma("unroll") for (int n = 0; n < 2; ++n) _Pragma("unroll") for (int k = 0; k < 2; ++k) dst[n][k] = *(const PG8_LAS bf16x8*)(lds + PG8_SB(b, h) + boff + n * 2048 + k * 1024); } while (0)
#define PG8_MMA(ai, bj, At, Bt) do { __builtin_amdgcn_s_setprio(1); _Pragma("unroll") for (int m = 0; m < 4; ++m) _Pragma("unroll") for (int n = 0; n < 2; ++n) _Pragma("unroll") for (int k = 0; k < 2; ++k) \
        acc[ai][bj][m][n] = __builtin_amdgcn_mfma_f32_16x16x32_bf16(Bt[n][k], At[m][k], acc[ai][bj][m][n], 0, 0, 0); __builtin_amdgcn_s_setprio(0); } while (0)
#define PG8_WAIT_V(n) asm volatile("s_waitcnt vmcnt(" #n ")" ::: "memory")
#define PG8_WAIT_L(n) asm volatile("s_waitcnt lgkmcnt(" #n ")" ::: "memory")
#define PG8_BAR __builtin_amdgcn_s_barrier()
#define PG8_SCHED __builtin_amdgcn_sched_barrier(0)
    Unit cur, nxt; int ui = 0;
    if (!S.next(0, cur)) return;
    f32x4 acc[2][2][4][2];
#pragma unroll
    for (int a = 0; a < 2; ++a)
#pragma unroll
        for (int b = 0; b < 2; ++b)
#pragma unroll
            for (int m = 0; m < 4; ++m)
#pragma unroll
                for (int n = 0; n < 2; ++n) acc[a][b][m][n] = (f32x4){0.f, 0.f, 0.f, 0.f};
    bf16x8 At[4][2], B0[2][2], B1[2][2];
    const char* cA = (const char*)g.A + (size_t)cur.pm * tstep; const char* cB = (const char*)g.Bt + (size_t)cur.pn * tstep;
    S.a_ready(cur);
    if constexpr (SP2) {
        PG8_STAGE(PG8_SB(0, 0), cB, voffB); PG8_STAGE(PG8_SB(0, 1), cB + hstep, voffB); PG8_STAGE(PG8_SA(0, 0), cA, voffA); PG8_STAGE(PG8_SA(0, 1), cA + hstep, voffA);
        if (wr == 1) PG8_BAR;
        PG8_WAIT_V(2); PG8_BAR;
        PG8_STAGE(PG8_SB(1, 0), cB + kstep, voffB); PG8_STAGE(PG8_SA(1, 0), cA + kstep, voffA); PG8_STAGE(PG8_SB(1, 1), cB + hstep + kstep, voffB);
        PG8_WAIT_V(6); PG8_BAR;
    } else {
        PG8_STAGE(PG8_SB(0, 0), cB, voffB); PG8_STAGE(PG8_SA(0, 0), cA, voffA); PG8_STAGE(PG8_SB(0, 1), cB + hstep, voffB); PG8_STAGE(PG8_SA(0, 1), cA + hstep, voffA);
        if (wr == 1) PG8_BAR;
        PG8_WAIT_V(4); PG8_BAR;
        PG8_STAGE(PG8_SB(1, 0), cB + kstep, voffB); PG8_STAGE(PG8_SA(1, 0), cA + kstep, voffA); PG8_STAGE(PG8_SB(1, 1), cB + hstep + kstep, voffB);
        PG8_WAIT_V(6); PG8_BAR;
    }
    for (;;) {
        const bool has_next = S.next(ui + 1, nxt);
        const char* nA = has_next ? (const char*)g.A + (size_t)nxt.pm * tstep : cA; const char* nB = has_next ? (const char*)g.Bt + (size_t)nxt.pn * tstep : cB;
        for (int t = 0; t < nt; t += 2) {
            const bool last = (t == nt - 2);
            const char* a1 = cA + (size_t)(t + 1) * kstep;
            const char* a2 = last ? nA : cA + (size_t)(t + 2) * kstep; const char* b2 = last ? nB : cB + (size_t)(t + 2) * kstep;
            const char* a3 = a2 + kstep; const char* b3 = b2 + kstep;
            if (last && has_next) S.a_ready(nxt);
            if constexpr (SP2) {
            PG8_LDB(B0, 0, 0); PG8_LDB(B1, 0, 1); PG8_SCHED; PG8_LDA(At, 0, 0); PG8_STAGE(PG8_SA(1, 1), a1 + hstep, voffA);
            PG8_WAIT_V(8); PG8_WAIT_L(0); PG8_BAR; PG8_MMA(0, 0, At, B0); PG8_MMA(0, 1, At, B1); PG8_BAR; PG8_SCHED;
            PG8_LDA(At, 0, 1); PG8_STAGE(PG8_SB(0, 0), b2, voffB); PG8_STAGE(PG8_SB(0, 1), b2 + hstep, voffB); PG8_STAGE(PG8_SA(0, 0), a2, voffA);
            PG8_WAIT_V(8); PG8_WAIT_L(0); PG8_BAR; PG8_MMA(1, 0, At, B0); PG8_MMA(1, 1, At, B1); PG8_BAR; PG8_SCHED;
            PG8_LDB(B0, 1, 0); PG8_LDB(B1, 1, 1); PG8_SCHED; PG8_LDA(At, 1, 0); PG8_STAGE(PG8_SA(0, 1), a2 + hstep, voffA);
            PG8_WAIT_V(8); PG8_WAIT_L(0); PG8_BAR; PG8_MMA(0, 0, At, B0); PG8_MMA(0, 1, At, B1); PG8_BAR; PG8_SCHED;
            PG8_LDA(At, 1, 1); PG8_STAGE(PG8_SB(1, 0), b3, voffB); PG8_STAGE(PG8_SB(1, 1), b3 + hstep, voffB); PG8_STAGE(PG8_SA(1, 0), a3, voffA);
            PG8_WAIT_V(8); PG8_WAIT_L(0); PG8_BAR; PG8_MMA(1, 0, At, B0); PG8_MMA(1, 1, At, B1); PG8_BAR; PG8_SCHED;
            } else {
            PG8_LDB(B0, 0, 0); PG8_SCHED; PG8_LDA(At, 0, 0); PG8_STAGE(PG8_SA(1, 1), a1 + hstep, voffA);
            PG8_WAIT_L(8); PG8_BAR; PG8_WAIT_L(0); PG8_MMA(0, 0, At, B0); PG8_BAR; PG8_SCHED;
            PG8_LDB(B1, 0, 1); PG8_STAGE(PG8_SB(0, 0), b2, voffB);
            PG8_BAR; PG8_WAIT_L(0); PG8_MMA(0, 1, At, B1); PG8_BAR;
            PG8_LDA(At, 0, 1); PG8_STAGE(PG8_SA(0, 0), a2, voffA);
            PG8_BAR; PG8_WAIT_L(0); PG8_MMA(1, 0, At, B0); PG8_BAR; PG8_SCHED;
            PG8_STAGE(PG8_SB(0, 1), b2 + hstep, voffB);
            PG8_WAIT_V(6); PG8_BAR; PG8_MMA(1, 1, At, B1); PG8_BAR;
            PG8_LDB(B0, 1, 0); PG8_SCHED; PG8_LDA(At, 1, 0); PG8_STAGE(PG8_SA(0, 1), a2 + hstep, voffA);
            PG8_WAIT_L(8); PG8_BAR; PG8_WAIT_L(0); PG8_MMA(0, 0, At, B0); PG8_BAR; PG8_SCHED;
            PG8_LDB(B1, 1, 1); PG8_STAGE(PG8_SB(1, 0), b3, voffB);
            PG8_BAR; PG8_WAIT_L(0); PG8_MMA(0, 1, At, B1); PG8_BAR;
            PG8_LDA(At, 1, 1); PG8_STAGE(PG8_SA(1, 0), a3, voffA);
            PG8_BAR; PG8_WAIT_L(0); PG8_MMA(1, 0, At, B0); PG8_BAR; PG8_SCHED;
            PG8_STAGE(PG8_SB(1, 1), b3 + hstep, voffB);
            PG8_WAIT_V(6); PG8_BAR; PG8_MMA(1, 1, At, B1); PG8_BAR;
            }
        }
        if constexpr (ALIGN_EPI) { if (wr == 0) PG8_BAR; }
        if constexpr (!Epi::AFTER_DRAIN) { E(acc, cur, wr, wc, fr, fq); S.done(cur); }
        if (!has_next) break;
#pragma unroll
        for (int a = 0; a < 2; ++a)
#pragma unroll
            for (int b = 0; b < 2; ++b)
#pragma unroll
                for (int m = 0; m < 4; ++m)
#pragma unroll
                    for (int n = 0; n < 2; ++n) acc[a][b][m][n] = (f32x4){0.f, 0.f, 0.f, 0.f};
        cur = nxt; cA = nA; cB = nB; ++ui;
        if constexpr (ALIGN_EPI) { if (wr == 1) PG8_BAR; }
    }
    PG8_WAIT_V(0);
    if constexpr (!ALIGN_EPI) { if (wr == 0) PG8_BAR; }
    PG8_BAR;
    if constexpr (Epi::AFTER_DRAIN) { E.fused(acc, cur, wr, wc, fr, fq, lds, wid, lane); S.done(cur); }
#undef PG8_SA
#undef PG8_SB
#undef PG8_STAGE
#undef PG8_LDA
#undef PG8_LDB
#undef PG8_MMA
#undef PG8_WAIT_V
#undef PG8_WAIT_L
#undef PG8_BAR
#undef PG8_SCHED
}
}

#ifndef PG8_SP2
#define PG8_SP2 true
#endif
#ifndef PG8_ALIGN
#define PG8_ALIGN true
#endif
#include <hip/hip_bf16.h>
#include <cmath>
namespace attn_body {
using bf16=__hip_bfloat16;
using bf16x8=__attribute__((ext_vector_type(8)))short;
using s16x4=__attribute__((ext_vector_type(4)))short;
using f32x16=__attribute__((ext_vector_type(16)))float;
using u32x4=__attribute__((ext_vector_type(4)))unsigned;
constexpr int SEQ=4096,D=64,PQ=1024,PO=1024;
constexpr int KT=4096,VT=8192;
constexpr int NW=8,QBLK=32,QB=QBLK*NW,KVBLK=64,NQB=SEQ/QB;
constexpr int ATTN_UNIT_ROWS=QB;
__device__ __forceinline__ int crow(int r,int hi){return (r&3)+8*(r>>2)+4*hi;}
#define SBAR() __builtin_amdgcn_sched_barrier(0)
__device__ __forceinline__ void cmask(f32x16&p0,f32x16&p1,int jb,int qrel,int hi){
  const float NEG=-INFINITY;
  if(jb>(qrel>>6)){
  #pragma unroll
  for(int r=0;r<16;++r){p0[r]=NEG;p1[r]=NEG;}}
}

constexpr int NSLOT=3, SLOTB=8192;
constexpr int LDS_K=0, LDS_V=NSLOT*SLOTB, LDS_WS=LDS_V+NSLOT*2*SLOTB, LDS_OST=LDS_WS+NW*64*4, LDS_BYTES=LDS_OST+NW*4096;
constexpr float C2=0.125f*1.4426950408889634f;
__device__ __forceinline__ void glds16(const void*gsrc,unsigned lds_dst){unsigned keep;
  asm volatile("s_mov_b32 %0, m0\n\ts_mov_b32 m0, %2\n\ts_nop 0\n\tglobal_load_lds_dwordx4 %1, off\n\ts_mov_b32 m0, %0":"=&s"(keep):"v"(gsrc),"s"(lds_dst):"memory");}
__device__ __forceinline__ void glds16s(const void*sbase,unsigned voff,unsigned lds_dst){unsigned keep;
  asm volatile("s_mov_b32 %0, m0\n\ts_mov_b32 m0, %3\n\ts_nop 0\n\tglobal_load_lds_dwordx4 %1, %2\n\ts_mov_b32 m0, %0":"=&s"(keep):"v"(voff),"s"(sbase),"s"(lds_dst):"memory");}
__device__ __forceinline__ float max3f(float a,float b,float c){float r;asm("v_max3_f32 %0, %1, %2, %3":"=v"(r):"v"(a),"v"(b),"v"(c));return r;}
__device__ __forceinline__ float max2f(float a,float b){float r;asm("v_max_f32_e32 %0, %1, %2":"=v"(r):"v"(a),"v"(b));return r;}
__device__ __forceinline__ float fadd_s(float a,float b){float r;asm("v_add_f32_e32 %0, %1, %2":"=v"(r):"v"(a),"v"(b));return r;}
__device__ __forceinline__ float fsub_s(float a,float b){float r;asm("v_sub_f32_e32 %0, %1, %2":"=v"(r):"v"(a),"v"(b));return r;}
typedef float f32x2_t __attribute__((ext_vector_type(2))); typedef __bf16 bf16x2_t __attribute__((ext_vector_type(2)));
__device__ __forceinline__ unsigned cvtpk_s(float lo,float hi){f32x2_t v={lo,hi};bf16x2_t b=__builtin_convertvector(v,bf16x2_t);return __builtin_bit_cast(unsigned,b);}
#define WAIT_BAR(N) asm volatile("s_waitcnt vmcnt(" #N ") lgkmcnt(0)\n\ts_barrier":::"memory")

__device__ __forceinline__ void qkt(f32x16&p0,f32x16&p1,const char*Kslot,const bf16x8*qr,const f32x16&negm,int r32,int hi){
  const char*kb=Kslot+hi*1024+r32*16;
  #pragma unroll
  for(int d0=0;d0<4;++d0){
    const bf16x8 b0=*reinterpret_cast<const bf16x8*>(kb+d0*2048);
    const bf16x8 b1=*reinterpret_cast<const bf16x8*>(kb+d0*2048+512);
    if(d0==0){p0=__builtin_amdgcn_mfma_f32_32x32x16_bf16(b0,qr[0],negm,0,0,0);p1=__builtin_amdgcn_mfma_f32_32x32x16_bf16(b1,qr[0],negm,0,0,0);}
    else{p0=__builtin_amdgcn_mfma_f32_32x32x16_bf16(b0,qr[d0],p0,0,0,0);p1=__builtin_amdgcn_mfma_f32_32x32x16_bf16(b1,qr[d0],p1,0,0,0);}}
}
typedef __attribute__((address_space(3))) const char* lds_cptr;
typedef short v4i16_t __attribute__((ext_vector_type(4)));
__device__ __forceinline__ void kload8(bf16x8*kf,lds_cptr kp){
  kf[0]=*(const __attribute__((address_space(3))) bf16x8*)(kp);      kf[1]=*(const __attribute__((address_space(3))) bf16x8*)(kp+512);
  kf[2]=*(const __attribute__((address_space(3))) bf16x8*)(kp+2048); kf[3]=*(const __attribute__((address_space(3))) bf16x8*)(kp+2560);
  kf[4]=*(const __attribute__((address_space(3))) bf16x8*)(kp+4096); kf[5]=*(const __attribute__((address_space(3))) bf16x8*)(kp+4608);
  kf[6]=*(const __attribute__((address_space(3))) bf16x8*)(kp+6144); kf[7]=*(const __attribute__((address_space(3))) bf16x8*)(kp+6656);
}
__device__ __forceinline__ void kload2(bf16x8*kf,lds_cptr kp,int j){ kf[2*j]=*(const __attribute__((address_space(3))) bf16x8*)(kp+j*2048); kf[2*j+1]=*(const __attribute__((address_space(3))) bf16x8*)(kp+j*2048+512); }
__device__ __forceinline__ s16x4 vtr(lds_cptr p){ return __builtin_bit_cast(s16x4,__builtin_amdgcn_ds_read_tr16_b64_v4i16((__attribute__((address_space(3))) v4i16_t*)p)); }
__device__ __forceinline__ float rowmax(const f32x16&p0,const f32x16&p1){
  float a=max3f(p0[0],p0[1],p1[0]),b=max3f(p0[2],p0[3],p1[1]);a=max3f(a,p1[2],p1[3]);
  #pragma unroll
  for(int r=4;r<16;r+=4){a=max3f(a,p0[r],p0[r+1]);b=max3f(b,p0[r+2],p0[r+3]);a=max3f(a,p1[r],p1[r+1]);b=max3f(b,p1[r+2],p1[r+3]);}
  const float m=max2f(a,b);
  auto rr=__builtin_amdgcn_permlane32_swap(__float_as_uint(m),__float_as_uint(m),false,false);
  return max2f(__uint_as_float(rr[0]),__uint_as_float(rr[1]));
}
__device__ __forceinline__ void pv(f32x16*o,int vb,bf16x8 pa0,bf16x8 pa1,bf16x8 pa2,bf16x8 pa3){
  #pragma unroll
  for(int d0=0;d0<4;++d0){s16x4 lo[4],hi[4];
    #pragma unroll
    for(int ks=0;ks<4;++ks){
      asm volatile("ds_read_b64_tr_b16 %0,%1 offset:%c2":"=&v"(lo[ks]):"v"(vb),"i"(d0*4096+ks*1024):"memory");
      asm volatile("ds_read_b64_tr_b16 %0,%1 offset:%c2":"=&v"(hi[ks]):"v"(vb),"i"(d0*4096+ks*1024+512):"memory");}
    asm volatile("s_waitcnt lgkmcnt(0)":::"memory");SBAR();
    #define PK(k) (bf16x8){lo[k][0],lo[k][1],lo[k][2],lo[k][3],hi[k][0],hi[k][1],hi[k][2],hi[k][3]}
    o[d0]=__builtin_amdgcn_mfma_f32_32x32x16_bf16(pa0,PK(0),o[d0],0,0,0);
    o[d0]=__builtin_amdgcn_mfma_f32_32x32x16_bf16(pa1,PK(1),o[d0],0,0,0);
    o[d0]=__builtin_amdgcn_mfma_f32_32x32x16_bf16(pa2,PK(2),o[d0],0,0,0);
    o[d0]=__builtin_amdgcn_mfma_f32_32x32x16_bf16(pa3,PK(3),o[d0],0,0,0);
    #undef PK
  }
}

#ifndef ATTN_STORE16
#define ATTN_STORE16(p,v) (*(u32x4*)(p)=(v))
#endif
template<int THRL> __device__ __forceinline__ void attn_unit(int qb,const bf16*Q,const bf16*__restrict__ K,const bf16*__restrict__ V,bf16*O,char*shm){
  const int tid=threadIdx.x,lane=tid&63,r32=lane&31,hi=lane>>5; const int wid=__builtin_amdgcn_readfirstlane(tid>>6);
  const int q0=qb*QB;
  const bf16*Qw=Q+(long)(q0+wid*QBLK)*PQ;
  const bf16*Kh=K,*Vh=V;
  const unsigned lds0=(unsigned)(uintptr_t)shm;
  float*wsf=(float*)(shm+LDS_WS)+wid*64;
  const unsigned koff=(unsigned)(wid*1024+lane*16);
  const unsigned voffv=koff;
  const unsigned kdst=lds0+LDS_K+wid*1024, vdst=lds0+LDS_V+wid*1024;
  #define DMA_K(t,slot) glds16s(Kh+(long)(t)*KT,koff,(unsigned)__builtin_amdgcn_readfirstlane(kdst+(slot)))
  #define DMA_V(t,slot) do{ glds16s(Vh+(long)(t)*VT,voffv,(unsigned)__builtin_amdgcn_readfirstlane(vdst+2*(slot))); glds16s(Vh+4096+(long)(t)*VT,voffv,(unsigned)__builtin_amdgcn_readfirstlane(vdst+8192+2*(slot))); }while(0)
  const int vb0=(int)(lds0+LDS_V)+((lane>>4)&1)*32+(lane&3)*8+(4*hi+((lane&15)>>2))*64;
  const char*Kbase=shm+LDS_K; bf16x8 kf[8];
  const lds_cptr shm3=(lds_cptr)shm; const lds_cptr kp0=shm3+LDS_K+hi*1024+r32*16; const lds_cptr vp0=shm3+LDS_V+((lane>>4)&1)*32+(lane&3)*8+(4*hi+((lane&15)>>2))*64;
  const int NT=(q0+QB)/KVBLK;
  DMA_K(0,0);DMA_V(0,0);DMA_K(1,SLOTB);
  bf16x8 qr[4];
  #pragma unroll
  for(int d0=0;d0<4;++d0)qr[d0]=*reinterpret_cast<const bf16x8*>(&Qw[(long)r32*PQ+d0*16+hi*8]);
  float mhat=0.f,l_reg=0.f;f32x16 o[4];o[0]=f32x16{};o[1]=f32x16{};o[2]=f32x16{};o[3]=f32x16{};
  const int qrel=wid*QBLK+r32;
  #define CMASK(P0,P1,t) do{int jb_=(t)-(NT-4); if(jb_>=0)cmask(P0,P1,jb_,qrel,hi);}while(0)
  bool resc=false;
  #define START(P0,P1) do{ const float rm=rowmax(P0,P1); resc=false; \
    { const float dl=rm; mhat=fadd_s(mhat,dl); \
      _Pragma("unroll") for(int r=0;r<16;++r){P0[r]=fsub_s(P0[r],dl);P1[r]=fsub_s(P1[r],dl);} } \
    _Pragma("unroll") for(int r=0;r<16;++r)P0[r]=__builtin_amdgcn_exp2f(P0[r]); }while(0)
  #define RESC() do{ if(resc){ asm volatile("s_waitcnt lgkmcnt(0)":::"memory"); \
      _Pragma("unroll") for(int d_=0;d_<4;++d_) _Pragma("unroll") for(int r=0;r<16;++r)o[d_][r]*=wsf[crow(r,hi)]; } }while(0)
  f32x16 pA0,pA1,pB0,pB1;
  int sl_prev=0,sl_cur=0,sl_next=SLOTB;
  #define ROT() do{sl_prev=sl_cur;sl_cur=sl_next;sl_next=(sl_next==(NSLOT-1)*SLOTB)?0:sl_next+SLOTB;}while(0)
  DMA_K(2,2*SLOTB);
  WAIT_BAR(4);
  { const f32x16 zero16=f32x16{}; qkt(pA0,pA1,Kbase,qr,zero16,r32,hi); }asm volatile("s_nop 15\n\ts_nop 7":"+v"(pA0),"+v"(pA1));CMASK(pA0,pA1,0);
  START(pA0,pA1);
  _Pragma("unroll") for(int r=0;r<16;++r)pA1[r]=__builtin_amdgcn_exp2f(pA1[r]);
  WAIT_BAR(0);
  DMA_K(3,0);DMA_V(1,SLOTB);
  ROT();
  kload8(kf,kp0+sl_cur);
  WAIT_BAR(3);
  s16x4 vlo[8],vhi[8]; u32x4 pw0,pw1,pw2,pw3;
  #define PKW(P,B) cvtpk_s(P[B],P[B+1])
  #define PAF(k) __builtin_bit_cast(bf16x8,pw##k)
  #define VFR(i) (bf16x8){vlo[i][0],vlo[i][1],vlo[i][2],vlo[i][3],vhi[i][0],vhi[i][1],vhi[i][2],vhi[i][3]}
  #define PIN(x) asm volatile("":"+v"(x))
  #define MX3(a,b,c) __builtin_fmaxf(__builtin_fmaxf((a),(b)),(c))
  #define GAPA(MF,A0,A1,A2,A3,W0,W1,PW) do{ MF; sacc+=A0; sacc+=A1; sacc+=A2; sacc+=A3; PIN(sacc); W0; W1; PIN(PW); SBAR(); }while(0)
  #define EX(v) __builtin_amdgcn_exp2f(v)
  #define GAPM(MF,X,B) do{ MF; X[B]-=mhat; X[B+1]-=mhat; X[B+2]-=mhat; X[B+3]-=mhat; PIN(X); }while(0)
  #define GAPB(MF,X,B) do{ MF; X[B]=EX(X[B]); X[B+1]=EX(X[B+1]); X[B+2]=EX(X[B+2]); X[B+3]=EX(X[B+3]); PIN(X); SBAR(); }while(0)
  #define VRD(i) do{ vlo[i]=vtr(vp_+(((i)>>2)*4096+((i)&3)*1024)); vhi[i]=vtr(vp_+(((i)>>2)*4096+((i)&3)*1024+512)); }while(0)
  #define VRD2(i) do{ vlo[i]=vtr(vp_+((2+((i)>>2))*4096+((i)&3)*1024)); vhi[i]=vtr(vp_+((2+((i)>>2))*4096+((i)&3)*1024+512)); }while(0)
  #define KRD(G,j) do{ if(G){ kload2(kf,kp0+sl_next,j); SBAR(); } }while(0)
  #define STEP(C0,C1,P0,P1,t,GK,GV,GL) do{ SBAR(); \
    const lds_cptr vp_=vp0+2*sl_prev; \
    VRD(0); SBAR(); float sacc=(P0[0]+P0[1]); \
    GAPA(C0=__builtin_amdgcn_mfma_f32_32x32x16_bf16(kf[0],qr[0],f32x16{},0,0,0), P0[2],P0[3],P0[4],P0[5],     pw0[0]=PKW(P0,0), pw0[1]=PKW(P0,2), pw0); \
    VRD(4); SBAR(); GAPA(C1=__builtin_amdgcn_mfma_f32_32x32x16_bf16(kf[1],qr[0],f32x16{},0,0,0), P0[6],P0[7],P0[8],P0[9],     pw0[2]=PKW(P0,4), pw0[3]=PKW(P0,6), pw0); \
    VRD(1); SBAR(); GAPA(C0=__builtin_amdgcn_mfma_f32_32x32x16_bf16(kf[2],qr[1],C0,0,0,0),   P0[10],P0[11],P0[12],P0[13], pw1[0]=PKW(P0,8), pw1[1]=PKW(P0,10), pw1); \
    VRD(5); SBAR(); GAPA(C1=__builtin_amdgcn_mfma_f32_32x32x16_bf16(kf[3],qr[1],C1,0,0,0),   P0[14],P0[15],P1[0],P1[1],   pw1[2]=PKW(P0,12),pw1[3]=PKW(P0,14), pw1); \
    VRD(2); SBAR(); GAPA(C0=__builtin_amdgcn_mfma_f32_32x32x16_bf16(kf[4],qr[2],C0,0,0,0),   P1[2],P1[3],P1[4],P1[5],     pw2[0]=PKW(P1,0), pw2[1]=PKW(P1,2), pw2); \
    VRD(6); SBAR(); GAPA(C1=__builtin_amdgcn_mfma_f32_32x32x16_bf16(kf[5],qr[2],C1,0,0,0),   P1[6],P1[7],P1[8],P1[9],     pw2[2]=PKW(P1,4), pw2[3]=PKW(P1,6), pw2); \
    VRD(3); SBAR(); GAPA(C0=__builtin_amdgcn_mfma_f32_32x32x16_bf16(kf[6],qr[3],C0,0,0,0),   P1[10],P1[11],P1[12],P1[13], pw3[0]=PKW(P1,8), pw3[1]=PKW(P1,10), pw3); \
    VRD(7); SBAR(); GAPA(C1=__builtin_amdgcn_mfma_f32_32x32x16_bf16(kf[7],qr[3],C1,0,0,0),   P1[14],P1[15],0.f,0.f,       pw3[2]=PKW(P1,12),pw3[3]=PKW(P1,14), pw3); \
    l_reg+=sacc; \
    if(GK){DMA_K((t)+3,sl_cur);} if(GV){DMA_V((t)+1,sl_next);} \
    GAPM(o[0]=__builtin_amdgcn_mfma_f32_32x32x16_bf16(PAF(0),VFR(0),o[0],0,0,0), C0,0);  VRD2(0); SBAR(); \
    GAPM(o[1]=__builtin_amdgcn_mfma_f32_32x32x16_bf16(PAF(0),VFR(4),o[1],0,0,0), C0,4);  VRD2(4); SBAR(); \
    GAPM(o[0]=__builtin_amdgcn_mfma_f32_32x32x16_bf16(PAF(1),VFR(1),o[0],0,0,0), C0,8);  VRD2(1); SBAR(); \
    GAPM(o[1]=__builtin_amdgcn_mfma_f32_32x32x16_bf16(PAF(1),VFR(5),o[1],0,0,0), C0,12); VRD2(5); SBAR(); \
    GAPM(o[0]=__builtin_amdgcn_mfma_f32_32x32x16_bf16(PAF(2),VFR(2),o[0],0,0,0), C1,0);  VRD2(2); SBAR(); \
    GAPM(o[1]=__builtin_amdgcn_mfma_f32_32x32x16_bf16(PAF(2),VFR(6),o[1],0,0,0), C1,4);  VRD2(6); SBAR(); \
    GAPM(o[0]=__builtin_amdgcn_mfma_f32_32x32x16_bf16(PAF(3),VFR(3),o[0],0,0,0), C1,8);  VRD2(3); SBAR(); \
    GAPM(o[1]=__builtin_amdgcn_mfma_f32_32x32x16_bf16(PAF(3),VFR(7),o[1],0,0,0), C1,12); VRD2(7); SBAR(); \
    CMASK(C0,C1,t); \
    { float a=MX3(C0[0],C0[1],C1[0]),b=MX3(C0[2],C0[3],C1[1]); a=MX3(a,C1[2],C1[3]); \
      _Pragma("unroll") for(int r=4;r<16;r+=4){a=MX3(a,C0[r],C0[r+1]);b=MX3(b,C0[r+2],C0[r+3]);a=MX3(a,C1[r],C1[r+1]);b=MX3(b,C1[r+2],C1[r+3]);} \
      float rm=__builtin_fmaxf(a,b); { auto rr=__builtin_amdgcn_permlane32_swap(__float_as_uint(rm),__float_as_uint(rm),false,false); rm=__builtin_fmaxf(__uint_as_float(rr[0]),__uint_as_float(rr[1])); } \
      resc=false; \
      if(__builtin_expect(__any(rm>(float)THRL),0)){ const float dl=__builtin_fmaxf(rm,0.f); mhat+=dl; \
        _Pragma("unroll") for(int r=0;r<16;++r){C0[r]-=dl;C1[r]-=dl;} \
        const float f=__builtin_amdgcn_exp2f(-dl); l_reg*=f; if(hi==0)wsf[r32]=f; resc=true; } } \
    SBAR(); \
    GAPB(o[2]=__builtin_amdgcn_mfma_f32_32x32x16_bf16(PAF(0),VFR(0),o[2],0,0,0), C0,0); \
    GAPB(o[3]=__builtin_amdgcn_mfma_f32_32x32x16_bf16(PAF(0),VFR(4),o[3],0,0,0), C0,4); \
    KRD(GL,0); GAPB(o[2]=__builtin_amdgcn_mfma_f32_32x32x16_bf16(PAF(1),VFR(1),o[2],0,0,0), C0,8); \
    KRD(GL,1); GAPB(o[3]=__builtin_amdgcn_mfma_f32_32x32x16_bf16(PAF(1),VFR(5),o[3],0,0,0), C0,12); \
    KRD(GL,2); GAPB(o[2]=__builtin_amdgcn_mfma_f32_32x32x16_bf16(PAF(2),VFR(2),o[2],0,0,0), C1,0); \
    KRD(GL,3); GAPB(o[3]=__builtin_amdgcn_mfma_f32_32x32x16_bf16(PAF(2),VFR(6),o[3],0,0,0), C1,4); \
    GAPB(o[2]=__builtin_amdgcn_mfma_f32_32x32x16_bf16(PAF(3),VFR(3),o[2],0,0,0), C1,8); \
    GAPB(o[3]=__builtin_amdgcn_mfma_f32_32x32x16_bf16(PAF(3),VFR(7),o[3],0,0,0), C1,12); \
    }while(0)
  int t=1;
  #undef CMASK
  #define CMASK(P0,P1,t) do{}while(0)
  for(;t+5<NT;t+=2){
    STEP(pB0,pB1,pA0,pA1,t,true,true,true);     WAIT_BAR(3); RESC(); ROT();
    STEP(pA0,pA1,pB0,pB1,t+1,true,true,true);   WAIT_BAR(3); RESC(); ROT();
  }
  #undef CMASK
  #define CMASK(P0,P1,t) do{int jb_=(t)-(NT-4); if(jb_>=0)cmask(P0,P1,jb_,qrel,hi);}while(0)
  #define ENDW(tt) do{ if((tt)+3<NT){WAIT_BAR(3);} else if((tt)+2<NT){WAIT_BAR(2);} else {WAIT_BAR(0);} }while(0)
  for(;t+1<NT;t+=2){
    STEP(pB0,pB1,pA0,pA1,t,(t+3<NT),(t+1<NT),(t+1<NT));       ENDW(t);   RESC(); ROT();
    STEP(pA0,pA1,pB0,pB1,t+1,(t+4<NT),(t+2<NT),(t+2<NT));     ENDW(t+1); RESC(); ROT();
  }
  STEP(pB0,pB1,pA0,pA1,NT-1,false,false,false); RESC();
  { float sacc=pB0[0]+pB0[1]; _Pragma("unroll") for(int r=2;r<16;++r)sacc+=pB0[r]; _Pragma("unroll") for(int r=0;r<16;++r)sacc+=pB1[r]; l_reg+=sacc;
    pw0=(u32x4){PKW(pB0,0),PKW(pB0,2),PKW(pB0,4),PKW(pB0,6)};pw1=(u32x4){PKW(pB0,8),PKW(pB0,10),PKW(pB0,12),PKW(pB0,14)};pw2=(u32x4){PKW(pB1,0),PKW(pB1,2),PKW(pB1,4),PKW(pB1,6)};pw3=(u32x4){PKW(pB1,8),PKW(pB1,10),PKW(pB1,12),PKW(pB1,14)};
    SBAR(); pv(o,vb0+2*sl_cur,PAF(0),PAF(1),PAF(2),PAF(3)); }
  #undef PKW
  #undef PAF
  #undef VFR
  #undef PIN
  #undef MX3
  #undef GAPA
  #undef GAPB
  #undef GAPM
  #undef EX
  #undef VRD
  #undef VRD2
  #undef KRD
  #undef STEP
  #undef ENDW
  {auto rr=__builtin_amdgcn_permlane32_swap(__float_as_uint(l_reg),__float_as_uint(l_reg),false,false);l_reg=__uint_as_float(rr[0])+__uint_as_float(rr[1]);}
  if(hi==0)wsf[32+r32]=l_reg;asm volatile("s_waitcnt lgkmcnt(0)":::"memory");
  float rli[16];
  #pragma unroll
  for(int r=0;r<16;++r)rli[r]=__builtin_amdgcn_rcpf(wsf[32+crow(r,hi)]);
  bf16*Ow=O+(long)(q0+wid*QBLK)*PO;
  { bf16*stg=(bf16*)(shm+LDS_OST)+wid*2048;
    #pragma unroll
    for(int p=0;p<2;++p){
    #pragma unroll
    for(int r=0;r<16;++r){const int orow=crow(r,hi);
      #pragma unroll
      for(int d0=0;d0<2;++d0)stg[orow*64+d0*32+r32]=__float2bfloat16(o[2*p+d0][r]*rli[r]);}
    asm volatile("s_waitcnt lgkmcnt(0)":::"memory");
    #pragma unroll
    for(int i=0;i<4;++i){const int row=i*8+(lane>>3),ch=lane&7; const u32x4 v=*(const u32x4*)(stg+row*64+ch*8); ATTN_STORE16(Ow+(long)row*PO+p*64+ch*8,v);}
    asm volatile("s_waitcnt lgkmcnt(0)":::"memory"); } }
  asm volatile("s_waitcnt lgkmcnt(0)\n\ts_barrier":::"memory");
  #undef DMA_K
  #undef DMA_V
  #undef CMASK
  #undef START
  #undef RESC
  #undef ROT
}
constexpr int ATTN_LDS_BYTES=LDS_BYTES;
struct AttnTensors { const bf16* Q; const bf16* Kimg; const bf16* Vimg; bf16* O0; bf16* O1; };
struct AttnUnit { int vh; int qb; };
struct StaticOrder {
  int vcu;
  __device__ __forceinline__ explicit StaticOrder(int vcu_):vcu(vcu_){}
  __device__ __forceinline__ bool next(int i,AttnUnit&u)const{ if(i>=4)return false; const int s=vcu&3; u.vh=vcu>>2; u.qb=(i==0)?s:(i==1)?7-s:(i==2)?8+s:15-s; return true; }
  __device__ __forceinline__ void a_ready(const AttnUnit&)const{}
  __device__ __forceinline__ void done(const AttnUnit&)const{}
};
__device__ __forceinline__ void attn_run(const AttnTensors&T,int vh,int qb,char*lds){
  const int comp=vh&1,h=(vh>>1)&3,b=vh>>3;
  attn_unit<8>(qb,T.Q+(long)b*SEQ*PQ+h*128+comp*64,T.Kimg+(long)((b*8+h*2+comp)*(SEQ/64))*KT,T.Vimg+(long)((b*4+h)*(SEQ/64))*VT,(comp?T.O1:T.O0)+(long)b*SEQ*PO+h*128,lds);
}
__device__ __forceinline__ void attn_phase_queue(char*lds,const AttnTensors&T,unsigned*qhead,int xq,volatile __attribute__((address_space(3))) unsigned*mbox){
  const bool t0=(threadIdx.x==0);
  if(t0)mbox[0]=__hip_atomic_fetch_add(qhead,1u,__ATOMIC_RELAXED,__HIP_MEMORY_SCOPE_AGENT);
  asm volatile("s_waitcnt vmcnt(0) lgkmcnt(0)\n\ts_barrier":::"memory");
  unsigned ticket=(unsigned)__builtin_amdgcn_readfirstlane(mbox[0]); int par=0;
  while(ticket<64u){
    unsigned nxt=0u; if(t0)nxt=__hip_atomic_fetch_add(qhead,1u,__ATOMIC_RELAXED,__HIP_MEMORY_SCOPE_AGENT);
    attn_run(T,4*xq+(int)(ticket&3u),15-(int)(ticket>>2),lds);
    par^=1; if(t0)mbox[par]=nxt;
    asm volatile("s_waitcnt vmcnt(0) lgkmcnt(0)\n\ts_barrier":::"memory");
    ticket=(unsigned)__builtin_amdgcn_readfirstlane(mbox[par]);
  }
}
#undef SBAR
#undef WAIT_BAR
}

constexpr int NWAVES = 8;
#ifndef MK_N_LAUNCHES
#define MK_N_LAUNCHES 1
#endif
constexpr int PER_PHASE = 8;
constexpr int N_LAUNCHES = MK_N_LAUNCHES;

constexpr int BATCH = 4, T = 4096, D = 1024;
constexpr int M = BATCH * T;
constexpr int RW_W = 512, RW_H = 8, RW_N = 64, DA_W = 512;
constexpr int RW_SHIFTED = 1664, RW_COLS = 2176, D_IN = 4224;
constexpr int NMAIN = 4096;
constexpr float RMS_EPS = 1e-6f, GN_EPS = 64e-5f, SUBLN_EPS = 1e-5f;
constexpr float LAMBDA_INIT = 0.2f;
constexpr float LOG2E = 1.4426950408889634f;

constexpr size_t MiB = 1u << 20, KiB = 1u << 10;
constexpr size_t WS_CTL = 0, CTL_ZERO_BYTES = 128 * KiB;
constexpr size_t WS_MOD = 128 * KiB;
constexpr size_t WS_W2T = 256 * KiB;
constexpr size_t WS_BONUS = 512 * KiB;
constexpr size_t WS_X = 1 * MiB;
constexpr size_t WS_WOUT = 1 * MiB + 512 * KiB;
constexpr size_t WS_WIN = 3 * MiB + 512 * KiB;
constexpr size_t WS_XN = 11 * MiB + 768 * KiB;
constexpr size_t WS_REC1 = WS_XN;
constexpr size_t WS_Y = WS_XN;
constexpr size_t WS_URK = WS_XN + 32 * MiB;
constexpr size_t WS_UVG = WS_URK + 32 * MiB;
constexpr size_t WS_UQG = WS_UVG + 32 * MiB;
constexpr size_t WS_KIMG = WS_UQG + 32 * MiB;
constexpr size_t WS_VIMG = WS_KIMG + 16 * MiB;
constexpr size_t WS_REC2 = WS_VIMG + 16 * MiB;
constexpr size_t WS_LO = WS_REC2 + 65 * MiB;
constexpr size_t WS_ORW = WS_LO;
constexpr size_t WS_END = WS_ORW + 16 * MiB;
static_assert(WS_END <= 256 * MiB, "d_ws map");
constexpr int UP = 1024;
constexpr int CW_TMO = 0, CW_CODE = 1;
constexpr int CW_BAR = 4096;
constexpr int CW_SEAM = 16384;
constexpr int CW_QUEUE = 24576;
static_assert((CW_QUEUE + 1024 + 16 * 64) * 4 <= (int)CTL_ZERO_BYTES, "CTL words inside the memset region");

constexpr int RING_OFF = 0, RING_BYTES = 131072;
constexpr int LDSCTL_OFF = RING_BYTES, MISC_OFF = LDSCTL_OFF + 320;
constexpr int LDS_BYTES = 147456;
static_assert(MISC_OFF + 128 <= LDS_BYTES, "LDS map");

#define GAS __attribute__((address_space(1)))
#define LAS __attribute__((address_space(3)))
typedef unsigned short bf16;
typedef unsigned v4u __attribute__((ext_vector_type(4)));
typedef float f32x4 __attribute__((ext_vector_type(4)));
typedef short bf16x8 __attribute__((ext_vector_type(8)));
typedef GAS unsigned gu32;
typedef GAS unsigned long long gu64;
#define RLX_AGENT __ATOMIC_RELAXED, __HIP_MEMORY_SCOPE_AGENT
#define LDS_WAIT() asm volatile("s_waitcnt lgkmcnt(0)" ::: "memory")
#define VM_WAIT() asm volatile("s_waitcnt vmcnt(0)" ::: "memory")
__device__ __forceinline__ unsigned long long rt() { return __builtin_amdgcn_s_memrealtime(); }
__device__ __forceinline__ unsigned f2bf(float f) { unsigned u = __builtin_bit_cast(unsigned, f); return (u + 0x7fffu + ((u >> 16) & 1u)) >> 16; }
__device__ __forceinline__ unsigned pk2(float lo, float hi) { return f2bf(lo) | (f2bf(hi) << 16); }

#define XB_TMO      128
#define XB_XCNT(j)  (256  + 64 * (j))
#define XB_XSUB(j)  (1280 + 64 * (j))
#define XB_XGEN(j)  (2304 + 64 * (j))
#define XB_TOP      3328
#define XB_TOPGEN   3392
#define XCD_BAR_WORDS 3456
#define XB_SPIN_CAP (1u << 18)

__device__ __forceinline__ unsigned xb_ld(unsigned* p)              { return __hip_atomic_load(p, __ATOMIC_RELAXED, __HIP_MEMORY_SCOPE_AGENT); }
__device__ __forceinline__ unsigned xb_add(unsigned* p, unsigned v) { return __hip_atomic_fetch_add(p, v, __ATOMIC_RELAXED, __HIP_MEMORY_SCOPE_AGENT); }
__device__ __forceinline__ unsigned xb_xcc_id() { return (unsigned)__builtin_amdgcn_s_getreg((3 << 11) | 20) & 0xFu; }
#define XB_SPIN(cond, bar) do { unsigned _sp = 0; while (cond) { __builtin_amdgcn_s_sleep(1); \
    if ((++_sp & 255u) == 0u) { if (xb_ld(&(bar)[XB_TMO])) break; if (_sp > XB_SPIN_CAP) { atomicAdd(&(bar)[XB_TMO], 1u); break; } } } } while (0)

struct XcdBarrier {
    unsigned* bar; unsigned x;
    volatile LAS unsigned* st;
};

__device__ __forceinline__ XcdBarrier xcd_barrier_post(unsigned* bar, volatile LAS unsigned* st) {
    XcdBarrier b; b.bar = bar; b.x = xb_xcc_id(); b.st = st;
    if (threadIdx.x == 0) (void)xb_add(&bar[XB_XCNT(b.x)], 1u);
    return b;
}
__device__ __forceinline__ void xcd_barrier_complete(unsigned* bar, unsigned x, unsigned& nloc, unsigned& nx) {
    const unsigned G = gridDim.x * gridDim.y * gridDim.z;
    unsigned sum, cnt, mine, sp = 0u;
    for (;;) {
        sum = 0u; cnt = 0u; mine = 0u;
#pragma unroll
        for (unsigned j = 0; j < 16; ++j) { const unsigned c = xb_ld(&bar[XB_XCNT(j)]); sum += c; cnt += (c > 0u) ? 1u : 0u; mine = (j == x) ? c : mine; }
        if (sum == G) break;
        __builtin_amdgcn_s_sleep(1);
        if ((++sp & 255u) == 0u) { if (xb_ld(&bar[XB_TMO])) break; if (sp > XB_SPIN_CAP) { atomicAdd(&bar[XB_TMO], 1u); break; } }
    }
    nloc = mine > 0u ? mine : 1u; nx = cnt > 0u ? cnt : 1u;
}

__device__ __forceinline__ void xcd_barrier(const XcdBarrier& b) {
    asm volatile("s_waitcnt vmcnt(0)" ::: "memory");
    __syncthreads();
    if (threadIdx.x == 0) {
        unsigned* bar = b.bar;
        __builtin_amdgcn_s_waitcnt(0);
        unsigned nloc = b.st[0], nx = b.st[1];
        if (nloc == 0u) { xcd_barrier_complete(bar, b.x, nloc, nx); b.st[0] = nloc; b.st[1] = nx; }
        const unsigned old = xb_add(&bar[XB_XSUB(b.x)], 1u);
        const unsigned gen = old / nloc;
        if (old + 1u == (gen + 1u) * nloc) {
            __builtin_amdgcn_fence(__ATOMIC_RELEASE, "agent");
            asm volatile("s_waitcnt vmcnt(0)" ::: "memory");
            const unsigned og = xb_add(&bar[XB_TOP], 1u);
            const unsigned tg = og / nx;
            if (og + 1u == (tg + 1u) * nx) xb_add(&bar[XB_TOPGEN], 1u);
            else XB_SPIN(xb_ld(&bar[XB_TOPGEN]) == tg, bar);
            __builtin_amdgcn_fence(__ATOMIC_ACQUIRE, "agent");
            xb_add(&bar[XB_XGEN(b.x)], 1u);
            asm volatile("s_waitcnt vmcnt(0)" ::: "memory");
        } else {
            XB_SPIN(xb_ld(&bar[XB_XGEN(b.x)]) == gen, bar);
            __builtin_amdgcn_fence(__ATOMIC_ACQUIRE, "agent");
            asm volatile("s_waitcnt vmcnt(0)" ::: "memory");
        }
    }
    __syncthreads();
}
struct Frame {
    LAS unsigned char* lds;
    volatile LAS unsigned* MISC;
    gu32* ctl;
    int tid, lane, wave;
    int vcu, G;
    const float* in[23]; float* out; unsigned char* ws;
};
enum { I_X = 0, I_C, I_WADA, I_BADA, I_GPRE, I_GPOST, I_WIN, I_WOUT, I_MU, I_W0, I_WW2, I_A0, I_WA2, I_KK, I_KA, I_RK, I_LNW, I_LNB, I_LQ1, I_LK1, I_LQ2, I_LK2, I_SUBLN };

typedef float f32x2c_t __attribute__((ext_vector_type(2))); typedef __bf16 bf16x2c_t __attribute__((ext_vector_type(2)));
__device__ __forceinline__ unsigned cvtpk(float lo, float hi) { f32x2c_t v = {lo, hi}; bf16x2c_t b = __builtin_convertvector(v, bf16x2c_t); return __builtin_bit_cast(unsigned, b); }
__device__ __forceinline__ float bf2f(unsigned short v) { return __builtin_bit_cast(float, (unsigned)v << 16); }
__device__ __forceinline__ float bflo(unsigned v) { return __builtin_bit_cast(float, v << 16); }
__device__ __forceinline__ float bfhi(unsigned v) { return __builtin_bit_cast(float, v & 0xffff0000u); }
__device__ __forceinline__ float sigmoidf_(float x) { return 1.f / (1.f + __expf(-x)); }
__device__ __forceinline__ float siluf_(float x) { return x / (1.f + __expf(-x)); }

__device__ __forceinline__ float wave_sum(float v) {
#pragma unroll
    for (int o = 1; o < 64; o <<= 1) v += __shfl_xor(v, o);
    return v;
}
__device__ __forceinline__ int win_col(int n) { return n < 1536 ? n : (n < 2048 ? 1664 + (n - 1536) : (n < 4096 ? 2176 + (n - 2048) : 1536 + (n - 4096))); }
template <bool IMG = false> __device__ __forceinline__ void p0_transpose_item(const float* W, int K, int N, bf16* WT, int k0, int src_col0, int dst_row0, LAS float* scr, int lane) {
#pragma unroll 8
    for (int i = 0; i < 32; ++i) { const int kk = 2 * i + (lane >> 5); scr[kk * 33 + (lane & 31)] = W[(size_t)(k0 + kk) * N + src_col0 + (lane & 31)]; }
    LDS_WAIT(); asm volatile("" ::: "memory");
    const int c = lane & 7;
#pragma unroll
    for (int j = 0; j < 4; ++j) { const int n = (lane >> 3) + 8 * j; const LAS float* s = scr + (8 * c) * 33 + n;
        v4u o; o.x = pk2(s[0 * 33], s[1 * 33]); o.y = pk2(s[2 * 33], s[3 * 33]); o.z = pk2(s[4 * 33], s[5 * 33]); o.w = pk2(s[6 * 33], s[7 * 33]);
        if (IMG) { const int nn = dst_row0 + n, kk_ = k0 + 8 * c; *(GAS v4u*)((char*)WT + ((size_t)(((nn >> 4) * 32 + (kk_ >> 5)) * 64 + ((kk_ >> 3) & 3) * 16 + (nn & 15))) * 16) = o; }
        else *(GAS v4u*)(WT + (size_t)(dst_row0 + n) * K + k0 + 8 * c) = o; }
    LDS_WAIT(); asm volatile("" ::: "memory");
}
__device__ __forceinline__ void p0_mod_item(Frame& F, int item) {
    const float* c = F.in[I_C]; const float* wada = F.in[I_WADA]; const float* bada = F.in[I_BADA]; float* mod = (float*)(F.ws + WS_MOD);
    const int col = item * 4;
    f32x4 acc[4] = {{0.f, 0.f, 0.f, 0.f}, {0.f, 0.f, 0.f, 0.f}, {0.f, 0.f, 0.f, 0.f}, {0.f, 0.f, 0.f, 0.f}};
    f32x4 wv[16];
#pragma unroll
    for (int i = 0; i < 16; ++i) wv[i] = *(const f32x4*)(wada + (size_t)(F.lane + 64 * i) * 3072 + col);
#pragma unroll
    for (int i = 0; i < 16; ++i) { const int k = F.lane + 64 * i;
#pragma unroll
        for (int b = 0; b < 4; ++b) acc[b] += siluf_(c[b * D + k]) * wv[i]; }
#pragma unroll
    for (int b = 0; b < 4; ++b)
#pragma unroll
        for (int i = 0; i < 4; ++i) acc[b][i] = wave_sum(acc[b][i]);
    if (F.lane == 0) {
        const f32x4 bv = *(const f32x4*)(bada + col);
#pragma unroll
        for (int b = 0; b < 4; ++b) *(f32x4*)(mod + b * 3072 + col) = acc[b] + bv;
    }
}
__device__ __forceinline__ void p0_prologue(Frame& F) {
    LAS float* scr = (LAS float*)(F.lds + RING_OFF + F.wave * 16384);
    const int gw = F.vcu * NWAVES + F.wave, NGW = F.G * NWAVES;
    constexpr int I_MOD = 3072 / 4, I_IN = (D / 64) * (D_IN / 32), I_OUT = (D / 64) * (D / 32), I_W2 = 512 / 32;
    constexpr int NITEMS = I_MOD + I_IN + I_OUT + 2 * I_W2;
    bf16* WinT = (bf16*)(F.ws + WS_WIN); bf16* WoutT = (bf16*)(F.ws + WS_WOUT);
    for (int it = gw; it < NITEMS; it += NGW) {
        int r = it;
        if (r < I_MOD) { p0_mod_item(F, r); continue; } r -= I_MOD;
        if (r < I_IN) { const int nblk = D_IN / 32, kb = r / nblk, nb = r % nblk; p0_transpose_item(F.in[I_WIN], D, D_IN, WinT, 64 * kb, win_col(32 * nb), 32 * nb, scr, F.lane); continue; } r -= I_IN;
        if (r < I_OUT) { const int nblk = D / 32, kb = r / nblk, nb = r % nblk; p0_transpose_item<true>(F.in[I_WOUT], D, D, WoutT, 64 * kb, 32 * nb, 32 * nb, scr, F.lane); continue; } r -= I_OUT;
        { const int which = r / I_W2, nb = r % I_W2; p0_transpose_item(F.in[which ? I_WA2 : I_WW2], 64, 512, (bf16*)(F.ws + WS_W2T) + (size_t)which * 512 * 64, 0, 32 * nb, 32 * nb, scr, F.lane); }
    }
}
__device__ __forceinline__ void p1_rows(Frame& F) {
    const int gw = F.vcu * NWAVES + F.wave, NGW = F.G * NWAVES;
    const float* x = F.in[I_X]; const float* gpre = F.in[I_GPRE]; const float* mod = (const float*)(F.ws + WS_MOD); bf16* XN = (bf16*)(F.ws + WS_XN);
    for (int m0 = gw; m0 < M; m0 += 8 * NGW) {
        f32x4 v[8][4];
#pragma unroll
        for (int r = 0; r < 8; ++r) { const int m = m0 + r * NGW; if (m < M) { const GAS f32x4* xr = (const GAS f32x4*)(x + (size_t)m * D) + F.lane;
#pragma unroll
            for (int j = 0; j < 4; ++j) v[r][j] = __builtin_nontemporal_load(xr + 64 * j); } }
#pragma unroll
        for (int r = 0; r < 8; ++r) { const int m = m0 + r * NGW; if (m < M) { const int b = m / T; float s = 0.f;
#pragma unroll
            for (int j = 0; j < 4; ++j) s += (v[r][j].x * v[r][j].x + v[r][j].y * v[r][j].y) + (v[r][j].z * v[r][j].z + v[r][j].w * v[r][j].w);
            const float rstd = 1.f / sqrtf(wave_sum(s) * (1.f / D) + RMS_EPS);
            GAS unsigned long long* o8 = (GAS unsigned long long*)(XN + (size_t)m * D) + F.lane;
#pragma unroll
            for (int j = 0; j < 4; ++j) { const int col = 4 * F.lane + 256 * j;
                const f32x4 g = *(const f32x4*)(gpre + col), sh = *(const f32x4*)(mod + b * 3072 + col), sc = *(const f32x4*)(mod + b * 3072 + 1024 + col);
                const f32x4 h = v[r][j] * rstd * g * (sc + 1.f) + sh;
                o8[64 * j] = (unsigned long long)pk2(h.x, h.y) | ((unsigned long long)pk2(h.z, h.w) << 32); } } }
    }
}
__device__ __forceinline__ void glds16f(const void* gsrc, unsigned lds_dst) { unsigned keep;
    asm volatile("s_mov_b32 %0, m0\n\ts_mov_b32 m0, %2\n\ts_nop 0\n\tglobal_load_lds_dwordx4 %1, off\n\ts_mov_b32 m0, %0" : "=&s"(keep) : "v"(gsrc), "s"(lds_dst) : "memory"); }
__device__ __forceinline__ void glds4f(const void* gsrc, unsigned lds_dst) { unsigned keep;
    asm volatile("s_mov_b32 %0, m0\n\ts_mov_b32 m0, %2\n\ts_nop 0\n\tglobal_load_lds_dword %1, off\n\ts_mov_b32 m0, %0" : "=&s"(keep) : "v"(gsrc), "s"(lds_dst) : "memory"); }
__device__ __forceinline__ void p2_lora(Frame& F) {
    typedef float f32x4_ __attribute__((ext_vector_type(4)));
    const bf16* XN = (const bf16*)(F.ws + WS_XN); const bf16* Wl = (const bf16*)(F.ws + WS_WIN) + (size_t)NMAIN * D; bf16* LO = (bf16*)(F.ws + WS_LO);
    const int fr = F.lane & 15, fq = F.lane >> 4, w = F.wave;
    const unsigned lds0 = (unsigned)(uintptr_t)(F.lds + RING_OFF);
    for (int unit = F.vcu; unit < M / 64; unit += F.G) {
        const int row0 = unit * 64;
        const bf16* bp = Wl + (size_t)(w * 16 + fr) * D + fq * 8;
        bf16x8 bb[32];
#pragma unroll
        for (int k = 0; k < 32; ++k) bb[k] = *(const bf16x8*)(bp + k * 32);
#pragma unroll
        for (int j = 0; j < 16; ++j) { const int p = w + 8 * j, ks = p >> 2, rt = p & 3;
            glds16f(XN + (size_t)(row0 + rt * 16 + fr) * D + ks * 32 + fq * 8, (unsigned)__builtin_amdgcn_readfirstlane(lds0 + p * 1024)); }
        f32x4_ acc[4] = {{0.f, 0.f, 0.f, 0.f}, {0.f, 0.f, 0.f, 0.f}, {0.f, 0.f, 0.f, 0.f}, {0.f, 0.f, 0.f, 0.f}};
#define LORA_STAGE(s_, cnt_) do { asm volatile("s_waitcnt vmcnt(" #cnt_ ")" ::: "memory"); __builtin_amdgcn_s_barrier(); asm volatile("" ::: "memory"); \
            _Pragma("unroll") for (int k = 0; k < 8; ++k) { const int ks = (s_) * 8 + k; \
                _Pragma("unroll") for (int rt = 0; rt < 4; ++rt) { const bf16x8 a = *(const LAS bf16x8*)(F.lds + RING_OFF + (4 * ks + rt) * 1024 + F.lane * 16); \
                    acc[rt] = __builtin_amdgcn_mfma_f32_16x16x32_bf16(bb[ks], a, acc[rt], 0, 0, 0); } } } while (0)
        LORA_STAGE(0, 12); LORA_STAGE(1, 8); LORA_STAGE(2, 4); LORA_STAGE(3, 0);
#undef LORA_STAGE
#pragma unroll
        for (int rt = 0; rt < 4; ++rt) { const unsigned long long o = (unsigned long long)cvtpk(acc[rt][0], acc[rt][1]) | ((unsigned long long)cvtpk(acc[rt][2], acc[rt][3]) << 32);
            *(GAS unsigned long long*)(LO + (size_t)(row0 + rt * 16 + fr) * 128 + w * 16 + 4 * fq) = o; }
        LDS_WAIT(); __builtin_amdgcn_s_barrier();
    }
}
__device__ __forceinline__ float tshift(float cur, float prev, float mu) { return cur + (prev - cur) * mu; }

constexpr int REC_WA = 0, REC_RA = 2048, REC_AR = 4096, REC_BK = 5120, REC_VT = 9216, REC_MAK = 11264, REC_G = 11776, REC_BYTES = 12032;
constexpr int NCHUNK = T / 16;
constexpr int REC1_N = (int)((32 * MiB) / REC_BYTES);
static_assert((size_t)(BATCH * RW_H * NCHUNK - REC1_N) * REC_BYTES <= 65 * MiB, "record regions");
__device__ __forceinline__ unsigned char* rec_ptr(unsigned char* ws, int b, int h, int chunk) {
    const int idx = (b * RW_H + h) * NCHUNK + chunk;
    return idx < REC1_N ? ws + WS_REC1 + (size_t)idx * REC_BYTES : ws + WS_REC2 + (size_t)(idx - REC1_N) * REC_BYTES;
}
constexpr int PW_KAP = 0, PW_RH = 2304, PW_BH = 4608, PW_KH = 6912, PW_AAB = 9216, PW_AAK = 10496, PW_TM = 11776;
constexpr int PWS = 72;
static_assert(PW_TM + 16 * 20 * 4 <= 13312 && 2 * 16 * 68 * 4 <= PW_AAB, "prep scratch");

constexpr int PWB = 13312;
constexpr int PT_S = 68;
__device__ __forceinline__ float fast_exp(float x) { return __builtin_amdgcn_exp2f(x * LOG2E); }
__device__ __forceinline__ float fast_sigmoid(float x) { return __builtin_amdgcn_rcpf(1.f + fast_exp(-x)); }
__device__ __forceinline__ float fast_tanh(float x) { const float e = fast_exp(-2.f * fabsf(x)); const float t = (1.f - e) * __builtin_amdgcn_rcpf(1.f + e); return x < 0.f ? -t : t; }
__device__ __forceinline__ void p3_prep(Frame& F) {
    typedef float f32x4_ __attribute__((ext_vector_type(4)));
    const bf16* LO = (const bf16*)(F.ws + WS_LO); const bf16* Urk = (const bf16*)(F.ws + WS_URK); const bf16* Uvg = (const bf16*)(F.ws + WS_UVG); float* BON = (float*)(F.ws + WS_BONUS);
    const bf16* W2T = (const bf16*)(F.ws + WS_W2T);
    const float* mu = F.in[I_MU];
    LAS unsigned char* pw = F.lds + RING_OFF + F.wave * PWB;
    const int c = F.tid, lane = F.lane, h = F.wave, fi = lane & 15, fg = lane >> 4;
    const float k_k = F.in[I_KK][c], k_a = F.in[I_KA][c], r_k = F.in[I_RK][c], mu_r = mu[c], mu_k = mu[512 + c], mu_v = mu[1024 + c];
    float w0c[4], a0c[4];
#pragma unroll
    for (int nt = 0; nt < 4; ++nt) { w0c[nt] = F.in[I_W0][h * 64 + nt * 16 + fi]; a0c[nt] = F.in[I_A0][h * 64 + nt * 16 + fi]; }
    for (int tile = F.vcu; tile < M / 16; tile += F.G) {
        const int m0 = tile * 16, b = m0 / T, chunk = (m0 % T) / 16; const bool firstc = (chunk == 0);
        unsigned char* rec = rec_ptr(F.ws, b, h, chunk);
        unsigned short rw_[17], kw_[17], vw_[17];
#pragma unroll
        for (int i = 0; i < 17; ++i) { const size_t m = (size_t)(m0 + i - 1);
            if (i == 0 && firstc) { rw_[0] = 0; kw_[0] = 0; vw_[0] = 0; }
            else { rw_[i] = Urk[m * UP + c]; kw_[i] = Urk[m * UP + 512 + c]; vw_[i] = Uvg[m * UP + c]; } }
        float lw2[16], av[16];
        {
            bf16x8 fw[2], fa[2];
#pragma unroll
            for (int ks = 0; ks < 2; ++ks) {
                const bf16* lp = LO + (size_t)(m0 + fi) * 128 + ks * 32 + fg * 8; const bool nz = !(firstc && fi == 0);
                const v4u cw_ = *(const GAS v4u*)lp, ca_ = *(const GAS v4u*)(lp + 64);
                v4u pw_ = {0u, 0u, 0u, 0u}, pa_ = pw_; if (nz) { pw_ = *(const GAS v4u*)(lp - 128); pa_ = *(const GAS v4u*)(lp - 64); }
                const f32x4_ m0w = *(const f32x4_*)(mu + 1536 + ks * 32 + fg * 8), m1w = *(const f32x4_*)(mu + 1536 + ks * 32 + fg * 8 + 4), m0a = *(const f32x4_*)(mu + 1600 + ks * 32 + fg * 8), m1a = *(const f32x4_*)(mu + 1600 + ks * 32 + fg * 8 + 4);
                v4u ow, oa;
#pragma unroll
                for (int u = 0; u < 4; ++u) { const float mwl = (u < 2 ? m0w : m1w)[(2 * u) & 3], mwh = (u < 2 ? m0w : m1w)[(2 * u + 1) & 3], mal = (u < 2 ? m0a : m1a)[(2 * u) & 3], mah = (u < 2 ? m0a : m1a)[(2 * u + 1) & 3];
                    ow[u] = cvtpk(fast_tanh(tshift(bflo(cw_[u]), bflo(pw_[u]), mwl)), fast_tanh(tshift(bfhi(cw_[u]), bfhi(pw_[u]), mwh)));
                    oa[u] = cvtpk(tshift(bflo(ca_[u]), bflo(pa_[u]), mal), tshift(bfhi(ca_[u]), bfhi(pa_[u]), mah)); }
                fw[ks] = __builtin_bit_cast(bf16x8, ow); fa[ks] = __builtin_bit_cast(bf16x8, oa); }
            f32x4_ cw[4], ca[4];
#pragma unroll
            for (int nt = 0; nt < 4; ++nt) { cw[nt] = (f32x4_){0.f, 0.f, 0.f, 0.f}; ca[nt] = cw[nt]; }
#pragma unroll
            for (int nt = 0; nt < 4; ++nt)
#pragma unroll
                for (int ks = 0; ks < 2; ++ks) { const size_t o = (size_t)(h * 64 + nt * 16 + fi) * 64 + ks * 32 + fg * 8;
                    const bf16x8 bw = *(const bf16x8*)(W2T + o), ba = *(const bf16x8*)(W2T + 512 * 64 + o);
                    cw[nt] = __builtin_amdgcn_mfma_f32_16x16x32_bf16(fw[ks], bw, cw[nt], 0, 0, 0); ca[nt] = __builtin_amdgcn_mfma_f32_16x16x32_bf16(fa[ks], ba, ca[nt], 0, 0, 0); }
            LAS float* t1 = (LAS float*)pw; LAS float* t2 = t1 + 16 * PT_S;
#pragma unroll
            for (int nt = 0; nt < 4; ++nt)
#pragma unroll
                for (int j = 0; j < 4; ++j) { const float x_ = w0c[nt] + cw[nt][j];
                    const float sp = 0.6931471805599453f * __builtin_amdgcn_logf(1.f + fast_exp(-x_));
                    t1[(4 * fg + j) * PT_S + nt * 16 + fi] = -fast_exp(-sp - 0.5f) * LOG2E;
                    t2[(4 * fg + j) * PT_S + nt * 16 + fi] = fast_sigmoid(a0c[nt] + ca[nt][j]); }
            LDS_WAIT(); asm volatile("" ::: "memory");
#pragma unroll
            for (int i = 0; i < 16; ++i) { lw2[i] = t1[i * PT_S + lane]; av[i] = t2[i * PT_S + lane]; }
            LDS_WAIT(); asm volatile("" ::: "memory");
        }
        float kap[16], cl[16];
        {
        float rr[16], kt[16], kk[16], bb[16];
        LAS float* r1 = (LAS float*)pw; LAS float* r2 = r1 + 16 * PT_S; LAS float* s1 = (LAS float*)(pw + PW_TM);
        {
        float vv[16];
#pragma unroll
        for (int i = 0; i < 16; ++i) {
            const float r = tshift(bf2f(rw_[i + 1]), bf2f(rw_[i]), mu_r), k = tshift(bf2f(kw_[i + 1]), bf2f(kw_[i]), mu_k);
            vv[i] = tshift(bf2f(vw_[i + 1]), bf2f(vw_[i]), mu_v);
            const float kkr = k * k_k; kk[i] = kkr; kt[i] = k * (1.f + (av[i] - 1.f) * k_a); rr[i] = r;
            r1[i * PT_S + lane] = kkr * kkr; r2[i * PT_S + lane] = r * kt[i] * r_k; }
#pragma unroll
        for (int g = 0; g < 4; ++g) { const unsigned long long o = (unsigned long long)cvtpk(vv[4 * g], vv[4 * g + 1]) | ((unsigned long long)cvtpk(vv[4 * g + 2], vv[4 * g + 3]) << 32);
            *(GAS unsigned long long*)(rec + REC_VT + (lane >> 4) * 512 + (g * 16 + (lane & 15)) * 8) = o; }
        }
        LDS_WAIT(); asm volatile("" ::: "memory");
        { const int i = lane >> 2, q = lane & 3; float sa = 0.f, sb = 0.f;
#pragma unroll
          for (int u = 0; u < 4; ++u) { const f32x4_ x = *(const LAS f32x4_*)(r1 + i * PT_S + 16 * q + 4 * u), y = *(const LAS f32x4_*)(r2 + i * PT_S + 16 * q + 4 * u); sa += (x[0] + x[1]) + (x[2] + x[3]); sb += (y[0] + y[1]) + (y[2] + y[3]); }
          sa += __shfl_xor(sa, 1); sa += __shfl_xor(sa, 2); sb += __shfl_xor(sb, 1); sb += __shfl_xor(sb, 2);
          if (q == 0) { s1[i] = sa; BON[(m0 + i) * 8 + h] = sb; } }
        LDS_WAIT(); asm volatile("" ::: "memory");
        float run = 0.f;
#pragma unroll
        for (int i = 0; i < 16; ++i) { kk[i] = kk[i] * __builtin_amdgcn_rcpf(fmaxf(__builtin_amdgcn_sqrtf(s1[i]), 1e-12f)); bb[i] = av[i] * kk[i]; run += lw2[i]; cl[i] = run; }
        LDS_WAIT(); asm volatile("" ::: "memory");
        LAS unsigned short* okap = (LAS unsigned short*)(pw + PW_KAP); LAS unsigned short* orh = (LAS unsigned short*)(pw + PW_RH);
        LAS unsigned short* obh = (LAS unsigned short*)(pw + PW_BH); LAS unsigned short* okh = (LAS unsigned short*)(pw + PW_KH);
        const float cl15 = cl[15];
#pragma unroll
        for (int g = 0; g < 4; ++g) { float kd[4], nbd[4];
#pragma unroll
            for (int u = 0; u < 4; ++u) { const int i = 4 * g + u;
                const float e = __builtin_amdgcn_exp2f(cl[i]), em1 = (i == 0) ? 1.f : __builtin_amdgcn_exp2f(cl[i - 1]), inv = __builtin_amdgcn_exp2f(-cl[i]), eL = __builtin_amdgcn_exp2f(cl15 - cl[i]);
                kap[i] = kk[i] * em1; const float rh = rr[i] * e, kh = kt[i] * inv, bh = bb[i] * inv; kd[u] = kt[i] * eL; nbd[u] = -bb[i] * eL;
                okap[i * PWS + lane] = (unsigned short)(cvtpk(kap[i], 0.f) & 0xffffu); orh[i * PWS + lane] = (unsigned short)(cvtpk(rh, 0.f) & 0xffffu); obh[i * PWS + lane] = (unsigned short)(cvtpk(bh, 0.f) & 0xffffu); okh[i * PWS + lane] = (unsigned short)(cvtpk(kh, 0.f) & 0xffffu); }
            v4u o; o.x = cvtpk(nbd[0], nbd[1]); o.y = cvtpk(nbd[2], nbd[3]); o.z = cvtpk(kd[0], kd[1]); o.w = cvtpk(kd[2], kd[3]);
            *(GAS v4u*)(rec + REC_BK + (lane >> 4) * 1024 + (g * 16 + (lane & 15)) * 16) = o; }
        }
        *(GAS float*)(rec + REC_G + ((((lane >> 2) & 3) * 4 + (lane >> 4)) * 4 + (lane & 3)) * 4) = __builtin_amdgcn_exp2f(cl[15]);
        LDS_WAIT(); asm volatile("" ::: "memory");
        f32x4_ sab = {0.f, 0.f, 0.f, 0.f}, sak = sab, srb = sab, srk = sab;
#pragma unroll
        for (int ks = 0; ks < 2; ++ks) { const int off = (fi * PWS + ks * 32 + fg * 8) * 2;
            const bf16x8 fk = *(const LAS bf16x8*)(pw + PW_KAP + off), fr_ = *(const LAS bf16x8*)(pw + PW_RH + off), fb = *(const LAS bf16x8*)(pw + PW_BH + off), fh = *(const LAS bf16x8*)(pw + PW_KH + off);
            sab = __builtin_amdgcn_mfma_f32_16x16x32_bf16(fk, fb, sab, 0, 0, 0); sak = __builtin_amdgcn_mfma_f32_16x16x32_bf16(fk, fh, sak, 0, 0, 0);
            srb = __builtin_amdgcn_mfma_f32_16x16x32_bf16(fr_, fb, srb, 0, 0, 0); srk = __builtin_amdgcn_mfma_f32_16x16x32_bf16(fr_, fh, srk, 0, 0, 0); }
        LAS float* Aab = (LAS float*)(pw + PW_AAB); LAS float* Aak = (LAS float*)(pw + PW_AAK); LAS float* Tm = (LAS float*)(pw + PW_TM);
        LAS unsigned short* arimg = (LAS unsigned short*)(pw + PW_BH);
        asm volatile("" ::: "memory");
#pragma unroll
        for (int j = 0; j < 4; ++j) { const int i = 4 * fg + j;
            Aab[i * 20 + fi] = (fi < i) ? sab[j] : 0.f; Aak[i * 20 + fi] = (fi < i) ? sak[j] : 0.f;
            const float nrb = (fi <= i) ? -srb[j] : 0.f, rk = (fi <= i) ? srk[j] : 0.f; const unsigned pk = cvtpk(nrb, rk);
            arimg[((fi >> 2) * 16 + i) * 8 + (fi & 3)] = (unsigned short)(pk & 0xffffu); arimg[((fi >> 2) * 16 + i) * 8 + 4 + (fi & 3)] = (unsigned short)(pk >> 16); }
        LDS_WAIT(); asm volatile("" ::: "memory");
        *(GAS v4u*)(rec + REC_AR + lane * 16) = *(const LAS v4u*)(pw + PW_BH + lane * 16);
        float tc[16];
#pragma unroll
        for (int i = 0; i < 16; ++i) { float acc = (i == fi) ? 1.f : 0.f;
#pragma unroll
            for (int j4 = 0; j4 < i; j4 += 4) { const f32x4_ ar_ = *(const LAS f32x4_*)(Aab + i * 20 + j4);
#pragma unroll
                for (int u = 0; u < 4; ++u) if (j4 + u < i) acc -= ar_[u] * tc[j4 + u]; }
            tc[i] = acc; }
        if (fg == 0) {
#pragma unroll
            for (int i = 0; i < 16; ++i) Tm[i * 20 + fi] = tc[i]; }
        LDS_WAIT(); asm volatile("" ::: "memory");
        { LAS unsigned short* okap = (LAS unsigned short*)(pw + PW_KAP);
#pragma unroll
        for (int i = 0; i < 16; ++i) { float acc = 0.f;
#pragma unroll
            for (int j4 = 0; j4 <= i; j4 += 4) { const f32x4_ tr_ = *(const LAS f32x4_*)(Tm + i * 20 + j4);
#pragma unroll
                for (int u = 0; u < 4; ++u) if (j4 + u <= i) acc += tr_[u] * kap[j4 + u]; }
            okap[i * PWS + lane] = (unsigned short)(cvtpk(acc, 0.f) & 0xffffu); } }
        { const int i = lane >> 2, q = lane & 3; f32x4_ acc = {0.f, 0.f, 0.f, 0.f};
#pragma unroll
          for (int j4 = 0; j4 < 16; j4 += 4) { const f32x4_ tr_ = *(const LAS f32x4_*)(Tm + i * 20 + j4);
#pragma unroll
              for (int u = 0; u < 4; ++u) acc += tr_[u] * *(const LAS f32x4_*)(Aak + (j4 + u) * 20 + 4 * q); }
          *(GAS unsigned long long*)(rec + REC_MAK + (q * 16 + i) * 8) = (unsigned long long)cvtpk(acc[0], acc[1]) | ((unsigned long long)cvtpk(acc[2], acc[3]) << 32); }
        LDS_WAIT(); asm volatile("" ::: "memory");
#pragma unroll
        for (int ks = 0; ks < 2; ++ks) { const int off = (fi * PWS + ks * 32 + 4 * fg) * 2;
            const unsigned long long w0_ = *(const LAS unsigned long long*)(pw + PW_KAP + off), w1_ = *(const LAS unsigned long long*)(pw + PW_KAP + off + 32);
            const unsigned long long r0_ = *(const LAS unsigned long long*)(pw + PW_RH + off), r1_ = *(const LAS unsigned long long*)(pw + PW_RH + off + 32);
            v4u o; o.x = (unsigned)w0_; o.y = (unsigned)(w0_ >> 32); o.z = (unsigned)w1_; o.w = (unsigned)(w1_ >> 32);
            *(GAS v4u*)(rec + REC_WA + ks * 1024 + lane * 16) = o;
            o.x = (unsigned)r0_; o.y = (unsigned)(r0_ >> 32); o.z = (unsigned)r1_; o.w = (unsigned)(r1_ >> 32);
            *(GAS v4u*)(rec + REC_RA + ks * 1024 + lane * 16) = o; }
        LDS_WAIT(); asm volatile("" ::: "memory");
    }
}
constexpr int SCAN_NS = 8;
__device__ __forceinline__ void p4_scan(Frame& F) {
    typedef float f32x4_ __attribute__((ext_vector_type(4)));
    const int si = (int)blockIdx.x;
    if (si >= BATCH * RW_H) return;
    const int b = si / RW_H, h = si % RW_H, lane = F.lane, w = F.wave;
    const unsigned lds0 = (unsigned)(uintptr_t)(F.lds + RING_OFF);
    if (w >= 4) {
        const int lw = w - 4;
#define SCAN_ISSUE(n) do { const int n_ = (n) < NCHUNK ? (n) : NCHUNK - 1; const unsigned char* rp = rec_ptr(F.ws, b, h, n_); const unsigned sb = lds0 + (unsigned)(((n) % SCAN_NS) * REC_BYTES); \
            glds16f(rp + lw * 1024 + lane * 16, (unsigned)__builtin_amdgcn_readfirstlane(sb + lw * 1024)); glds16f(rp + (lw + 4) * 1024 + lane * 16, (unsigned)__builtin_amdgcn_readfirstlane(sb + (lw + 4) * 1024)); \
            if (lw < 3) { glds16f(rp + (lw + 8) * 1024 + lane * 16, (unsigned)__builtin_amdgcn_readfirstlane(sb + (lw + 8) * 1024)); glds4f(rp + 11264 + lw * 256 + lane * 4, (unsigned)__builtin_amdgcn_readfirstlane(sb + 11264 + lw * 256)); } } while (0)
        for (int n = 0; n < SCAN_NS - 1; ++n) SCAN_ISSUE(n);
        for (int n = 0; n < NCHUNK; ++n) {
            if (lw < 3) asm volatile("s_waitcnt vmcnt(24)" ::: "memory"); else asm volatile("s_waitcnt vmcnt(12)" ::: "memory");
            __builtin_amdgcn_s_barrier(); asm volatile("" ::: "memory");
            SCAN_ISSUE(n + SCAN_NS - 1);
        }
        asm volatile("s_waitcnt vmcnt(0)" ::: "memory");
        __builtin_amdgcn_s_barrier();
#undef SCAN_ISSUE
        return;
    }
    bf16* Orw = (bf16*)(F.ws + WS_ORW);
    const int fc = lane & 15, fg = lane >> 4;
    f32x4_ H[4];
#pragma unroll
    for (int mt = 0; mt < 4; ++mt) H[mt] = (f32x4_){0.f, 0.f, 0.f, 0.f};
    bf16x8 hb0 = {0, 0, 0, 0, 0, 0, 0, 0}, hb1 = hb0;
    bf16* orow = Orw + ((size_t)b * T + 4 * fg) * 512 + h * 64 + 16 * w + fc;
    for (int n = 0; n < NCHUNK; ++n) {
        LDS_WAIT(); __builtin_amdgcn_s_barrier(); asm volatile("" ::: "memory");
        const LAS unsigned char* sb = F.lds + RING_OFF + (n % SCAN_NS) * REC_BYTES;
        typedef unsigned u32x2_ __attribute__((ext_vector_type(2)));
        const bf16x8 wa0 = *(const LAS bf16x8*)(sb + REC_WA + lane * 16), wa1 = *(const LAS bf16x8*)(sb + REC_WA + 1024 + lane * 16);
        const u32x2_ mk = *(const LAS u32x2_*)(sb + REC_MAK + lane * 8);
        const bf16x8 ra0 = *(const LAS bf16x8*)(sb + REC_RA + lane * 16), ra1 = *(const LAS bf16x8*)(sb + REC_RA + 1024 + lane * 16), ar = *(const LAS bf16x8*)(sb + REC_AR + lane * 16);
        bf16x8 bk[4]; f32x4_ gm[4];
#pragma unroll
        for (int mt = 0; mt < 4; ++mt) { bk[mt] = *(const LAS bf16x8*)(sb + REC_BK + mt * 1024 + lane * 16); gm[mt] = *(const LAS f32x4_*)(sb + REC_G + fg * 64 + mt * 16); }
        const u32x2_ vt = *(const LAS u32x2_*)(sb + REC_VT + w * 512 + lane * 8);
        const bf16x8 vz = __builtin_bit_cast(bf16x8, (v4u){0u, 0u, vt.x, vt.y}), mak = __builtin_bit_cast(bf16x8, (v4u){0u, 0u, mk.x, mk.y});
        f32x4_ U = {0.f, 0.f, 0.f, 0.f}, O = {0.f, 0.f, 0.f, 0.f};
        U = __builtin_amdgcn_mfma_f32_16x16x32_bf16(wa0, hb0, U, 0, 0, 0);
        U = __builtin_amdgcn_mfma_f32_16x16x32_bf16(wa1, hb1, U, 0, 0, 0);
        U = __builtin_amdgcn_mfma_f32_16x16x32_bf16(mak, vz, U, 0, 0, 0);
        O = __builtin_amdgcn_mfma_f32_16x16x32_bf16(ra0, hb0, O, 0, 0, 0);
        O = __builtin_amdgcn_mfma_f32_16x16x32_bf16(ra1, hb1, O, 0, 0, 0);
#pragma unroll
        for (int mt = 0; mt < 4; ++mt) H[mt] = H[mt] * gm[mt];
        const bf16x8 uv = __builtin_bit_cast(bf16x8, (v4u){cvtpk(U[0], U[1]), cvtpk(U[2], U[3]), vt.x, vt.y});
#pragma unroll
        for (int mt = 0; mt < 4; ++mt) H[mt] = __builtin_amdgcn_mfma_f32_16x16x32_bf16(bk[mt], uv, H[mt], 0, 0, 0);
        O = __builtin_amdgcn_mfma_f32_16x16x32_bf16(ar, uv, O, 0, 0, 0);
        hb0 = __builtin_bit_cast(bf16x8, (v4u){cvtpk(H[0][0], H[0][1]), cvtpk(H[0][2], H[0][3]), cvtpk(H[1][0], H[1][1]), cvtpk(H[1][2], H[1][3])});
        hb1 = __builtin_bit_cast(bf16x8, (v4u){cvtpk(H[2][0], H[2][1]), cvtpk(H[2][2], H[2][3]), cvtpk(H[3][0], H[3][1]), cvtpk(H[3][2], H[3][3])});
        bf16* op = orow + (size_t)n * 16 * 512;
#pragma unroll
        for (int j = 0; j < 4; ++j) op[(size_t)j * 512] = (bf16)(cvtpk(O[j], 0.f) & 0xffffu);
    }
    LDS_WAIT(); __builtin_amdgcn_s_barrier();
}
__device__ __forceinline__ void p6_assemble(Frame& F) {
    const int gw = F.vcu * NWAVES + F.wave, NGW = F.G * NWAVES;
    const bf16* Orw = (const bf16*)(F.ws + WS_ORW); const bf16* Uvg = (const bf16*)(F.ws + WS_UVG); const bf16* Uqg = (const bf16*)(F.ws + WS_UQG); const bf16* O0 = (const bf16*)(F.ws + WS_URK); const bf16* O1 = O0 + 512;
    const float* BON = (const float*)(F.ws + WS_BONUS); bf16* Y = (bf16*)(F.ws + WS_Y);
    const float lam = __expf(wave_sum(F.in[I_LQ1][F.lane] * F.in[I_LK1][F.lane])) - __expf(wave_sum(F.in[I_LQ2][F.lane] * F.in[I_LK2][F.lane])) + LAMBDA_INIT;
    const int c0 = 8 * F.lane;
    float lw[8], lb[8], muv[8], sw[8];
#pragma unroll
    for (int i = 0; i < 8; ++i) { lw[i] = F.in[I_LNW][c0 + i]; lb[i] = F.in[I_LNB][c0 + i]; muv[i] = F.in[I_MU][1024 + c0 + i]; sw[i] = F.in[I_SUBLN][(c0 + i) & 127] * (1.f - LAMBDA_INIT); }
    for (int m = gw; m < M; m += NGW) {
        const bool first = (m % T == 0);
        const v4u ow = *(const GAS v4u*)(Orw + (size_t)m * 512 + c0), vw = *(const GAS v4u*)(Uvg + (size_t)m * UP + c0), gw_ = *(const GAS v4u*)(Uvg + (size_t)m * UP + 512 + c0);
        v4u pw = {0u, 0u, 0u, 0u}; if (!first) pw = *(const GAS v4u*)(Uvg + (size_t)(m - 1) * UP + c0);
        float o[8], v[8], g[8];
#pragma unroll
        for (int i = 0; i < 4; ++i) { o[2 * i] = bflo(ow[i]); o[2 * i + 1] = bfhi(ow[i]); g[2 * i] = bflo(gw_[i]); g[2 * i + 1] = bfhi(gw_[i]);
            v[2 * i] = tshift(bflo(vw[i]), bflo(pw[i]), muv[2 * i]); v[2 * i + 1] = tshift(bfhi(vw[i]), bfhi(pw[i]), muv[2 * i + 1]); }
        float s = 0.f;
#pragma unroll
        for (int i = 0; i < 8; ++i) s += o[i];
        s += __shfl_xor(s, 1); s += __shfl_xor(s, 2); s += __shfl_xor(s, 4);
        const float mean = s * (1.f / 64.f); float q = 0.f;
#pragma unroll
        for (int i = 0; i < 8; ++i) { o[i] -= mean; q += o[i] * o[i]; }
        q += __shfl_xor(q, 1); q += __shfl_xor(q, 2); q += __shfl_xor(q, 4);
        const float rstd = 1.f / sqrtf(q * (1.f / 64.f) + GN_EPS), bon = BON[m * 8 + (F.lane >> 3)];
        float y[8];
#pragma unroll
        for (int i = 0; i < 8; ++i) y[i] = (o[i] * rstd * lw[i] + lb[i] + bon * v[i]) * siluf_(g[i]);
        v4u yo; yo.x = pk2(y[0], y[1]); yo.y = pk2(y[2], y[3]); yo.z = pk2(y[4], y[5]); yo.w = pk2(y[6], y[7]);
        *(GAS v4u*)(Y + (size_t)m * D + c0) = yo;
        const v4u a0 = *(const GAS v4u*)(O0 + (size_t)m * 1024 + c0), a1 = *(const GAS v4u*)(O1 + (size_t)m * 1024 + c0), dgw = *(const GAS v4u*)(Uqg + (size_t)m * 1024 + 512 + c0);
        float d[8]; float ms = 0.f;
#pragma unroll
        for (int i = 0; i < 4; ++i) { d[2 * i] = bflo(a0[i]) - lam * bflo(a1[i]); d[2 * i + 1] = bfhi(a0[i]) - lam * bfhi(a1[i]); g[2 * i] = bflo(dgw[i]); g[2 * i + 1] = bfhi(dgw[i]); }
#pragma unroll
        for (int i = 0; i < 8; ++i) ms += d[i] * d[i];
        ms += __shfl_xor(ms, 1); ms += __shfl_xor(ms, 2); ms += __shfl_xor(ms, 4); ms += __shfl_xor(ms, 8);
        const float rs = 1.f / sqrtf(ms * (1.f / 128.f) + SUBLN_EPS);
#pragma unroll
        for (int i = 0; i < 8; ++i) y[i] = d[i] * rs * sw[i] * siluf_(g[i]);
        yo.x = pk2(y[0], y[1]); yo.y = pk2(y[2], y[3]); yo.z = pk2(y[4], y[5]); yo.w = pk2(y[6], y[7]);
        *(GAS v4u*)(Y + (size_t)m * D + 512 + c0) = yo;
    }
}
__device__ __forceinline__ void p67_fused(Frame& F) {
    typedef float f32x4_ __attribute__((ext_vector_type(4)));
    const bf16* Orw = (const bf16*)(F.ws + WS_ORW); const bf16* Uvg = (const bf16*)(F.ws + WS_UVG); const bf16* Uqg = (const bf16*)(F.ws + WS_UQG); const bf16* O0 = (const bf16*)(F.ws + WS_URK); const bf16* O1 = O0 + 512;
    const float* BON = (const float*)(F.ws + WS_BONUS); const unsigned char* Wimg = (const unsigned char*)(F.ws + WS_WOUT);
    const float* x = F.in[I_X]; const float* gpost = F.in[I_GPOST]; const float* mod = (const float*)(F.ws + WS_MOD);
    const int lane = F.lane, w = F.wave, fr = lane & 15, fq = lane >> 4;
    const float lam = __expf(wave_sum(F.in[I_LQ1][lane] * F.in[I_LK1][lane])) - __expf(wave_sum(F.in[I_LQ2][lane] * F.in[I_LK2][lane])) + LAMBDA_INIT;
    LAS unsigned char* A = F.lds + RING_OFF;
    {
        const int unit = F.vcu; const int r0 = unit * 64, bb = r0 / T;
        {
            const int c0 = 8 * lane;
            float lw[8], lb[8], muv[8], sw[8];
#pragma unroll
            for (int i = 0; i < 8; ++i) { lw[i] = F.in[I_LNW][c0 + i]; lb[i] = F.in[I_LNB][c0 + i]; muv[i] = F.in[I_MU][1024 + c0 + i]; sw[i] = F.in[I_SUBLN][(c0 + i) & 127] * (1.f - LAMBDA_INIT); }
            LAS unsigned char* arow = A + ((lane >> 2) * 4 + (w >> 1)) * 1024 + ((lane & 3) * 16 + 8 * (w & 1)) * 16;
#pragma unroll 2
            for (int j = 0; j < 8; ++j) { const int m = r0 + 8 * w + j; const bool first = (m % T == 0);
                const v4u ow = *(const GAS v4u*)(Orw + (size_t)m * 512 + c0), vw = *(const GAS v4u*)(Uvg + (size_t)m * UP + c0), gw_ = *(const GAS v4u*)(Uvg + (size_t)m * UP + 512 + c0);
                v4u pw = {0u, 0u, 0u, 0u}; if (!first) pw = *(const GAS v4u*)(Uvg + (size_t)(m - 1) * UP + c0);
                const v4u a0 = *(const GAS v4u*)(O0 + (size_t)m * 1024 + c0), a1 = *(const GAS v4u*)(O1 + (size_t)m * 1024 + c0), dgw = *(const GAS v4u*)(Uqg + (size_t)m * 1024 + 512 + c0);
                const float bon = BON[m * 8 + (lane >> 3)];
                float o[8], v[8], g[8];
#pragma unroll
                for (int i = 0; i < 4; ++i) { o[2 * i] = bflo(ow[i]); o[2 * i + 1] = bfhi(ow[i]); g[2 * i] = bflo(gw_[i]); g[2 * i + 1] = bfhi(gw_[i]);
                    v[2 * i] = tshift(bflo(vw[i]), bflo(pw[i]), muv[2 * i]); v[2 * i + 1] = tshift(bfhi(vw[i]), bfhi(pw[i]), muv[2 * i + 1]); }
                float s = 0.f;
#pragma unroll
                for (int i = 0; i < 8; ++i) s += o[i];
                s += __shfl_xor(s, 1); s += __shfl_xor(s, 2); s += __shfl_xor(s, 4);
                const float mean = s * (1.f / 64.f); float q = 0.f;
#pragma unroll
                for (int i = 0; i < 8; ++i) { o[i] -= mean; q += o[i] * o[i]; }
                q += __shfl_xor(q, 1); q += __shfl_xor(q, 2); q += __shfl_xor(q, 4);
                const float rstd = 1.f / sqrtf(q * (1.f / 64.f) + GN_EPS);
                float y[8];
#pragma unroll
                for (int i = 0; i < 8; ++i) y[i] = (o[i] * rstd * lw[i] + lb[i] + bon * v[i]) * siluf_(g[i]);
                *(LAS v4u*)(arow + j * 16) = (v4u){cvtpk(y[0], y[1]), cvtpk(y[2], y[3]), cvtpk(y[4], y[5]), cvtpk(y[6], y[7])};
                float d[8]; float ms = 0.f;
#pragma unroll
                for (int i = 0; i < 4; ++i) { d[2 * i] = bflo(a0[i]) - lam * bflo(a1[i]); d[2 * i + 1] = bfhi(a0[i]) - lam * bfhi(a1[i]); g[2 * i] = bflo(dgw[i]); g[2 * i + 1] = bfhi(dgw[i]); }
#pragma unroll
                for (int i = 0; i < 8; ++i) ms += d[i] * d[i];
                ms += __shfl_xor(ms, 1); ms += __shfl_xor(ms, 2); ms += __shfl_xor(ms, 4); ms += __shfl_xor(ms, 8);
                const float rs = 1.f / sqrtf(ms * (1.f / 128.f) + SUBLN_EPS);
#pragma unroll
                for (int i = 0; i < 8; ++i) y[i] = d[i] * rs * sw[i] * siluf_(g[i]);
                *(LAS v4u*)(arow + 65536 + j * 16) = (v4u){cvtpk(y[0], y[1]), cvtpk(y[2], y[3]), cvtpk(y[4], y[5]), cvtpk(y[6], y[7])}; }
        }
        __syncthreads();
        f32x4_ acc[4][8];
#pragma unroll
        for (int rt = 0; rt < 4; ++rt)
#pragma unroll
            for (int nt = 0; nt < 8; ++nt) acc[rt][nt] = (f32x4_){0.f, 0.f, 0.f, 0.f};
        const unsigned char* bp = Wimg + ((size_t)(8 * w) * 32 * 64 + lane) * 16;
        bf16x8 b0_[8], b1_[8];
#pragma unroll
        for (int nt = 0; nt < 8; ++nt) b0_[nt] = *(const bf16x8*)(bp + nt * 32768);
#define P67_STEP(BC, BN, ks_) do { \
            if ((ks_) + 1 < 32) { _Pragma("unroll") for (int nt = 0; nt < 8; ++nt) BN[nt] = *(const bf16x8*)(bp + nt * 32768 + ((ks_) + 1) * 1024); } \
            bf16x8 af[4]; _Pragma("unroll") for (int rt = 0; rt < 4; ++rt) af[rt] = *(const LAS bf16x8*)(A + ((ks_) * 4 + rt) * 1024 + lane * 16); \
            _Pragma("unroll") for (int nt = 0; nt < 8; ++nt) _Pragma("unroll") for (int rt = 0; rt < 4; ++rt) acc[rt][nt] = __builtin_amdgcn_mfma_f32_16x16x32_bf16(BC[nt], af[rt], acc[rt][nt], 0, 0, 0); } while (0)
        for (int ks = 0; ks < 32; ks += 2) { P67_STEP(b0_, b1_, ks); P67_STEP(b1_, b0_, ks + 1); }
#undef P67_STEP
        float ss[4];
#pragma unroll
        for (int rt = 0; rt < 4; ++rt) { float s_ = 0.f;
#pragma unroll
            for (int nt = 0; nt < 8; ++nt) { const f32x4_ a_ = acc[rt][nt]; s_ += (a_[0] * a_[0] + a_[1] * a_[1]) + (a_[2] * a_[2] + a_[3] * a_[3]); }
            s_ += __shfl_xor(s_, 16); s_ += __shfl_xor(s_, 32); ss[rt] = s_; }
        __syncthreads();
        LAS float* P = (LAS float*)A;
        if (fq == 0) {
#pragma unroll
            for (int rt = 0; rt < 4; ++rt) P[(rt * 16 + fr) * 8 + w] = ss[rt]; }
        __syncthreads();
        const float* grow = mod + (size_t)bb * 3072 + 2048;
#pragma unroll
        for (int rt = 0; rt < 4; ++rt) { const int row = rt * 16 + fr; const f32x4_ p0_ = *(const LAS f32x4_*)(P + row * 8), p1_ = *(const LAS f32x4_*)(P + row * 8 + 4);
            const float rstd = 1.f / sqrtf(((p0_[0] + p0_[1]) + (p0_[2] + p0_[3]) + (p1_[0] + p1_[1]) + (p1_[2] + p1_[3])) * (1.f / D) + RMS_EPS);
            const size_t off = (size_t)(r0 + row) * D + 128 * w + 4 * fq;
#pragma unroll
            for (int hh = 0; hh < 2; ++hh) { f32x4_ xv[4];
#pragma unroll
                for (int n4 = 0; n4 < 4; ++n4) xv[n4] = *(const f32x4_*)(x + off + 16 * (4 * hh + n4));
#pragma unroll
                for (int n4 = 0; n4 < 4; ++n4) { const int nt = 4 * hh + n4, col = 128 * w + 16 * nt + 4 * fq; const f32x4_ cf = *(const f32x4_*)(grow + col) * *(const f32x4_*)(gpost + col);
                    *(f32x4_*)(F.out + off + 16 * nt) = xv[n4] + acc[rt][nt] * rstd * cf; } } }
        __syncthreads();
    }
}
__device__ __forceinline__ void nan_rows_f32(Frame& F, float* out) {
    const int gw = F.vcu * NWAVES + F.wave, NGW = F.G * NWAVES; const float q = __builtin_nanf("");
    for (int m = gw; m < M; m += NGW) { GAS f32x4* o = (GAS f32x4*)(out + (size_t)m * D) + F.lane;
#pragma unroll
        for (int j = 0; j < 4; ++j) o[64 * j] = (f32x4){q, q, q, q}; }
}
__device__ __forceinline__ void wrong_grid_word(Frame& F) {
    if (blockIdx.x == 0 && F.tid == 0) { unsigned expect = 0u; __hip_atomic_compare_exchange_strong((unsigned*)(F.ctl + CW_CODE), &expect, 0x7f0u, __ATOMIC_RELAXED, __ATOMIC_RELAXED, __HIP_MEMORY_SCOPE_AGENT);
        __hip_atomic_store(F.ctl + CW_TMO, 1u, RLX_AGENT); }
}

struct Args { const float* in[23]; float* out; unsigned char* ws; int ph_lo, ph_hi, li, pad; };
__global__ void __launch_bounds__(NWAVES * 64, 2) skel_fwd(Args args) {
    extern __shared__ __attribute__((aligned(16))) unsigned char lds[];
    Frame F;
    F.lds = (LAS unsigned char*)lds;
    F.MISC = (volatile LAS unsigned*)(F.lds + MISC_OFF);
    F.tid = threadIdx.x; F.lane = F.tid & 63; F.wave = __builtin_amdgcn_readfirstlane(F.tid >> 6);
    F.G = gridDim.x; { const int bx = blockIdx.x; F.vcu = (F.G % 8 == 0) ? (bx % 8) * (F.G / 8) + bx / 8 : bx; }
#define GRID_BAR(seam) do { if (N_LAUNCHES == PER_PHASE) { if (F.tid == 0) __hip_atomic_store(F.ctl + CW_TMO, 0xBADBA0u | (unsigned)(seam), RLX_AGENT); } \
    else { xcd_barrier(bar); } } while (0)
    unsigned char* ws = args.ws; F.ws = ws;
    F.ctl = (gu32*)(ws + WS_CTL);
#pragma unroll
    for (int i = 0; i < 23; ++i) F.in[i] = args.in[i];
    F.out = args.out;
    for (int u = F.tid; u < (LDS_BYTES - LDSCTL_OFF) / 4; u += NWAVES * 64) ((LAS unsigned*)(F.lds + LDSCTL_OFF))[u] = 0u;
    __syncthreads();
    XcdBarrier bar; bar.bar = (unsigned*)(F.ctl + CW_BAR); bar.x = 0; bar.st = nullptr;
    if (N_LAUNCHES != PER_PHASE) bar = xcd_barrier_post((unsigned*)(F.ctl + CW_BAR), F.MISC + 8);

    const int lo = args.ph_lo, hi = args.ph_hi;
#define IN(k) (lo <= (k) && (k) < hi)
#define BOTH(k) (IN(k) && IN((k) + 1))

#ifndef PROBE_PHASE
#define PROBE_PHASE -1
#endif
#ifndef PROBE_REPS
#define PROBE_REPS 2
#endif
#define REPS(k) ((k) == PROBE_PHASE ? PROBE_REPS : 1)
    if (IN(0)) { for (int rep = 0; rep < REPS(0); ++rep) p0_prologue(F); if (BOTH(0)) GRID_BAR(0); }
    if (IN(1)) { for (int rep = 0; rep < REPS(1); ++rep) p1_rows(F); if (BOTH(1)) GRID_BAR(1); }
    if (PROBE_PHASE == 9) { for (int rep = 0; rep < 16; ++rep) GRID_BAR(9); }
    if (IN(2)) {
        pg8::Gemm g{(const pg8::bf16_t*)(ws + WS_XN), (const pg8::bf16_t*)(ws + WS_WIN), M, NMAIN, D}; pg8::StaticOrder S; S.init(M, NMAIN, F.G, (int)blockIdx.x);
        pg8::EpiU E{(pg8::bf16_t*)(ws + WS_URK), (pg8::bf16_t*)(ws + WS_UVG), (pg8::bf16_t*)(ws + WS_UQG), (pg8::bf16_t*)(ws + WS_KIMG), (pg8::bf16_t*)(ws + WS_VIMG), attn_body::C2, T};
        for (int rep = 0; rep < REPS(2); ++rep) pg8::gemm_phase<pg8::EpiU, pg8::StaticOrder, PG8_ALIGN, PG8_SP2>(F.lds + RING_OFF, g, S, E);
        for (int rep = 0; rep < REPS(8); ++rep) p2_lora(F);
        if (BOTH(2)) GRID_BAR(2);
    }
    if (IN(3)) { for (int rep = 0; rep < REPS(3); ++rep) p3_prep(F); if (BOTH(3)) GRID_BAR(3); }
    if (IN(4)) {
        for (int rep = 0; rep < REPS(4); ++rep) p4_scan(F);
        const attn_body::AttnTensors AT{(const attn_body::bf16*)(ws + WS_UQG), (const attn_body::bf16*)(ws + WS_KIMG), (const attn_body::bf16*)(ws + WS_VIMG), (attn_body::bf16*)(ws + WS_URK), (attn_body::bf16*)(ws + WS_URK) + 512};
        if (F.G == 256) attn_body::attn_phase_queue((char*)lds + RING_OFF, AT, (unsigned*)(F.ctl + CW_QUEUE + 64 * ((int)blockIdx.x & 7)), (int)blockIdx.x & 7, F.MISC + 16);
        if (PROBE_PHASE == 5) { GRID_BAR(5); attn_body::attn_phase_queue((char*)lds + RING_OFF, AT, (unsigned*)(F.ctl + CW_QUEUE + 512 + 64 * ((int)blockIdx.x & 7)), (int)blockIdx.x & 7, F.MISC + 16); }
        if (BOTH(4)) GRID_BAR(4);
    }
    if (IN(6)) { }
    if (IN(7)) { if (F.G == 256) p67_fused(F); else { nan_rows_f32(F, F.out); wrong_grid_word(F); } }
#undef IN
#undef BOTH
}

extern "C" void kernel_launch(void* const* d_in, const int* in_sizes, int n_in, void* d_out, int out_size, void* d_ws, size_t ws_size, hipStream_t stream) {
    static int grid = 0;
    if (grid == 0) {
        if (n_in != 23 || in_sizes[0] != M * D || out_size != M * D || ws_size < WS_END) { fprintf(stderr, "kernel_launch: built for 23 inputs, x and out of %d floats, >= %zu bytes of workspace; got n_in %d, in0 %d, out %d, ws %zu; nothing launched\n", M * D, (size_t)WS_END, n_in, n_in > 0 ? in_sizes[0] : -1, out_size, ws_size); grid = -1; return; }
        int dev = 0, cus = 0, per_cu = 0;
        if (hipGetDevice(&dev) != hipSuccess || hipDeviceGetAttribute(&cus, hipDeviceAttributeMultiprocessorCount, dev) != hipSuccess) { fprintf(stderr, "kernel_launch: hipGetDevice / hipDeviceGetAttribute failed; nothing launched\n"); grid = -1; return; }
        if (hipFuncSetAttribute((const void*)skel_fwd, hipFuncAttributeMaxDynamicSharedMemorySize, LDS_BYTES) != hipSuccess) { fprintf(stderr, "kernel_launch: hipFuncSetAttribute failed\n"); grid = -1; return; }
        if (hipOccupancyMaxActiveBlocksPerMultiprocessor(&per_cu, (const void*)skel_fwd, NWAVES * 64, LDS_BYTES) != hipSuccess || per_cu < 1)
            fprintf(stderr, "kernel_launch: note: the occupancy query reports %d workgroups per CU\n", per_cu);
        (void)hipGetLastError();
        grid = cus;
        if (grid != 256) fprintf(stderr, "kernel_launch: launching %d workgroups; the fused phases need exactly 256\n", grid);
    }
    if (grid < 0) return;
    if (hipMemsetAsync((char*)d_ws + WS_CTL, 0, CTL_ZERO_BYTES, stream) != hipSuccess) { fprintf(stderr, "kernel_launch: hipMemsetAsync of the control words failed; nothing launched\n"); return; }
    Args a{};
    for (int i = 0; i < 23; ++i) a.in[i] = (const float*)d_in[i];
    a.out = (float*)d_out; a.ws = (unsigned char*)d_ws;
    for (int li = 0; li < N_LAUNCHES; ++li) {
        a.ph_lo = (N_LAUNCHES == PER_PHASE) ? li : 0; a.ph_hi = (N_LAUNCHES == PER_PHASE) ? li + 1 : PER_PHASE; a.li = li;
        hipLaunchKernelGGL(skel_fwd, dim3(grid), dim3(NWAVES * 64), LDS_BYTES, stream, a);
        const hipError_t le = hipPeekAtLastError();
        if (le != hipSuccess) { fprintf(stderr, "kernel_launch: launch %d failed: %s\n", li, hipGetErrorName(le)); break; }
    }
}
```

```cpp
#include <hip/hip_runtime.h>
#include <cstdio>
#include <cstdint>
namespace pg8 {
#define PG8_LAS __attribute__((address_space(3)))
typedef unsigned short bf16_t;
typedef short bf16x8 __attribute__((ext_vector_type(8)));
typedef float f32x4 __attribute__((ext_vector_type(4)));
typedef unsigned u32x4 __attribute__((ext_vector_type(4)));
constexpr int BM = 256, BK = 64, HALF = 128, HTB = HALF * BK * 2  , STAGE_BYTES = 8 * HTB, NXCD = 8, WGM = 8;

__host__ __device__ __forceinline__ int lds_byte(int r, int c) { const int st = (r >> 4) * 2 + (c >> 5), rr = r & 15, cc = c & 31, ob = rr * 64 + cc * 2; return st * 1024 + (ob ^ (((ob >> 9) & 1) << 5)); }
__host__ __device__ __forceinline__ void stage_rc(int b, int& R, int& C) { const int st = b / 1024, sb = b % 1024, swz = sb ^ (((sb >> 9) & 1) << 5); R = (st >> 1) * 16 + swz / 64; C = (st & 1) * 32 + (swz % 64) / 2; }
__host__ __device__ __forceinline__ int perm32(int rho) { const int n = rho >> 4, i = rho & 15; return 8 * (i >> 2) + 4 * n + (i & 3); }

struct Unit { int pm, pn; };
struct Gemm { const bf16_t* A; const bf16_t* Bt; int M, N, K; };

struct StaticOrder {
    int nM, nN, nwg, G, c;
    __host__ __device__ void init(int M, int N, int G_, int c_) { nM = M / BM; nN = N / BM; nwg = nM * nN; G = G_; c = c_; }
    __host__ __device__ bool next(int i, Unit& u) const {
        const long L = (long)i * G + c; if (L >= nwg) return false;
        int wgid = (int)L; { const int q = nwg / NXCD, r = nwg % NXCD, xcd = wgid % NXCD, off = wgid / NXCD; wgid = (xcd < r ? xcd * (q + 1) : r * (q + 1) + (xcd - r) * q) + off; }
        const int nig = WGM * nN, gid = wgid / nig, fm = gid * WGM, gsz = (nM - fm) < WGM ? (nM - fm) : WGM;
        u.pm = fm + ((wgid % nig) % gsz); u.pn = (wgid % nig) / gsz; return true;
    }
    __device__ __forceinline__ void a_ready(const Unit&) const {}
    __device__ __forceinline__ void done(const Unit&) const {}
};

__device__ __forceinline__ unsigned cvt_pk_bf16(float lo, float hi) { unsigned r; asm volatile("v_cvt_pk_bf16_f32 %0, %1, %2" : "=v"(r) : "v"(lo), "v"(hi)); return r; }
typedef float f32x2 __attribute__((ext_vector_type(2)));
struct EpiU {
    static constexpr bool PERM = true, AFTER_DRAIN = false;
    bf16_t* Urk; bf16_t* Uvg; bf16_t* Uqg; bf16_t* Kimg; bf16_t* Vimg; float qscale; int seq;
    __device__ __forceinline__ void operator()(const f32x4 (&acc)[2][2][4][2], const Unit& u, int wr, int wc, int fr, int fq) const {
        const int row0 = u.pm * BM + wr * 64 + fr;
        const float sc = (u.pn == 8 || u.pn == 9) ? qscale : 1.f;
        const bool img = (u.pn >= 10 && u.pn <= 13);
        bf16_t* base = (u.pn < 4) ? (Urk + u.pn * BM) : (u.pn < 8 ? (Uvg + (u.pn - 4) * BM) : (u.pn < 10 ? (Uqg + (u.pn - 8) * BM) : (Uqg + 512 + (u.pn - 14) * BM)));
        const int col0 = wc * 32 + 8 * fq;
#pragma unroll
        for (int ai = 0; ai < 2; ++ai)
#pragma unroll
            for (int m = 0; m < 4; ++m) { const int r = row0 + ai * HALF + m * 16; bf16_t* rowp = base + (size_t)r * 1024 + col0;
                const int bb = r / seq, t = r % seq;
#pragma unroll
                for (int bj = 0; bj < 2; ++bj) { f32x4 v0 = acc[ai][bj][m][0] * sc, v1 = acc[ai][bj][m][1] * sc;
                    u32x4 w; w.x = cvt_pk_bf16(v0[0], v0[1]); w.y = cvt_pk_bf16(v0[2], v0[3]); w.z = cvt_pk_bf16(v1[0], v1[1]); w.w = cvt_pk_bf16(v1[2], v1[3]);
                    if (!img) *(u32x4*)(rowp + bj * HALF) = w;
                    else if (u.pn < 12) { const int hh = 4 * (u.pn - 10) + 2 * bj + (wc >> 1), dch = 4 * (wc & 1) + fq;
                        *(u32x4*)((char*)Kimg + ((size_t)((bb * 8 + hh) * (seq / 64) + (t >> 6)) * 8192 + dch * 1024 + (t & 63) * 16)) = w; }
                    else { const int h = 2 * (u.pn - 12) + bj;
                        *(u32x4*)((char*)Vimg + ((size_t)((bb * 4 + h) * (seq / 64) + (t >> 6)) * 16384 + (wc * 4 + ((t & 63) >> 4)) * 1024 + ((t & 15) * 4 + fq) * 16)) = w; } } }
    }
};

struct PanelStats {
    unsigned* xbuf;
    unsigned* cnt;
    unsigned* tmo;
    int ntn; float eps;
    bool rms;
    unsigned code;
    __device__ __forceinline__ bool run(const f32x4 (&v)[2][2][4][2], const Unit& u, int wr, int wc, int fr, int fq, PG8_LAS unsigned char* lds, int wid, int lane) const {
        typedef float f32x2v __attribute__((ext_vector_type(2)));
        PG8_LAS f32x2v* P = (PG8_LAS f32x2v*)lds;
        PG8_LAS f32x2v* S = (PG8_LAS f32x2v*)(lds + 8192);
        PG8_LAS unsigned* flag = (PG8_LAS unsigned*)(lds + 8192 + 2048);
#pragma unroll
        for (int ai = 0; ai < 2; ++ai)
#pragma unroll
            for (int m = 0; m < 4; ++m) {
                float s = 0.f;
#pragma unroll
                for (int bj = 0; bj < 2; ++bj)
#pragma unroll
                    for (int n = 0; n < 2; ++n) { const f32x4 x = v[ai][bj][m][n]; s += (x[0] + x[1]) + (x[2] + x[3]); }
                s += __shfl_xor(s, 16); s += __shfl_xor(s, 32);
                const float mw = s * (1.0f / 64.0f); float q = 0.f;
#pragma unroll
                for (int bj = 0; bj < 2; ++bj)
#pragma unroll
                    for (int n = 0; n < 2; ++n) { const f32x4 d = v[ai][bj][m][n] - mw; q += (d[0] * d[0] + d[1] * d[1]) + (d[2] * d[2] + d[3] * d[3]); }
                q += __shfl_xor(q, 16); q += __shfl_xor(q, 32);
                if (fq == 0) P[(ai * HALF + wr * 64 + m * 16 + fr) * 4 + wc] = (f32x2v){mw, q};
            }
        asm volatile("s_waitcnt lgkmcnt(0)" ::: "memory"); __builtin_amdgcn_s_barrier(); asm volatile("" ::: "memory");
#if defined(BROKEN_EXCHANGE_NO_WAIT)
#warning BROKEN CONTROL BUILD: the row-statistics exchange does not wait; results are wrong by design
        if (blockIdx.x >= 64) { const long long t0_ = clock64(); while (clock64() - t0_ < 60000) __builtin_amdgcn_s_sleep(8); }
#endif
        const int row = wid * 32 + (lane & 31);
        if (lane < 32) {
            const f32x2v a = P[row * 4 + 0], b = P[row * 4 + 1], c = P[row * 4 + 2], d = P[row * 4 + 3];
            const float mt = (a.x + b.x + c.x + d.x) * 0.25f;
            const float da = a.x - mt, db = b.x - mt, dc = c.x - mt, dd = d.x - mt;
            const float m2 = (a.y + b.y) + (c.y + d.y) + 64.0f * ((da * da + db * db) + (dc * dc + dd * dd));
            unsigned long long* slot = (unsigned long long*)xbuf + ((size_t)(u.pm * BM + row) * 4 + u.pn);
            __hip_atomic_store(slot, ((unsigned long long)__float_as_uint(m2) << 32) | __float_as_uint(mt), __ATOMIC_RELAXED, __HIP_MEMORY_SCOPE_AGENT);
        }
        asm volatile("s_waitcnt vmcnt(0)" ::: "memory");
        if (lane == 0) __hip_atomic_fetch_add(cnt + 64 * u.pm, 1u, __ATOMIC_RELAXED, __HIP_MEMORY_SCOPE_AGENT);
        if (wid == 0) {
            bool dead = false; const unsigned long long t0 = __builtin_amdgcn_s_memrealtime(); const unsigned want = 8u * (unsigned)ntn;
            for (;;) {
#if defined(BROKEN_EXCHANGE_NO_WAIT)
                break;
#endif
                if ((unsigned)__builtin_amdgcn_readfirstlane(__hip_atomic_load(cnt + 64 * u.pm, __ATOMIC_RELAXED, __HIP_MEMORY_SCOPE_AGENT)) >= want) break;
                if (__builtin_amdgcn_s_memrealtime() - t0 > 2000000ull) {
                    if (lane == 0) { unsigned expect = 0u; __hip_atomic_compare_exchange_strong(tmo + 1, &expect, code | (unsigned)(u.pm & 0xff), __ATOMIC_RELAXED, __ATOMIC_RELAXED, __HIP_MEMORY_SCOPE_AGENT);
                                     __hip_atomic_store(tmo, 1u, __ATOMIC_RELAXED, __HIP_MEMORY_SCOPE_AGENT); }
                    dead = true; break; }
                __builtin_amdgcn_s_sleep(2);
            }
            __builtin_amdgcn_fence(__ATOMIC_ACQUIRE, "agent");
            if (lane == 0) flag[0] = dead ? 1u : 0u;
        }
        asm volatile("s_waitcnt vmcnt(0) lgkmcnt(0)" ::: "memory"); __builtin_amdgcn_s_barrier(); asm volatile("" ::: "memory");
        const bool bad = flag[0] != 0u;
        if (lane < 32) {
            const unsigned long long* slot = (const unsigned long long*)xbuf + (size_t)(u.pm * BM + row) * 4; float mt[4], m2[4]; float ms = 0.f;
#pragma unroll
            for (int t = 0; t < 4; ++t) { if (t < ntn) { const unsigned long long w = __hip_atomic_load(slot + t, __ATOMIC_RELAXED, __HIP_MEMORY_SCOPE_AGENT); mt[t] = __uint_as_float((unsigned)w); m2[t] = __uint_as_float((unsigned)(w >> 32)); } else { mt[t] = 0.f; m2[t] = 0.f; } ms += mt[t]; }
            const float mean = ms / (float)ntn; float q = 0.f;
#pragma unroll
            for (int t = 0; t < 4; ++t) if (t < ntn) { const float dm = mt[t] - mean; q += m2[t] + 256.0f * dm * dm; }
            S[row] = (f32x2v){mean, 1.0f / sqrtf(q / (256.0f * (float)ntn) + (rms ? mean * mean : 0.f) + eps)};
        }
        asm volatile("s_waitcnt lgkmcnt(0)" ::: "memory"); __builtin_amdgcn_s_barrier(); asm volatile("" ::: "memory");
        return bad;
    }
};
struct EpiRmsRes {
    static constexpr bool PERM = false, AFTER_DRAIN = true;
    const float* base; float* out; int ldc; const float* gate; int gate_pitch; int rows_per_batch; const float* gpost; PanelStats st; unsigned poison;
    __device__ __forceinline__ void fused(f32x4 (&acc)[2][2][4][2], const Unit& u, int wr, int wc, int fr, int fq, PG8_LAS unsigned char* lds, int wid, int lane) const {
        typedef float f32x2v __attribute__((ext_vector_type(2)));
        const PG8_LAS f32x2v* S = (const PG8_LAS f32x2v*)(lds + 8192);
        const int col0 = u.pn * BM + wc * 32 + 4 * fq;
        const float* grow = gate + (size_t)((u.pm * BM) / rows_per_batch) * gate_pitch;
        f32x4 cf[2][2];
#pragma unroll
        for (int bj = 0; bj < 2; ++bj)
#pragma unroll
            for (int n = 0; n < 2; ++n) cf[bj][n] = *(const f32x4*)(grow + col0 + bj * HALF + n * 16) * *(const f32x4*)(gpost + col0 + bj * HALF + n * 16);
        f32x4 pre[2][2][2];
#pragma unroll
        for (int m = 0; m < 2; ++m) { const size_t off = (size_t)(u.pm * BM + wr * 64 + m * 16 + fr) * ldc + col0;
#pragma unroll
            for (int bj = 0; bj < 2; ++bj)
#pragma unroll
                for (int n = 0; n < 2; ++n) pre[m][bj][n] = *(const f32x4*)(base + off + bj * HALF + n * 16); }
        const bool bad = st.run(acc, u, wr, wc, fr, fq, lds, wid, lane) || poison != 0u;
        const float qnan = __builtin_nanf("");
#pragma unroll
        for (int ai = 0; ai < 2; ++ai)
#pragma unroll
            for (int m = 0; m < 4; ++m) { const int r = ai * HALF + wr * 64 + m * 16 + fr; const f32x2v sr = S[r]; const size_t off = (size_t)(u.pm * BM + r) * ldc + col0;
#pragma unroll
                for (int bj = 0; bj < 2; ++bj)
#pragma unroll
                    for (int n = 0; n < 2; ++n) { const f32x4 bs = (ai == 0 && m < 2) ? pre[m & 1][bj][n] : *(const f32x4*)(base + off + bj * HALF + n * 16); f32x4 o = bs + acc[ai][bj][m][n] * sr.y * cf[bj][n];
                        if (bad) o = (f32x4){qnan, qnan, qnan, qnan}; *(f32x4*)(out + off + bj * HALF + n * 16) = o; }
                if (m & 1) asm volatile("" ::: "memory"); }
    }
};

template <class Epi, class Sched, bool ALIGN_EPI = false, bool SP2 = false>
__device__ __forceinline__ void gemm_phase(PG8_LAS unsigned char* lds, const Gemm g, const Sched& S, const Epi& E) {
    const int tid = threadIdx.x, wid = __builtin_amdgcn_readfirstlane(tid >> 6), lane = tid & 63, wr = wid >> 2, wc = wid & 3, fr = lane & 15, fq = lane >> 4;
    const int K = g.K, nt = K / BK;
    unsigned voffA[2], voffB[2];
#pragma unroll
    for (int i = 0; i < 2; ++i) { int R, C; stage_rc(tid * 16 + i * 8192, R, C); const int Rb = Epi::PERM ? ((R & ~31) + perm32(R & 31)) : R;
        voffA[i] = (unsigned)(R * K + C) * 2u; voffB[i] = (unsigned)(Rb * K + C) * 2u; }
    const size_t kstep = (size_t)(BK * 2);
    const size_t hstep = (size_t)HALF * K * 2;
    const size_t tstep = 2 * hstep;
    const unsigned ldsw = (unsigned)wid * 1024u;
    const int aoff = lds_byte(wr * 64 + fr, fq * 8), boff = lds_byte(wc * 32 + fr, fq * 8);
#define PG8_SA(b, h) (((b) * 2 + (h)) * HTB)
#define PG8_SB(b, h) ((4 + (b) * 2 + (h)) * HTB)
#define PG8_STAGE(bufoff, gbase, voff) do { _Pragma("unroll") for (int _i = 0; _i < 2; ++_i) \
        __builtin_amdgcn_global_load_lds((const unsigned*)((const char*)(gbase) + (voff)[_i]), (PG8_LAS unsigned*)(lds + (bufoff) + ldsw + _i * 8192), 16, 0, 0); } while (0)
#define PG8_LDA(dst, b, h) do { _Pragma("unroll") for (int m = 0; m < 4; ++m) _Pragma("unroll") for (int k = 0; k < 2; ++k) dst[m][k] = *(const PG8_LAS bf16x8*)(lds + PG8_SA(b, h) + aoff + m * 2048 + k * 1024); } while (0)
#define PG8_LDB(dst, b, h) do { _Pragma("unroll") for (int n = 0; n < 2; ++n) _Pragma("unroll") for (int k = 0; k < 2; ++k) dst[n][k] = *(const PG8_LAS bf16x8*)(lds + PG8_SB(b, h) + boff + n * 2048 + k * 1024); } while (0)
#define PG8_MMA(ai, bj, At, Bt) do { __builtin_amdgcn_s_setprio(1); _Pragma("unroll") for (int m = 0; m < 4; ++m) _Pragma("unroll") for (int n = 0; n < 2; ++n) _Pragma("unroll") for (int k = 0; k < 2; ++k) \
        acc[ai][bj][m][n] = __builtin_amdgcn_mfma_f32_16x16x32_bf16(Bt[n][k], At[m][k], acc[ai][bj][m][n], 0, 0, 0); __builtin_amdgcn_s_setprio(0); } while (0)
#define PG8_WAIT_V(n) asm volatile("s_waitcnt vmcnt(" #n ")" ::: "memory")
#define PG8_WAIT_L(n) asm volatile("s_waitcnt lgkmcnt(" #n ")" ::: "memory")
#define PG8_BAR __builtin_amdgcn_s_barrier()
#define PG8_SCHED __builtin_amdgcn_sched_barrier(0)
    Unit cur, nxt; int ui = 0;
    if (!S.next(0, cur)) return;
    f32x4 acc[2][2][4][2];
#pragma unroll
    for (int a = 0; a < 2; ++a)
#pragma unroll
        for (int b = 0; b < 2; ++b)
#pragma unroll
            for (int m = 0; m < 4; ++m)
#pragma unroll
                for (int n = 0; n < 2; ++n) acc[a][b][m][n] = (f32x4){0.f, 0.f, 0.f, 0.f};
    bf16x8 At[4][2], B0[2][2], B1[2][2];
    const char* cA = (const char*)g.A + (size_t)cur.pm * tstep; const char* cB = (const char*)g.Bt + (size_t)cur.pn * tstep;
    S.a_ready(cur);
    if constexpr (SP2) {
        PG8_STAGE(PG8_SB(0, 0), cB, voffB); PG8_STAGE(PG8_SB(0, 1), cB + hstep, voffB); PG8_STAGE(PG8_SA(0, 0), cA, voffA); PG8_STAGE(PG8_SA(0, 1), cA + hstep, voffA);
        if (wr == 1) PG8_BAR;
        PG8_WAIT_V(2); PG8_BAR;
        PG8_STAGE(PG8_SB(1, 0), cB + kstep, voffB); PG8_STAGE(PG8_SA(1, 0), cA + kstep, voffA); PG8_STAGE(PG8_SB(1, 1), cB + hstep + kstep, voffB);
        PG8_WAIT_V(6); PG8_BAR;
    } else {
        PG8_STAGE(PG8_SB(0, 0), cB, voffB); PG8_STAGE(PG8_SA(0, 0), cA, voffA); PG8_STAGE(PG8_SB(0, 1), cB + hstep, voffB); PG8_STAGE(PG8_SA(0, 1), cA + hstep, voffA);
        if (wr == 1) PG8_BAR;
        PG8_WAIT_V(4); PG8_BAR;
        PG8_STAGE(PG8_SB(1, 0), cB + kstep, voffB); PG8_STAGE(PG8_SA(1, 0), cA + kstep, voffA); PG8_STAGE(PG8_SB(1, 1), cB + hstep + kstep, voffB);
        PG8_WAIT_V(6); PG8_BAR;
    }
    for (;;) {
        const bool has_next = S.next(ui + 1, nxt);
        const char* nA = has_next ? (const char*)g.A + (size_t)nxt.pm * tstep : cA; const char* nB = has_next ? (const char*)g.Bt + (size_t)nxt.pn * tstep : cB;
        for (int t = 0; t < nt; t += 2) {
            const bool last = (t == nt - 2);
            const char* a1 = cA + (size_t)(t + 1) * kstep;
            const char* a2 = last ? nA : cA + (size_t)(t + 2) * kstep; const char* b2 = last ? nB : cB + (size_t)(t + 2) * kstep;
            const char* a3 = a2 + kstep; const char* b3 = b2 + kstep;
            if (last && has_next) S.a_ready(nxt);
            if constexpr (SP2) {
            PG8_LDB(B0, 0, 0); PG8_LDB(B1, 0, 1); PG8_SCHED; PG8_LDA(At, 0, 0); PG8_STAGE(PG8_SA(1, 1), a1 + hstep, voffA);
            PG8_WAIT_V(8); PG8_WAIT_L(0); PG8_BAR; PG8_MMA(0, 0, At, B0); PG8_MMA(0, 1, At, B1); PG8_BAR; PG8_SCHED;
            PG8_LDA(At, 0, 1); PG8_STAGE(PG8_SB(0, 0), b2, voffB); PG8_STAGE(PG8_SB(0, 1), b2 + hstep, voffB); PG8_STAGE(PG8_SA(0, 0), a2, voffA);
            PG8_WAIT_V(8); PG8_WAIT_L(0); PG8_BAR; PG8_MMA(1, 0, At, B0); PG8_MMA(1, 1, At, B1); PG8_BAR; PG8_SCHED;
            PG8_LDB(B0, 1, 0); PG8_LDB(B1, 1, 1); PG8_SCHED; PG8_LDA(At, 1, 0); PG8_STAGE(PG8_SA(0, 1), a2 + hstep, voffA);
            PG8_WAIT_V(8); PG8_WAIT_L(0); PG8_BAR; PG8_MMA(0, 0, At, B0); PG8_MMA(0, 1, At, B1); PG8_BAR; PG8_SCHED;
            PG8_LDA(At, 1, 1); PG8_STAGE(PG8_SB(1, 0), b3, voffB); PG8_STAGE(PG8_SB(1, 1), b3 + hstep, voffB); PG8_STAGE(PG8_SA(1, 0), a3, voffA);
            PG8_WAIT_V(8); PG8_WAIT_L(0); PG8_BAR; PG8_MMA(1, 0, At, B0); PG8_MMA(1, 1, At, B1); PG8_BAR; PG8_SCHED;
            } else {
            PG8_LDB(B0, 0, 0); PG8_SCHED; PG8_LDA(At, 0, 0); PG8_STAGE(PG8_SA(1, 1), a1 + hstep, voffA);
            PG8_WAIT_L(8); PG8_BAR; PG8_WAIT_L(0); PG8_MMA(0, 0, At, B0); PG8_BAR; PG8_SCHED;
            PG8_LDB(B1, 0, 1); PG8_STAGE(PG8_SB(0, 0), b2, voffB);
            PG8_BAR; PG8_WAIT_L(0); PG8_MMA(0, 1, At, B1); PG8_BAR;
            PG8_LDA(At, 0, 1); PG8_STAGE(PG8_SA(0, 0), a2, voffA);
            PG8_BAR; PG8_WAIT_L(0); PG8_MMA(1, 0, At, B0); PG8_BAR; PG8_SCHED;
            PG8_STAGE(PG8_SB(0, 1), b2 + hstep, voffB);
            PG8_WAIT_V(6); PG8_BAR; PG8_MMA(1, 1, At, B1); PG8_BAR;
            PG8_LDB(B0, 1, 0); PG8_SCHED; PG8_LDA(At, 1, 0); PG8_STAGE(PG8_SA(0, 1), a2 + hstep, voffA);
            PG8_WAIT_L(8); PG8_BAR; PG8_WAIT_L(0); PG8_MMA(0, 0, At, B0); PG8_BAR; PG8_SCHED;
            PG8_LDB(B1, 1, 1); PG8_STAGE(PG8_SB(1, 0), b3, voffB);
            PG8_BAR; PG8_WAIT_L(0); PG8_MMA(0, 1, At, B1); PG8_BAR;
            PG8_LDA(At, 1, 1); PG8_STAGE(PG8_SA(1, 0), a3, voffA);
            PG8_BAR; PG8_WAIT_L(0); PG8_MMA(1, 0, At, B0); PG8_BAR; PG8_SCHED;
            PG8_STAGE(PG8_SB(1, 1), b3 + hstep, voffB);
            PG8_WAIT_V(6); PG8_BAR; PG8_MMA(1, 1, At, B1); PG8_BAR;
            }
        }
        if constexpr (ALIGN_EPI) { if (wr == 0) PG8_BAR; }
        if constexpr (!Epi::AFTER_DRAIN) { E(acc, cur, wr, wc, fr, fq); S.done(cur); }
        if (!has_next) break;
#pragma unroll
        for (int a = 0; a < 2; ++a)
#pragma unroll
            for (int b = 0; b < 2; ++b)
#pragma unroll
                for (int m = 0; m < 4; ++m)
#pragma unroll
                    for (int n = 0; n < 2; ++n) acc[a][b][m][n] = (f32x4){0.f, 0.f, 0.f, 0.f};
        cur = nxt; cA = nA; cB = nB; ++ui;
        if constexpr (ALIGN_EPI) { if (wr == 1) PG8_BAR; }
    }
    PG8_WAIT_V(0);
    if constexpr (!ALIGN_EPI) { if (wr == 0) PG8_BAR; }
    PG8_BAR;
    if constexpr (Epi::AFTER_DRAIN) { E.fused(acc, cur, wr, wc, fr, fq, lds, wid, lane); S.done(cur); }
#undef PG8_SA
#undef PG8_SB
#undef PG8_STAGE
#undef PG8_LDA
#undef PG8_LDB
#undef PG8_MMA
#undef PG8_WAIT_V
#undef PG8_WAIT_L
#undef PG8_BAR
#undef PG8_SCHED
}
}

#ifndef PG8_SP2
#define PG8_SP2 true
#endif
#ifndef PG8_ALIGN
#define PG8_ALIGN true
#endif
#include <hip/hip_bf16.h>
#include <cmath>
namespace attn_body {
using bf16=__hip_bfloat16;
using bf16x8=__attribute__((ext_vector_type(8)))short;
using s16x4=__attribute__((ext_vector_type(4)))short;
using f32x16=__attribute__((ext_vector_type(16)))float;
using u32x4=__attribute__((ext_vector_type(4)))unsigned;
constexpr int SEQ=4096,D=64,PQ=1024,PO=1024;
constexpr int KT=4096,VT=8192;
constexpr int NW=8,QBLK=32,QB=QBLK*NW,KVBLK=64,NQB=SEQ/QB;
constexpr int ATTN_UNIT_ROWS=QB;
__device__ __forceinline__ int crow(int r,int hi){return (r&3)+8*(r>>2)+4*hi;}
#define SBAR() __builtin_amdgcn_sched_barrier(0)
__device__ __forceinline__ void cmask(f32x16&p0,f32x16&p1,int jb,int qrel,int hi){
  const float NEG=-INFINITY;
  if(jb>(qrel>>6)){
  #pragma unroll
  for(int r=0;r<16;++r){p0[r]=NEG;p1[r]=NEG;}}
}

constexpr int NSLOT=3, SLOTB=8192;
constexpr int LDS_K=0, LDS_V=NSLOT*SLOTB, LDS_WS=LDS_V+NSLOT*2*SLOTB, LDS_OST=LDS_WS+NW*64*4, LDS_BYTES=LDS_OST+NW*4096;
constexpr float C2=0.125f*1.4426950408889634f;
__device__ __forceinline__ void glds16(const void*gsrc,unsigned lds_dst){unsigned keep;
  asm volatile("s_mov_b32 %0, m0\n\ts_mov_b32 m0, %2\n\ts_nop 0\n\tglobal_load_lds_dwordx4 %1, off\n\ts_mov_b32 m0, %0":"=&s"(keep):"v"(gsrc),"s"(lds_dst):"memory");}
__device__ __forceinline__ void glds16s(const void*sbase,unsigned voff,unsigned lds_dst){unsigned keep;
  asm volatile("s_mov_b32 %0, m0\n\ts_mov_b32 m0, %3\n\ts_nop 0\n\tglobal_load_lds_dwordx4 %1, %2\n\ts_mov_b32 m0, %0":"=&s"(keep):"v"(voff),"s"(sbase),"s"(lds_dst):"memory");}
__device__ __forceinline__ float max3f(float a,float b,float c){float r;asm("v_max3_f32 %0, %1, %2, %3":"=v"(r):"v"(a),"v"(b),"v"(c));return r;}
__device__ __forceinline__ float max2f(float a,float b){float r;asm("v_max_f32_e32 %0, %1, %2":"=v"(r):"v"(a),"v"(b));return r;}
__device__ __forceinline__ float fadd_s(float a,float b){float r;asm("v_add_f32_e32 %0, %1, %2":"=v"(r):"v"(a),"v"(b));return r;}
__device__ __forceinline__ float fsub_s(float a,float b){float r;asm("v_sub_f32_e32 %0, %1, %2":"=v"(r):"v"(a),"v"(b));return r;}
typedef float f32x2_t __attribute__((ext_vector_type(2))); typedef __bf16 bf16x2_t __attribute__((ext_vector_type(2)));
__device__ __forceinline__ unsigned cvtpk_s(float lo,float hi){f32x2_t v={lo,hi};bf16x2_t b=__builtin_convertvector(v,bf16x2_t);return __builtin_bit_cast(unsigned,b);}
#define WAIT_BAR(N) asm volatile("s_waitcnt vmcnt(" #N ") lgkmcnt(0)\n\ts_barrier":::"memory")

__device__ __forceinline__ void qkt(f32x16&p0,f32x16&p1,const char*Kslot,const bf16x8*qr,const f32x16&negm,int r32,int hi){
  const char*kb=Kslot+hi*1024+r32*16;
  #pragma unroll
  for(int d0=0;d0<4;++d0){
    const bf16x8 b0=*reinterpret_cast<const bf16x8*>(kb+d0*2048);
    const bf16x8 b1=*reinterpret_cast<const bf16x8*>(kb+d0*2048+512);
    if(d0==0){p0=__builtin_amdgcn_mfma_f32_32x32x16_bf16(b0,qr[0],negm,0,0,0);p1=__builtin_amdgcn_mfma_f32_32x32x16_bf16(b1,qr[0],negm,0,0,0);}
    else{p0=__builtin_amdgcn_mfma_f32_32x32x16_bf16(b0,qr[d0],p0,0,0,0);p1=__builtin_amdgcn_mfma_f32_32x32x16_bf16(b1,qr[d0],p1,0,0,0);}}
}
typedef __attribute__((address_space(3))) const char* lds_cptr;
typedef short v4i16_t __attribute__((ext_vector_type(4)));
__device__ __forceinline__ void kload8(bf16x8*kf,lds_cptr kp){
  kf[0]=*(const __attribute__((address_space(3))) bf16x8*)(kp);      kf[1]=*(const __attribute__((address_space(3))) bf16x8*)(kp+512);
  kf[2]=*(const __attribute__((address_space(3))) bf16x8*)(kp+2048); kf[3]=*(const __attribute__((address_space(3))) bf16x8*)(kp+2560);
  kf[4]=*(const __attribute__((address_space(3))) bf16x8*)(kp+4096); kf[5]=*(const __attribute__((address_space(3))) bf16x8*)(kp+4608);
  kf[6]=*(const __attribute__((address_space(3))) bf16x8*)(kp+6144); kf[7]=*(const __attribute__((address_space(3))) bf16x8*)(kp+6656);
}
__device__ __forceinline__ void kload2(bf16x8*kf,lds_cptr kp,int j){ kf[2*j]=*(const __attribute__((address_space(3))) bf16x8*)(kp+j*2048); kf[2*j+1]=*(const __attribute__((address_space(3))) bf16x8*)(kp+j*2048+512); }
__device__ __forceinline__ s16x4 vtr(lds_cptr p){ return __builtin_bit_cast(s16x4,__builtin_amdgcn_ds_read_tr16_b64_v4i16((__attribute__((address_space(3))) v4i16_t*)p)); }
__device__ __forceinline__ float rowmax(const f32x16&p0,const f32x16&p1){
  float a=max3f(p0[0],p0[1],p1[0]),b=max3f(p0[2],p0[3],p1[1]);a=max3f(a,p1[2],p1[3]);
  #pragma unroll
  for(int r=4;r<16;r+=4){a=max3f(a,p0[r],p0[r+1]);b=max3f(b,p0[r+2],p0[r+3]);a=max3f(a,p1[r],p1[r+1]);b=max3f(b,p1[r+2],p1[r+3]);}
  const float m=max2f(a,b);
  auto rr=__builtin_amdgcn_permlane32_swap(__float_as_uint(m),__float_as_uint(m),false,false);
  return max2f(__uint_as_float(rr[0]),__uint_as_float(rr[1]));
}
__device__ __forceinline__ void pv(f32x16*o,int vb,bf16x8 pa0,bf16x8 pa1,bf16x8 pa2,bf16x8 pa3){
  #pragma unroll
  for(int d0=0;d0<4;++d0){s16x4 lo[4],hi[4];
    #pragma unroll
    for(int ks=0;ks<4;++ks){
      asm volatile("ds_read_b64_tr_b16 %0,%1 offset:%c2":"=&v"(lo[ks]):"v"(vb),"i"(d0*4096+ks*1024):"memory");
      asm volatile("ds_read_b64_tr_b16 %0,%1 offset:%c2":"=&v"(hi[ks]):"v"(vb),"i"(d0*4096+ks*1024+512):"memory");}
    asm volatile("s_waitcnt lgkmcnt(0)":::"memory");SBAR();
    #define PK(k) (bf16x8){lo[k][0],lo[k][1],lo[k][2],lo[k][3],hi[k][0],hi[k][1],hi[k][2],hi[k][3]}
    o[d0]=__builtin_amdgcn_mfma_f32_32x32x16_bf16(pa0,PK(0),o[d0],0,0,0);
    o[d0]=__builtin_amdgcn_mfma_f32_32x32x16_bf16(pa1,PK(1),o[d0],0,0,0);
    o[d0]=__builtin_amdgcn_mfma_f32_32x32x16_bf16(pa2,PK(2),o[d0],0,0,0);
    o[d0]=__builtin_amdgcn_mfma_f32_32x32x16_bf16(pa3,PK(3),o[d0],0,0,0);
    #undef PK
  }
}

#ifndef ATTN_STORE16
#define ATTN_STORE16(p,v) (*(u32x4*)(p)=(v))
#endif
template<int THRL> __device__ __forceinline__ void attn_unit(int qb,const bf16*Q,const bf16*__restrict__ K,const bf16*__restrict__ V,bf16*O,char*shm){
  const int tid=threadIdx.x,lane=tid&63,r32=lane&31,hi=lane>>5; const int wid=__builtin_amdgcn_readfirstlane(tid>>6);
  const int q0=qb*QB;
  const bf16*Qw=Q+(long)(q0+wid*QBLK)*PQ;
  const bf16*Kh=K,*Vh=V;
  const unsigned lds0=(unsigned)(uintptr_t)shm;
  float*wsf=(float*)(shm+LDS_WS)+wid*64;
  const unsigned koff=(unsigned)(wid*1024+lane*16);
  const unsigned voffv=koff;
  const unsigned kdst=lds0+LDS_K+wid*1024, vdst=lds0+LDS_V+wid*1024;
  #define DMA_K(t,slot) glds16s(Kh+(long)(t)*KT,koff,(unsigned)__builtin_amdgcn_readfirstlane(kdst+(slot)))
  #define DMA_V(t,slot) do{ glds16s(Vh+(long)(t)*VT,voffv,(unsigned)__builtin_amdgcn_readfirstlane(vdst+2*(slot))); glds16s(Vh+4096+(long)(t)*VT,voffv,(unsigned)__builtin_amdgcn_readfirstlane(vdst+8192+2*(slot))); }while(0)
  const int vb0=(int)(lds0+LDS_V)+((lane>>4)&1)*32+(lane&3)*8+(4*hi+((lane&15)>>2))*64;
  const char*Kbase=shm+LDS_K; bf16x8 kf[8];
  const lds_cptr shm3=(lds_cptr)shm; const lds_cptr kp0=shm3+LDS_K+hi*1024+r32*16; const lds_cptr vp0=shm3+LDS_V+((lane>>4)&1)*32+(lane&3)*8+(4*hi+((lane&15)>>2))*64;
  const int NT=(q0+QB)/KVBLK;
  DMA_K(0,0);DMA_V(0,0);DMA_K(1,SLOTB);
  bf16x8 qr[4];
  #pragma unroll
  for(int d0=0;d0<4;++d0)qr[d0]=*reinterpret_cast<const bf16x8*>(&Qw[(long)r32*PQ+d0*16+hi*8]);
  float mhat=0.f,l_reg=0.f;f32x16 o[4];o[0]=f32x16{};o[1]=f32x16{};o[2]=f32x16{};o[3]=f32x16{};
  const int qrel=wid*QBLK+r32;
  #define CMASK(P0,P1,t) do{int jb_=(t)-(NT-4); if(jb_>=0)cmask(P0,P1,jb_,qrel,hi);}while(0)
  bool resc=false;
  #define START(P0,P1) do{ const float rm=rowmax(P0,P1); resc=false; \
    { const float dl=rm; mhat=fadd_s(mhat,dl); \
      _Pragma("unroll") for(int r=0;r<16;++r){P0[r]=fsub_s(P0[r],dl);P1[r]=fsub_s(P1[r],dl);} } \
    _Pragma("unroll") for(int r=0;r<16;++r)P0[r]=__builtin_amdgcn_exp2f(P0[r]); }while(0)
  #define RESC() do{ if(resc){ asm volatile("s_waitcnt lgkmcnt(0)":::"memory"); \
      _Pragma("unroll") for(int d_=0;d_<4;++d_) _Pragma("unroll") for(int r=0;r<16;++r)o[d_][r]*=wsf[crow(r,hi)]; } }while(0)
  f32x16 pA0,pA1,pB0,pB1;
  int sl_prev=0,sl_cur=0,sl_next=SLOTB;
  #define ROT() do{sl_prev=sl_cur;sl_cur=sl_next;sl_next=(sl_next==(NSLOT-1)*SLOTB)?0:sl_next+SLOTB;}while(0)
  DMA_K(2,2*SLOTB);
  WAIT_BAR(4);
  { const f32x16 zero16=f32x16{}; qkt(pA0,pA1,Kbase,qr,zero16,r32,hi); }asm volatile("s_nop 15\n\ts_nop 7":"+v"(pA0),"+v"(pA1));CMASK(pA0,pA1,0);
  START(pA0,pA1);
  _Pragma("unroll") for(int r=0;r<16;++r)pA1[r]=__builtin_amdgcn_exp2f(pA1[r]);
  WAIT_BAR(0);
  DMA_K(3,0);DMA_V(1,SLOTB);
  ROT();
  kload8(kf,kp0+sl_cur);
  WAIT_BAR(3);
  s16x4 vlo[8],vhi[8]; u32x4 pw0,pw1,pw2,pw3;
  #define PKW(P,B) cvtpk_s(P[B],P[B+1])
  #define PAF(k) __builtin_bit_cast(bf16x8,pw##k)
  #define VFR(i) (bf16x8){vlo[i][0],vlo[i][1],vlo[i][2],vlo[i][3],vhi[i][0],vhi[i][1],vhi[i][2],vhi[i][3]}
  #define PIN(x) asm volatile("":"+v"(x))
  #define MX3(a,b,c) __builtin_fmaxf(__builtin_fmaxf((a),(b)),(c))
  #define GAPA(MF,A0,A1,A2,A3,W0,W1,PW) do{ MF; sacc+=A0; sacc+=A1; sacc+=A2; sacc+=A3; PIN(sacc); W0; W1; PIN(PW); SBAR(); }while(0)
  #define EX(v) __builtin_amdgcn_exp2f(v)
  #define GAPM(MF,X,B) do{ MF; X[B]-=mhat; X[B+1]-=mhat; X[B+2]-=mhat; X[B+3]-=mhat; PIN(X); }while(0)
  #define GAPB(MF,X,B) do{ MF; X[B]=EX(X[B]); X[B+1]=EX(X[B+1]); X[B+2]=EX(X[B+2]); X[B+3]=EX(X[B+3]); PIN(X); SBAR(); }while(0)
  #define VRD(i) do{ vlo[i]=vtr(vp_+(((i)>>2)*4096+((i)&3)*1024)); vhi[i]=vtr(vp_+(((i)>>2)*4096+((i)&3)*1024+512)); }while(0)
  #define VRD2(i) do{ vlo[i]=vtr(vp_+((2+((i)>>2))*4096+((i)&3)*1024)); vhi[i]=vtr(vp_+((2+((i)>>2))*4096+((i)&3)*1024+512)); }while(0)
  #define KRD(G,j) do{ if(G){ kload2(kf,kp0+sl_next,j); SBAR(); } }while(0)
  #define STEP(C0,C1,P0,P1,t,GK,GV,GL) do{ SBAR(); \
    const lds_cptr vp_=vp0+2*sl_prev; \
    VRD(0); SBAR(); float sacc=(P0[0]+P0[1]); \
    GAPA(C0=__builtin_amdgcn_mfma_f32_32x32x16_bf16(kf[0],qr[0],f32x16{},0,0,0), P0[2],P0[3],P0[4],P0[5],     pw0[0]=PKW(P0,0), pw0[1]=PKW(P0,2), pw0); \
    VRD(4); SBAR(); GAPA(C1=__builtin_amdgcn_mfma_f32_32x32x16_bf16(kf[1],qr[0],f32x16{},0,0,0), P0[6],P0[7],P0[8],P0[9],     pw0[2]=PKW(P0,4), pw0[3]=PKW(P0,6), pw0); \
    VRD(1); SBAR(); GAPA(C0=__builtin_amdgcn_mfma_f32_32x32x16_bf16(kf[2],qr[1],C0,0,0,0),   P0[10],P0[11],P0[12],P0[13], pw1[0]=PKW(P0,8), pw1[1]=PKW(P0,10), pw1); \
    VRD(5); SBAR(); GAPA(C1=__builtin_amdgcn_mfma_f32_32x32x16_bf16(kf[3],qr[1],C1,0,0,0),   P0[14],P0[15],P1[0],P1[1],   pw1[2]=PKW(P0,12),pw1[3]=PKW(P0,14), pw1); \
    VRD(2); SBAR(); GAPA(C0=__builtin_amdgcn_mfma_f32_32x32x16_bf16(kf[4],qr[2],C0,0,0,0),   P1[2],P1[3],P1[4],P1[5],     pw2[0]=PKW(P1,0), pw2[1]=PKW(P1,2), pw2); \
    VRD(6); SBAR(); GAPA(C1=__builtin_amdgcn_mfma_f32_32x32x16_bf16(kf[5],qr[2],C1,0,0,0),   P1[6],P1[7],P1[8],P1[9],     pw2[2]=PKW(P1,4), pw2[3]=PKW(P1,6), pw2); \
    VRD(3); SBAR(); GAPA(C0=__builtin_amdgcn_mfma_f32_32x32x16_bf16(kf[6],qr[3],C0,0,0,0),   P1[10],P1[11],P1[12],P1[13], pw3[0]=PKW(P1,8), pw3[1]=PKW(P1,10), pw3); \
    VRD(7); SBAR(); GAPA(C1=__builtin_amdgcn_mfma_f32_32x32x16_bf16(kf[7],qr[3],C1,0,0,0),   P1[14],P1[15],0.f,0.f,       pw3[2]=PKW(P1,12),pw3[3]=PKW(P1,14), pw3); \
    l_reg+=sacc; \
    if(GK){DMA_K((t)+3,sl_cur);} if(GV){DMA_V((t)+1,sl_next);} \
    GAPM(o[0]=__builtin_amdgcn_mfma_f32_32x32x16_bf16(PAF(0),VFR(0),o[0],0,0,0), C0,0);  VRD2(0); SBAR(); \
    GAPM(o[1]=__builtin_amdgcn_mfma_f32_32x32x16_bf16(PAF(0),VFR(4),o[1],0,0,0), C0,4);  VRD2(4); SBAR(); \
    GAPM(o[0]=__builtin_amdgcn_mfma_f32_32x32x16_bf16(PAF(1),VFR(1),o[0],0,0,0), C0,8);  VRD2(1); SBAR(); \
    GAPM(o[1]=__builtin_amdgcn_mfma_f32_32x32x16_bf16(PAF(1),VFR(5),o[1],0,0,0), C0,12); VRD2(5); SBAR(); \
    GAPM(o[0]=__builtin_amdgcn_mfma_f32_32x32x16_bf16(PAF(2),VFR(2),o[0],0,0,0), C1,0);  VRD2(2); SBAR(); \
    GAPM(o[1]=__builtin_amdgcn_mfma_f32_32x32x16_bf16(PAF(2),VFR(6),o[1],0,0,0), C1,4);  VRD2(6); SBAR(); \
    GAPM(o[0]=__builtin_amdgcn_mfma_f32_32x32x16_bf16(PAF(3),VFR(3),o[0],0,0,0), C1,8);  VRD2(3); SBAR(); \
    GAPM(o[1]=__builtin_amdgcn_mfma_f32_32x32x16_bf16(PAF(3),VFR(7),o[1],0,0,0), C1,12); VRD2(7); SBAR(); \
    CMASK(C0,C1,t); \
    { float a=MX3(C0[0],C0[1],C1[0]),b=MX3(C0[2],C0[3],C1[1]); a=MX3(a,C1[2],C1[3]); \
      _Pragma("unroll") for(int r=4;r<16;r+=4){a=MX3(a,C0[r],C0[r+1]);b=MX3(b,C0[r+2],C0[r+3]);a=MX3(a,C1[r],C1[r+1]);b=MX3(b,C1[r+2],C1[r+3]);} \
      float rm=__builtin_fmaxf(a,b); { auto rr=__builtin_amdgcn_permlane32_swap(__float_as_uint(rm),__float_as_uint(rm),false,false); rm=__builtin_fmaxf(__uint_as_float(rr[0]),__uint_as_float(rr[1])); } \
      resc=false; \
      if(__builtin_expect(__any(rm>(float)THRL),0)){ const float dl=__builtin_fmaxf(rm,0.f); mhat+=dl; \
        _Pragma("unroll") for(int r=0;r<16;++r){C0[r]-=dl;C1[r]-=dl;} \
        const float f=__builtin_amdgcn_exp2f(-dl); l_reg*=f; if(hi==0)wsf[r32]=f; resc=true; } } \
    SBAR(); \
    GAPB(o[2]=__builtin_amdgcn_mfma_f32_32x32x16_bf16(PAF(0),VFR(0),o[2],0,0,0), C0,0); \
    GAPB(o[3]=__builtin_amdgcn_mfma_f32_32x32x16_bf16(PAF(0),VFR(4),o[3],0,0,0), C0,4); \
    KRD(GL,0); GAPB(o[2]=__builtin_amdgcn_mfma_f32_32x32x16_bf16(PAF(1),VFR(1),o[2],0,0,0), C0,8); \
    KRD(GL,1); GAPB(o[3]=__builtin_amdgcn_mfma_f32_32x32x16_bf16(PAF(1),VFR(5),o[3],0,0,0), C0,12); \
    KRD(GL,2); GAPB(o[2]=__builtin_amdgcn_mfma_f32_32x32x16_bf16(PAF(2),VFR(2),o[2],0,0,0), C1,0); \
    KRD(GL,3); GAPB(o[3]=__builtin_amdgcn_mfma_f32_32x32x16_bf16(PAF(2),VFR(6),o[3],0,0,0), C1,4); \
    GAPB(o[2]=__builtin_amdgcn_mfma_f32_32x32x16_bf16(PAF(3),VFR(3),o[2],0,0,0), C1,8); \
    GAPB(o[3]=__builtin_amdgcn_mfma_f32_32x32x16_bf16(PAF(3),VFR(7),o[3],0,0,0), C1,12); \
    }while(0)
  int t=1;
  #undef CMASK
  #define CMASK(P0,P1,t) do{}while(0)
  for(;t+5<NT;t+=2){
    STEP(pB0,pB1,pA0,pA1,t,true,true,true);     WAIT_BAR(3); RESC(); ROT();
    STEP(pA0,pA1,pB0,pB1,t+1,true,true,true);   WAIT_BAR(3); RESC(); ROT();
  }
  #undef CMASK
  #define CMASK(P0,P1,t) do{int jb_=(t)-(NT-4); if(jb_>=0)cmask(P0,P1,jb_,qrel,hi);}while(0)
  #define ENDW(tt) do{ if((tt)+3<NT){WAIT_BAR(3);} else if((tt)+2<NT){WAIT_BAR(2);} else {WAIT_BAR(0);} }while(0)
  for(;t+1<NT;t+=2){
    STEP(pB0,pB1,pA0,pA1,t,(t+3<NT),(t+1<NT),(t+1<NT));       ENDW(t);   RESC(); ROT();
    STEP(pA0,pA1,pB0,pB1,t+1,(t+4<NT),(t+2<NT),(t+2<NT));     ENDW(t+1); RESC(); ROT();
  }
  STEP(pB0,pB1,pA0,pA1,NT-1,false,false,false); RESC();
  { float sacc=pB0[0]+pB0[1]; _Pragma("unroll") for(int r=2;r<16;++r)sacc+=pB0[r]; _Pragma("unroll") for(int r=0;r<16;++r)sacc+=pB1[r]; l_reg+=sacc;
    pw0=(u32x4){PKW(pB0,0),PKW(pB0,2),PKW(pB0,4),PKW(pB0,6)};pw1=(u32x4){PKW(pB0,8),PKW(pB0,10),PKW(pB0,12),PKW(pB0,14)};pw2=(u32x4){PKW(pB1,0),PKW(pB1,2),PKW(pB1,4),PKW(pB1,6)};pw3=(u32x4){PKW(pB1,8),PKW(pB1,10),PKW(pB1,12),PKW(pB1,14)};
    SBAR(); pv(o,vb0+2*sl_cur,PAF(0),PAF(1),PAF(2),PAF(3)); }
  #undef PKW
  #undef PAF
  #undef VFR
  #undef PIN
  #undef MX3
  #undef GAPA
  #undef GAPB
  #undef GAPM
  #undef EX
  #undef VRD
  #undef VRD2
  #undef KRD
  #undef STEP
  #undef ENDW
  {auto rr=__builtin_amdgcn_permlane32_swap(__float_as_uint(l_reg),__float_as_uint(l_reg),false,false);l_reg=__uint_as_float(rr[0])+__uint_as_float(rr[1]);}
  if(hi==0)wsf[32+r32]=l_reg;asm volatile("s_waitcnt lgkmcnt(0)":::"memory");
  float rli[16];
  #pragma unroll
  for(int r=0;r<16;++r)rli[r]=__builtin_amdgcn_rcpf(wsf[32+crow(r,hi)]);
  bf16*Ow=O+(long)(q0+wid*QBLK)*PO;
  { bf16*stg=(bf16*)(shm+LDS_OST)+wid*2048;
    #pragma unroll
    for(int p=0;p<2;++p){
    #pragma unroll
    for(int r=0;r<16;++r){const int orow=crow(r,hi);
      #pragma unroll
      for(int d0=0;d0<2;++d0)stg[orow*64+d0*32+r32]=__float2bfloat16(o[2*p+d0][r]*rli[r]);}
    asm volatile("s_waitcnt lgkmcnt(0)":::"memory");
    #pragma unroll
    for(int i=0;i<4;++i){const int row=i*8+(lane>>3),ch=lane&7; const u32x4 v=*(const u32x4*)(stg+row*64+ch*8); ATTN_STORE16(Ow+(long)row*PO+p*64+ch*8,v);}
    asm volatile("s_waitcnt lgkmcnt(0)":::"memory"); } }
  asm volatile("s_waitcnt lgkmcnt(0)\n\ts_barrier":::"memory");
  #undef DMA_K
  #undef DMA_V
  #undef CMASK
  #undef START
  #undef RESC
  #undef ROT
}
constexpr int ATTN_LDS_BYTES=LDS_BYTES;
struct AttnTensors { const bf16* Q; const bf16* Kimg; const bf16* Vimg; bf16* O0; bf16* O1; };
struct AttnUnit { int vh; int qb; };
struct StaticOrder {
  int vcu;
  __device__ __forceinline__ explicit StaticOrder(int vcu_):vcu(vcu_){}
  __device__ __forceinline__ bool next(int i,AttnUnit&u)const{ if(i>=4)return false; const int s=vcu&3; u.vh=vcu>>2; u.qb=(i==0)?s:(i==1)?7-s:(i==2)?8+s:15-s; return true; }
  __device__ __forceinline__ void a_ready(const AttnUnit&)const{}
  __device__ __forceinline__ void done(const AttnUnit&)const{}
};
template<int ABL=0> __device__ __forceinline__ void attn_run(const AttnTensors&T,int vh,int qb,char*lds){
  const int comp=vh&1,h=(vh>>1)&3,b=vh>>3;
  attn_unit<8>(qb,T.Q+(long)b*SEQ*PQ+h*128+comp*64,T.Kimg+(long)((b*8+h*2+comp)*(SEQ/64))*KT,T.Vimg+(long)((b*4+h)*(SEQ/64))*VT,(comp?T.O1:T.O0)+(long)b*SEQ*PO+h*128,lds);
}
__device__ __forceinline__ unsigned q_take(unsigned*qheads,int&cq){
  for(int tries=0;tries<8;++tries){
    const unsigned idx=__hip_atomic_fetch_add(qheads+cq,1u,__ATOMIC_RELAXED,__HIP_MEMORY_SCOPE_AGENT);
    if(idx<64u)return (unsigned)cq*64u+idx;
    int found=-1;
    #pragma unroll
    for(int j=1;j<8;++j){const int q=(cq+j)&7; if(found<0&&__hip_atomic_load(qheads+q,__ATOMIC_RELAXED,__HIP_MEMORY_SCOPE_AGENT)<64u)found=q;}
    if(found<0)return 0xffffffffu;
    cq=found;}
  return 0xffffffffu;
}
template<int ABL=0> __device__ __forceinline__ void attn_phase_queue(char*lds,const AttnTensors&T,unsigned*qheads,int xq,volatile __attribute__((address_space(3))) unsigned*mbox){
  const bool t0=(threadIdx.x==0); int cq=xq&7;
  if(t0)mbox[0]=q_take(qheads,cq);
  asm volatile("s_waitcnt vmcnt(0) lgkmcnt(0)\n\ts_barrier":::"memory");
  unsigned ticket=(unsigned)__builtin_amdgcn_readfirstlane(mbox[0]); int par=0;
  while(ticket!=0xffffffffu){
    unsigned nxt=0u; if(t0)nxt=__hip_atomic_fetch_add(qheads+cq,1u,__ATOMIC_RELAXED,__HIP_MEMORY_SCOPE_AGENT);
    attn_run<ABL>(T,4*(int)(ticket>>6)+(int)(ticket&3u),15-(int)((ticket&63u)>>2),lds);
    par^=1; if(t0)mbox[par]=(nxt<64u)?(unsigned)cq*64u+nxt:q_take(qheads,cq);
    asm volatile("s_waitcnt vmcnt(0) lgkmcnt(0)\n\ts_barrier":::"memory");
    ticket=(unsigned)__builtin_amdgcn_readfirstlane(mbox[par]);
  }
}
#undef SBAR
#undef WAIT_BAR
}

constexpr int NWAVES = 8;
#ifndef MK_N_LAUNCHES
#define MK_N_LAUNCHES 1
#endif
constexpr int PER_PHASE = 8;
constexpr int N_LAUNCHES = MK_N_LAUNCHES;

constexpr int BATCH = 4, T = 4096, D = 1024;
constexpr int M = BATCH * T;
constexpr int RW_W = 512, RW_H = 8, RW_N = 64, DA_W = 512;
constexpr int RW_SHIFTED = 1664, RW_COLS = 2176, D_IN = 4224;
constexpr int NMAIN = 4096;
constexpr float RMS_EPS = 1e-6f, GN_EPS = 64e-5f, SUBLN_EPS = 1e-5f;
constexpr float LAMBDA_INIT = 0.2f;
constexpr float LOG2E = 1.4426950408889634f;

constexpr size_t MiB = 1u << 20, KiB = 1u << 10;
constexpr size_t WS_CTL = 0, CTL_ZERO_BYTES = 128 * KiB;
constexpr size_t WS_MOD = 128 * KiB;
constexpr size_t WS_W2T = 256 * KiB;
constexpr size_t WS_BONUS = 512 * KiB;
constexpr size_t WS_X = 1 * MiB;
constexpr size_t WS_WOUT = 1 * MiB + 512 * KiB;
constexpr size_t WS_WIN = 3 * MiB + 512 * KiB;
constexpr size_t WS_XN = 11 * MiB + 768 * KiB;
constexpr size_t WS_REC1 = WS_XN;
constexpr size_t WS_Y = WS_XN;
constexpr size_t WS_URK = WS_XN + 32 * MiB;
constexpr size_t WS_UVG = WS_URK + 32 * MiB;
constexpr size_t WS_UQG = WS_UVG + 32 * MiB;
constexpr size_t WS_KIMG = WS_UQG + 32 * MiB;
constexpr size_t WS_VIMG = WS_KIMG + 16 * MiB;
constexpr size_t WS_REC2 = WS_VIMG + 16 * MiB;
constexpr size_t WS_LO = WS_REC2 + 65 * MiB;
constexpr size_t WS_ORW = WS_LO;
constexpr size_t WS_END = WS_ORW + 16 * MiB;
static_assert(WS_END <= 256 * MiB, "d_ws map");
constexpr int UP = 1024;
constexpr int CW_TMO = 0, CW_CODE = 1;
constexpr int CW_BAR = 4096;
constexpr int CW_SEAM = 16384;
constexpr int CW_QUEUE = 24576;
static_assert((CW_QUEUE + 1024 + 16 * 64) * 4 <= (int)CTL_ZERO_BYTES, "CTL words inside the memset region");

constexpr int RING_OFF = 0, RING_BYTES = 131072;
constexpr int LDSCTL_OFF = RING_BYTES, MISC_OFF = LDSCTL_OFF + 320;
constexpr int LDS_BYTES = 147456;
static_assert(MISC_OFF + 128 <= LDS_BYTES, "LDS map");

#define GAS __attribute__((address_space(1)))
#define LAS __attribute__((address_space(3)))
typedef unsigned short bf16;
typedef unsigned v4u __attribute__((ext_vector_type(4)));
typedef float f32x4 __attribute__((ext_vector_type(4)));
typedef short bf16x8 __attribute__((ext_vector_type(8)));
typedef GAS unsigned gu32;
typedef GAS unsigned long long gu64;
#define RLX_AGENT __ATOMIC_RELAXED, __HIP_MEMORY_SCOPE_AGENT
#define LDS_WAIT() asm volatile("s_waitcnt lgkmcnt(0)" ::: "memory")
#define VM_WAIT() asm volatile("s_waitcnt vmcnt(0)" ::: "memory")
__device__ __forceinline__ unsigned long long rt() { return __builtin_amdgcn_s_memrealtime(); }
__device__ __forceinline__ unsigned f2bf(float f) { unsigned u = __builtin_bit_cast(unsigned, f); return (u + 0x7fffu + ((u >> 16) & 1u)) >> 16; }
__device__ __forceinline__ unsigned pk2(float lo, float hi) { return f2bf(lo) | (f2bf(hi) << 16); }

#define XB_TMO      128
#define XB_XCNT(j)  (256  + 64 * (j))
#define XB_XSUB(j)  (1280 + 64 * (j))
#define XB_XGEN(j)  (2304 + 64 * (j))
#define XB_TOP      3328
#define XB_TOPGEN   3392
#define XCD_BAR_WORDS 3456
#define XB_SPIN_CAP (1u << 18)

__device__ __forceinline__ unsigned xb_ld(unsigned* p)              { return __hip_atomic_load(p, __ATOMIC_RELAXED, __HIP_MEMORY_SCOPE_AGENT); }
__device__ __forceinline__ unsigned xb_add(unsigned* p, unsigned v) { return __hip_atomic_fetch_add(p, v, __ATOMIC_RELAXED, __HIP_MEMORY_SCOPE_AGENT); }
__device__ __forceinline__ unsigned xb_xcc_id() { return (unsigned)__builtin_amdgcn_s_getreg((3 << 11) | 20) & 0xFu; }
#define XB_SPIN(cond, bar) do { unsigned _sp = 0; while (cond) { __builtin_amdgcn_s_sleep(1); \
    if ((++_sp & 255u) == 0u) { if (xb_ld(&(bar)[XB_TMO])) break; if (_sp > XB_SPIN_CAP) { atomicAdd(&(bar)[XB_TMO], 1u); break; } } } } while (0)

struct XcdBarrier {
    unsigned* bar; unsigned x;
    volatile LAS unsigned* st;
};

__device__ __forceinline__ XcdBarrier xcd_barrier_post(unsigned* bar, volatile LAS unsigned* st) {
    XcdBarrier b; b.bar = bar; b.x = xb_xcc_id(); b.st = st;
    if (threadIdx.x == 0) (void)xb_add(&bar[XB_XCNT(b.x)], 1u);
    return b;
}
__device__ __forceinline__ void xcd_barrier_complete(unsigned* bar, unsigned x, unsigned& nloc, unsigned& nx) {
    const unsigned G = gridDim.x * gridDim.y * gridDim.z;
    unsigned sum, cnt, mine, sp = 0u;
    for (;;) {
        sum = 0u; cnt = 0u; mine = 0u;
#pragma unroll
        for (unsigned j = 0; j < 16; ++j) { const unsigned c = xb_ld(&bar[XB_XCNT(j)]); sum += c; cnt += (c > 0u) ? 1u : 0u; mine = (j == x) ? c : mine; }
        if (sum == G) break;
        __builtin_amdgcn_s_sleep(1);
        if ((++sp & 255u) == 0u) { if (xb_ld(&bar[XB_TMO])) break; if (sp > XB_SPIN_CAP) { atomicAdd(&bar[XB_TMO], 1u); break; } }
    }
    nloc = mine > 0u ? mine : 1u; nx = cnt > 0u ? cnt : 1u;
}

__device__ __forceinline__ void xcd_barrier(const XcdBarrier& b) {
    asm volatile("s_waitcnt vmcnt(0)" ::: "memory");
    __syncthreads();
    if (threadIdx.x == 0) {
        unsigned* bar = b.bar;
        __builtin_amdgcn_s_waitcnt(0);
        unsigned nloc = b.st[0], nx = b.st[1];
        if (nloc == 0u) { xcd_barrier_complete(bar, b.x, nloc, nx); b.st[0] = nloc; b.st[1] = nx; }
        const unsigned old = xb_add(&bar[XB_XSUB(b.x)], 1u);
        const unsigned gen = old / nloc;
        if (old + 1u == (gen + 1u) * nloc) {
            __builtin_amdgcn_fence(__ATOMIC_RELEASE, "agent");
            asm volatile("s_waitcnt vmcnt(0)" ::: "memory");
            const unsigned og = xb_add(&bar[XB_TOP], 1u);
            const unsigned tg = og / nx;
            if (og + 1u == (tg + 1u) * nx) xb_add(&bar[XB_TOPGEN], 1u);
            else XB_SPIN(xb_ld(&bar[XB_TOPGEN]) == tg, bar);
            __builtin_amdgcn_fence(__ATOMIC_ACQUIRE, "agent");
            xb_add(&bar[XB_XGEN(b.x)], 1u);
            asm volatile("s_waitcnt vmcnt(0)" ::: "memory");
        } else {
            XB_SPIN(xb_ld(&bar[XB_XGEN(b.x)]) == gen, bar);
            __builtin_amdgcn_fence(__ATOMIC_ACQUIRE, "agent");
            asm volatile("s_waitcnt vmcnt(0)" ::: "memory");
        }
    }
    __syncthreads();
}
struct Frame {
    LAS unsigned char* lds;
    volatile LAS unsigned* MISC;
    gu32* ctl;
    int tid, lane, wave;
    int vcu, G;
    const float* in[23]; float* out; unsigned char* ws;
};
enum { I_X = 0, I_C, I_WADA, I_BADA, I_GPRE, I_GPOST, I_WIN, I_WOUT, I_MU, I_W0, I_WW2, I_A0, I_WA2, I_KK, I_KA, I_RK, I_LNW, I_LNB, I_LQ1, I_LK1, I_LQ2, I_LK2, I_SUBLN };

typedef float f32x2c_t __attribute__((ext_vector_type(2))); typedef __bf16 bf16x2c_t __attribute__((ext_vector_type(2)));
__device__ __forceinline__ unsigned cvtpk(float lo, float hi) { f32x2c_t v = {lo, hi}; bf16x2c_t b = __builtin_convertvector(v, bf16x2c_t); return __builtin_bit_cast(unsigned, b); }
__device__ __forceinline__ float bf2f(unsigned short v) { return __builtin_bit_cast(float, (unsigned)v << 16); }
__device__ __forceinline__ float bflo(unsigned v) { return __builtin_bit_cast(float, v << 16); }
__device__ __forceinline__ float bfhi(unsigned v) { return __builtin_bit_cast(float, v & 0xffff0000u); }
__device__ __forceinline__ float sigmoidf_(float x) { return 1.f / (1.f + __expf(-x)); }
__device__ __forceinline__ float siluf_(float x) { return x / (1.f + __expf(-x)); }
__device__ __forceinline__ float silu_fast(float x) { return x * __builtin_amdgcn_rcpf(1.f + __builtin_amdgcn_exp2f(-1.4426950408889634f * x)); }

__device__ __forceinline__ float wave_sum(float v) {
#pragma unroll
    for (int o = 1; o < 64; o <<= 1) v += __shfl_xor(v, o);
    return v;
}
__device__ __forceinline__ float sum8_dpp(float v) { v += __builtin_bit_cast(float, __builtin_amdgcn_update_dpp(0, __builtin_bit_cast(int, v), 0xB1, 0xf, 0xf, true)); v += __builtin_bit_cast(float, __builtin_amdgcn_update_dpp(0, __builtin_bit_cast(int, v), 0x4E, 0xf, 0xf, true));
    v += __builtin_bit_cast(float, __builtin_amdgcn_update_dpp(0, __builtin_bit_cast(int, v), 0x141, 0xf, 0xf, true)); return v; }
__device__ __forceinline__ float sum16_dpp(float v) { v = sum8_dpp(v); v += __builtin_bit_cast(float, __builtin_amdgcn_update_dpp(0, __builtin_bit_cast(int, v), 0x140, 0xf, 0xf, true)); return v; }
__device__ __forceinline__ int win_col(int n) { return n < 1536 ? n : (n < 2048 ? 1664 + (n - 1536) : (n < 4096 ? 2176 + (n - 2048) : 1536 + (n - 4096))); }
template <bool IMG = false> __device__ __forceinline__ void p0_transpose_item(const float* W, int K, int N, bf16* WT, int k0, int src_col0, int dst_row0, LAS float* scr, int lane) {
#pragma unroll 8
    for (int i = 0; i < 32; ++i) { const int kk = 2 * i + (lane >> 5); scr[kk * 33 + (lane & 31)] = W[(size_t)(k0 + kk) * N + src_col0 + (lane & 31)]; }
    LDS_WAIT(); asm volatile("" ::: "memory");
    const int c = lane & 7;
#pragma unroll
    for (int j = 0; j < 4; ++j) { const int n = (lane >> 3) + 8 * j; const LAS float* s = scr + (8 * c) * 33 + n;
        v4u o; o.x = cvtpk(s[0 * 33], s[1 * 33]); o.y = cvtpk(s[2 * 33], s[3 * 33]); o.z = cvtpk(s[4 * 33], s[5 * 33]); o.w = cvtpk(s[6 * 33], s[7 * 33]);
        if (IMG) { const int nn = dst_row0 + n, kk_ = k0 + 8 * c; *(GAS v4u*)((char*)WT + ((size_t)(((nn >> 4) * 32 + (kk_ >> 5)) * 64 + ((kk_ >> 3) & 3) * 16 + (nn & 15))) * 16) = o; }
        else *(GAS v4u*)(WT + (size_t)(dst_row0 + n) * K + k0 + 8 * c) = o; }
    LDS_WAIT(); asm volatile("" ::: "memory");
}
__device__ __forceinline__ void p0_mod_item(Frame& F, int item) {
    const float* c = F.in[I_C]; const float* wada = F.in[I_WADA]; const float* bada = F.in[I_BADA]; float* mod = (float*)(F.ws + WS_MOD);
    const int col = item * 4;
    f32x4 acc[4] = {{0.f, 0.f, 0.f, 0.f}, {0.f, 0.f, 0.f, 0.f}, {0.f, 0.f, 0.f, 0.f}, {0.f, 0.f, 0.f, 0.f}};
    f32x4 wv[16];
#pragma unroll
    for (int i = 0; i < 16; ++i) wv[i] = *(const f32x4*)(wada + (size_t)(F.lane + 64 * i) * 3072 + col);
#pragma unroll
    for (int i = 0; i < 16; ++i) { const int k = F.lane + 64 * i;
#pragma unroll
        for (int b = 0; b < 4; ++b) acc[b] += siluf_(c[b * D + k]) * wv[i]; }
#pragma unroll
    for (int b = 0; b < 4; ++b)
#pragma unroll
        for (int i = 0; i < 4; ++i) acc[b][i] = wave_sum(acc[b][i]);
    if (F.lane == 0) {
        const f32x4 bv = *(const f32x4*)(bada + col);
#pragma unroll
        for (int b = 0; b < 4; ++b) *(f32x4*)(mod + b * 3072 + col) = acc[b] + bv;
    }
}
__device__ __forceinline__ void p0_prologue(Frame& F) {
    LAS float* scr = (LAS float*)(F.lds + RING_OFF + F.wave * 16384);
    const int gw = F.vcu * NWAVES + F.wave, NGW = F.G * NWAVES;
    constexpr int I_MOD = 3072 / 4, I_IN = (D / 64) * (D_IN / 32), I_OUT = (D / 64) * (D / 32), I_W2 = 512 / 32;
    constexpr int NITEMS = I_MOD + I_IN + I_OUT + 2 * I_W2;
    bf16* WinT = (bf16*)(F.ws + WS_WIN); bf16* WoutT = (bf16*)(F.ws + WS_WOUT);
    for (int it = gw; it < NITEMS; it += NGW) {
        int r = it;
        if (r < I_MOD) { p0_mod_item(F, r); continue; } r -= I_MOD;
        if (r < I_IN) { const int nblk = D_IN / 32, kb = r / nblk, nb = r % nblk; p0_transpose_item(F.in[I_WIN], D, D_IN, WinT, 64 * kb, win_col(32 * nb), 32 * nb, scr, F.lane); continue; } r -= I_IN;
        if (r < I_OUT) { const int nblk = D / 32, kb = r / nblk, nb = r % nblk; p0_transpose_item<true>(F.in[I_WOUT], D, D, WoutT, 64 * kb, 32 * nb, 32 * nb, scr, F.lane); continue; } r -= I_OUT;
        { const int which = r / I_W2, nb = r % I_W2; p0_transpose_item(F.in[which ? I_WA2 : I_WW2], 64, 512, (bf16*)(F.ws + WS_W2T) + (size_t)which * 512 * 64, 0, 32 * nb, 32 * nb, scr, F.lane); }
    }
}
__device__ __forceinline__ void p1_rows(Frame& F) {
    const int gw = F.vcu * NWAVES + F.wave, NGW = F.G * NWAVES;
    const float* x = F.in[I_X]; const float* gpre = F.in[I_GPRE]; const float* mod = (const float*)(F.ws + WS_MOD); bf16* XN = (bf16*)(F.ws + WS_XN);
    for (int m0 = gw; m0 < M; m0 += 8 * NGW) {
        f32x4 v[8][4];
#pragma unroll
        for (int r = 0; r < 8; ++r) { const int m = m0 + r * NGW; if (m < M) { const GAS f32x4* xr = (const GAS f32x4*)(x + (size_t)m * D) + F.lane;
#pragma unroll
            for (int j = 0; j < 4; ++j) v[r][j] = __builtin_nontemporal_load(xr + 64 * j); } }
#pragma unroll
        for (int r = 0; r < 8; ++r) { const int m = m0 + r * NGW; if (m < M) { const int b = m / T; float s = 0.f;
#pragma unroll
            for (int j = 0; j < 4; ++j) s += (v[r][j].x * v[r][j].x + v[r][j].y * v[r][j].y) + (v[r][j].z * v[r][j].z + v[r][j].w * v[r][j].w);
            const float rstd = __builtin_amdgcn_rsqf(wave_sum(s) * (1.f / D) + RMS_EPS);
            GAS unsigned long long* o8 = (GAS unsigned long long*)(XN + (size_t)m * D) + F.lane;
#pragma unroll
            for (int j = 0; j < 4; ++j) { const int col = 4 * F.lane + 256 * j;
                const f32x4 g = *(const f32x4*)(gpre + col), sh = *(const f32x4*)(mod + b * 3072 + col), sc = *(const f32x4*)(mod + b * 3072 + 1024 + col);
                const f32x4 h = v[r][j] * rstd * g * (sc + 1.f) + sh;
                o8[64 * j] = (unsigned long long)cvtpk(h[0], h[1]) | ((unsigned long long)cvtpk(h[2], h[3]) << 32); } } }
    }
}
__device__ __forceinline__ void glds16f(const void* gsrc, unsigned lds_dst) { unsigned keep;
    asm volatile("s_mov_b32 %0, m0\n\ts_mov_b32 m0, %2\n\ts_nop 0\n\tglobal_load_lds_dwordx4 %1, off\n\ts_mov_b32 m0, %0" : "=&s"(keep) : "v"(gsrc), "s"(lds_dst) : "memory"); }
__device__ __forceinline__ void glds4f(const void* gsrc, unsigned lds_dst) { unsigned keep;
    asm volatile("s_mov_b32 %0, m0\n\ts_mov_b32 m0, %2\n\ts_nop 0\n\tglobal_load_lds_dword %1, off\n\ts_mov_b32 m0, %0" : "=&s"(keep) : "v"(gsrc), "s"(lds_dst) : "memory"); }
__device__ __forceinline__ void p2_lora(Frame& F) {
    typedef float f32x4_ __attribute__((ext_vector_type(4)));
    const bf16* XN = (const bf16*)(F.ws + WS_XN); const bf16* Wl = (const bf16*)(F.ws + WS_WIN) + (size_t)NMAIN * D; bf16* LO = (bf16*)(F.ws + WS_LO);
    const int fr = F.lane & 15, fq = F.lane >> 4, w = F.wave;
    const unsigned lds0 = (unsigned)(uintptr_t)(F.lds + RING_OFF);
    for (int unit = F.vcu; unit < M / 64; unit += F.G) {
        const int row0 = unit * 64;
        const bf16* bp = Wl + (size_t)(w * 16 + fr) * D + fq * 8;
        bf16x8 bb[32];
#pragma unroll
        for (int k = 0; k < 32; ++k) bb[k] = *(const bf16x8*)(bp + k * 32);
#pragma unroll
        for (int j = 0; j < 16; ++j) { const int p = w + 8 * j, ks = p >> 2, rt = p & 3;
            glds16f(XN + (size_t)(row0 + rt * 16 + fr) * D + ks * 32 + fq * 8, (unsigned)__builtin_amdgcn_readfirstlane(lds0 + p * 1024)); }
        f32x4_ acc[4] = {{0.f, 0.f, 0.f, 0.f}, {0.f, 0.f, 0.f, 0.f}, {0.f, 0.f, 0.f, 0.f}, {0.f, 0.f, 0.f, 0.f}};
#define LORA_STAGE(s_, cnt_) do { asm volatile("s_waitcnt vmcnt(" #cnt_ ")" ::: "memory"); __builtin_amdgcn_s_barrier(); asm volatile("" ::: "memory"); \
            _Pragma("unroll") for (int k = 0; k < 8; ++k) { const int ks = (s_) * 8 + k; \
                _Pragma("unroll") for (int rt = 0; rt < 4; ++rt) { const bf16x8 a = *(const LAS bf16x8*)(F.lds + RING_OFF + (4 * ks + rt) * 1024 + F.lane * 16); \
                    acc[rt] = __builtin_amdgcn_mfma_f32_16x16x32_bf16(bb[ks], a, acc[rt], 0, 0, 0); } } } while (0)
        LORA_STAGE(0, 12); LORA_STAGE(1, 8); LORA_STAGE(2, 4); LORA_STAGE(3, 0);
#undef LORA_STAGE
#pragma unroll
        for (int rt = 0; rt < 4; ++rt) { const unsigned long long o = (unsigned long long)cvtpk(acc[rt][0], acc[rt][1]) | ((unsigned long long)cvtpk(acc[rt][2], acc[rt][3]) << 32);
            *(GAS unsigned long long*)(LO + (size_t)(row0 + rt * 16 + fr) * 128 + w * 16 + 4 * fq) = o; }
        LDS_WAIT(); __builtin_amdgcn_s_barrier();
    }
}
__device__ __forceinline__ float tshift(float cur, float prev, float mu) { return cur + (prev - cur) * mu; }

constexpr int REC_WA = 0, REC_RA = 2048, REC_AR = 4096, REC_BK = 5120, REC_VT = 9216, REC_MAK = 11264, REC_G = 11776, REC_BYTES = 12032;
constexpr int NCHUNK = T / 16;
constexpr int REC1_N = (int)((32 * MiB) / REC_BYTES);
static_assert((size_t)(BATCH * RW_H * NCHUNK - REC1_N) * REC_BYTES <= 65 * MiB, "record regions");
__device__ __forceinline__ unsigned char* rec_ptr(unsigned char* ws, int b, int h, int chunk) {
    const int idx = (b * RW_H + h) * NCHUNK + chunk;
    return idx < REC1_N ? ws + WS_REC1 + (size_t)idx * REC_BYTES : ws + WS_REC2 + (size_t)(idx - REC1_N) * REC_BYTES;
}
constexpr int PW_KAP = 0, PW_RH = 2304, PW_BH = 4608, PW_KH = 6912, PW_AAB = 9216, PW_AAK = 10496, PW_TM = 11776;
constexpr int PWS = 72;
static_assert(PW_TM + 16 * 20 * 4 <= 13312 && 2 * 16 * 68 * 4 <= PW_AAB, "prep scratch");

constexpr int PWB = 13312;
constexpr int PT_S = 68;
__device__ __forceinline__ float fast_exp(float x) { return __builtin_amdgcn_exp2f(x * LOG2E); }
__device__ __forceinline__ float fast_sigmoid(float x) { return __builtin_amdgcn_rcpf(1.f + fast_exp(-x)); }
__device__ __forceinline__ float fast_tanh(float x) { const float e = fast_exp(-2.f * fabsf(x)); const float t = (1.f - e) * __builtin_amdgcn_rcpf(1.f + e); return x < 0.f ? -t : t; }
__device__ __forceinline__ void p3_prep(Frame& F) {
    typedef float f32x4_ __attribute__((ext_vector_type(4)));
    const bf16* LO = (const bf16*)(F.ws + WS_LO); const bf16* Urk = (const bf16*)(F.ws + WS_URK); const bf16* Uvg = (const bf16*)(F.ws + WS_UVG); float* BON = (float*)(F.ws + WS_BONUS);
    const bf16* W2T = (const bf16*)(F.ws + WS_W2T);
    const float* mu = F.in[I_MU];
    LAS unsigned char* pw = F.lds + RING_OFF + F.wave * PWB;
    const int c = F.tid, lane = F.lane, h = F.wave, fi = lane & 15, fg = lane >> 4;
    const float k_k = F.in[I_KK][c], k_a = F.in[I_KA][c], r_k = F.in[I_RK][c], mu_r = mu[c], mu_k = mu[512 + c], mu_v = mu[1024 + c];
    float w0c[4], a0c[4];
#pragma unroll
    for (int nt = 0; nt < 4; ++nt) { w0c[nt] = F.in[I_W0][h * 64 + nt * 16 + fi]; a0c[nt] = F.in[I_A0][h * 64 + nt * 16 + fi]; }
    for (int tile = F.vcu; tile < M / 16; tile += F.G) {
        const int m0 = tile * 16, b = m0 / T, chunk = (m0 % T) / 16; const bool firstc = (chunk == 0);
        unsigned char* rec = rec_ptr(F.ws, b, h, chunk);
        unsigned short rw_[17], kw_[17], vw_[17];
#pragma unroll
        for (int i = 0; i < 17; ++i) { const size_t m = (size_t)(m0 + i - 1);
            if (i == 0 && firstc) { rw_[0] = 0; kw_[0] = 0; vw_[0] = 0; }
            else { rw_[i] = Urk[m * UP + c]; kw_[i] = Urk[m * UP + 512 + c]; vw_[i] = Uvg[m * UP + c]; } }
        float lw2[16], av[16];
        {
            bf16x8 fw[2], fa[2];
#pragma unroll
            for (int ks = 0; ks < 2; ++ks) {
                const bf16* lp = LO + (size_t)(m0 + fi) * 128 + ks * 32 + fg * 8; const bool nz = !(firstc && fi == 0);
                const v4u cw_ = *(const GAS v4u*)lp, ca_ = *(const GAS v4u*)(lp + 64);
                v4u pw_ = {0u, 0u, 0u, 0u}, pa_ = pw_; if (nz) { pw_ = *(const GAS v4u*)(lp - 128); pa_ = *(const GAS v4u*)(lp - 64); }
                const f32x4_ m0w = *(const f32x4_*)(mu + 1536 + ks * 32 + fg * 8), m1w = *(const f32x4_*)(mu + 1536 + ks * 32 + fg * 8 + 4), m0a = *(const f32x4_*)(mu + 1600 + ks * 32 + fg * 8), m1a = *(const f32x4_*)(mu + 1600 + ks * 32 + fg * 8 + 4);
                v4u ow, oa;
#pragma unroll
                for (int u = 0; u < 4; ++u) { const float mwl = (u < 2 ? m0w : m1w)[(2 * u) & 3], mwh = (u < 2 ? m0w : m1w)[(2 * u + 1) & 3], mal = (u < 2 ? m0a : m1a)[(2 * u) & 3], mah = (u < 2 ? m0a : m1a)[(2 * u + 1) & 3];
                    ow[u] = cvtpk(fast_tanh(tshift(bflo(cw_[u]), bflo(pw_[u]), mwl)), fast_tanh(tshift(bfhi(cw_[u]), bfhi(pw_[u]), mwh)));
                    oa[u] = cvtpk(tshift(bflo(ca_[u]), bflo(pa_[u]), mal), tshift(bfhi(ca_[u]), bfhi(pa_[u]), mah)); }
                fw[ks] = __builtin_bit_cast(bf16x8, ow); fa[ks] = __builtin_bit_cast(bf16x8, oa); }
            f32x4_ cw[4], ca[4];
#pragma unroll
            for (int nt = 0; nt < 4; ++nt) { cw[nt] = (f32x4_){0.f, 0.f, 0.f, 0.f}; ca[nt] = cw[nt]; }
#pragma unroll
            for (int nt = 0; nt < 4; ++nt)
#pragma unroll
                for (int ks = 0; ks < 2; ++ks) { const size_t o = (size_t)(h * 64 + nt * 16 + fi) * 64 + ks * 32 + fg * 8;
                    const bf16x8 bw = *(const bf16x8*)(W2T + o), ba = *(const bf16x8*)(W2T + 512 * 64 + o);
                    cw[nt] = __builtin_amdgcn_mfma_f32_16x16x32_bf16(fw[ks], bw, cw[nt], 0, 0, 0); ca[nt] = __builtin_amdgcn_mfma_f32_16x16x32_bf16(fa[ks], ba, ca[nt], 0, 0, 0); }
            LAS float* t1 = (LAS float*)pw; LAS float* t2 = t1 + 16 * PT_S;
#pragma unroll
            for (int nt = 0; nt < 4; ++nt)
#pragma unroll
                for (int j = 0; j < 4; ++j) { const float x_ = w0c[nt] + cw[nt][j];
                    t1[(4 * fg + j) * PT_S + nt * 16 + fi] = -0.8750403856f * fast_sigmoid(x_);
                    t2[(4 * fg + j) * PT_S + nt * 16 + fi] = fast_sigmoid(a0c[nt] + ca[nt][j]); }
            LDS_WAIT(); asm volatile("" ::: "memory");
#pragma unroll
            for (int i = 0; i < 16; ++i) { lw2[i] = t1[i * PT_S + lane]; av[i] = t2[i * PT_S + lane]; }
            LDS_WAIT(); asm volatile("" ::: "memory");
        }
        float kap[16], cl[16];
        {
        float rr[16], kt[16], kk[16], bb[16];
        LAS float* r1 = (LAS float*)pw; LAS float* r2 = r1 + 16 * PT_S; LAS float* s1 = (LAS float*)(pw + PW_TM);
        {
        float vv[16];
#pragma unroll
        for (int i = 0; i < 16; ++i) {
            const float r = tshift(bf2f(rw_[i + 1]), bf2f(rw_[i]), mu_r), k = tshift(bf2f(kw_[i + 1]), bf2f(kw_[i]), mu_k);
            vv[i] = tshift(bf2f(vw_[i + 1]), bf2f(vw_[i]), mu_v);
            const float kkr = k * k_k; kk[i] = kkr; kt[i] = k * (1.f + (av[i] - 1.f) * k_a); rr[i] = r;
            r1[i * PT_S + lane] = kkr * kkr; r2[i * PT_S + lane] = r * kt[i] * r_k; }
#pragma unroll
        for (int g = 0; g < 4; ++g) { const unsigned long long o = (unsigned long long)cvtpk(vv[4 * g], vv[4 * g + 1]) | ((unsigned long long)cvtpk(vv[4 * g + 2], vv[4 * g + 3]) << 32);
            *(GAS unsigned long long*)(rec + REC_VT + (lane >> 4) * 512 + (g * 16 + (lane & 15)) * 8) = o; }
        }
        LDS_WAIT(); asm volatile("" ::: "memory");
        { const int i = lane >> 2, q = lane & 3; float sa = 0.f, sb = 0.f;
#pragma unroll
          for (int u = 0; u < 4; ++u) { const f32x4_ x = *(const LAS f32x4_*)(r1 + i * PT_S + 16 * q + 4 * u), y = *(const LAS f32x4_*)(r2 + i * PT_S + 16 * q + 4 * u); sa += (x[0] + x[1]) + (x[2] + x[3]); sb += (y[0] + y[1]) + (y[2] + y[3]); }
          sa += __shfl_xor(sa, 1); sa += __shfl_xor(sa, 2); sb += __shfl_xor(sb, 1); sb += __shfl_xor(sb, 2);
          if (q == 0) { s1[i] = sa; BON[(m0 + i) * 8 + h] = sb; } }
        LDS_WAIT(); asm volatile("" ::: "memory");
        float run = 0.f;
#pragma unroll
        for (int i = 0; i < 16; ++i) { kk[i] = kk[i] * __builtin_amdgcn_rcpf(fmaxf(__builtin_amdgcn_sqrtf(s1[i]), 1e-12f)); bb[i] = av[i] * kk[i]; run += lw2[i]; cl[i] = run; }
        LDS_WAIT(); asm volatile("" ::: "memory");
        LAS unsigned short* okap = (LAS unsigned short*)(pw + PW_KAP); LAS unsigned short* orh = (LAS unsigned short*)(pw + PW_RH);
        LAS unsigned short* obh = (LAS unsigned short*)(pw + PW_BH); LAS unsigned short* okh = (LAS unsigned short*)(pw + PW_KH);
        const float cl15 = cl[15];
#pragma unroll
        for (int g = 0; g < 4; ++g) { float kd[4], nbd[4];
#pragma unroll
            for (int u = 0; u < 4; ++u) { const int i = 4 * g + u;
                const float e = __builtin_amdgcn_exp2f(cl[i]), em1 = (i == 0) ? 1.f : __builtin_amdgcn_exp2f(cl[i - 1]), inv = __builtin_amdgcn_exp2f(-cl[i]), eL = __builtin_amdgcn_exp2f(cl15 - cl[i]);
                kap[i] = kk[i] * em1; const float rh = rr[i] * e, kh = kt[i] * inv, bh = bb[i] * inv; kd[u] = kt[i] * eL; nbd[u] = -bb[i] * eL;
                okap[i * PWS + lane] = (unsigned short)(cvtpk(kap[i], 0.f) & 0xffffu); orh[i * PWS + lane] = (unsigned short)(cvtpk(rh, 0.f) & 0xffffu); obh[i * PWS + lane] = (unsigned short)(cvtpk(bh, 0.f) & 0xffffu); okh[i * PWS + lane] = (unsigned short)(cvtpk(kh, 0.f) & 0xffffu); }
            v4u o; o.x = cvtpk(nbd[0], nbd[1]); o.y = cvtpk(nbd[2], nbd[3]); o.z = cvtpk(kd[0], kd[1]); o.w = cvtpk(kd[2], kd[3]);
            *(GAS v4u*)(rec + REC_BK + (lane >> 4) * 1024 + (g * 16 + (lane & 15)) * 16) = o; }
        }
        *(GAS float*)(rec + REC_G + ((((lane >> 2) & 3) * 4 + (lane >> 4)) * 4 + (lane & 3)) * 4) = __builtin_amdgcn_exp2f(cl[15]);
        LDS_WAIT(); asm volatile("" ::: "memory");
        f32x4_ sab = {0.f, 0.f, 0.f, 0.f}, sak = sab, srb = sab, srk = sab;
#pragma unroll
        for (int ks = 0; ks < 2; ++ks) { const int off = (fi * PWS + ks * 32 + fg * 8) * 2;
            const bf16x8 fk = *(const LAS bf16x8*)(pw + PW_KAP + off), fr_ = *(const LAS bf16x8*)(pw + PW_RH + off), fb = *(const LAS bf16x8*)(pw + PW_BH + off), fh = *(const LAS bf16x8*)(pw + PW_KH + off);
            sab = __builtin_amdgcn_mfma_f32_16x16x32_bf16(fk, fb, sab, 0, 0, 0); sak = __builtin_amdgcn_mfma_f32_16x16x32_bf16(fk, fh, sak, 0, 0, 0);
            srb = __builtin_amdgcn_mfma_f32_16x16x32_bf16(fr_, fb, srb, 0, 0, 0); srk = __builtin_amdgcn_mfma_f32_16x16x32_bf16(fr_, fh, srk, 0, 0, 0); }
        LAS float* Aab = (LAS float*)(pw + PW_AAB); LAS float* Aak = (LAS float*)(pw + PW_AAK); LAS float* Tm = (LAS float*)(pw + PW_TM);
        LAS unsigned short* arimg = (LAS unsigned short*)(pw + PW_BH);
        asm volatile("" ::: "memory");
#pragma unroll
        for (int j = 0; j < 4; ++j) { const int i = 4 * fg + j;
            Aab[i * 20 + fi] = (fi < i) ? sab[j] : 0.f; Aak[i * 20 + fi] = (fi < i) ? sak[j] : 0.f;
            const float nrb = (fi <= i) ? -srb[j] : 0.f, rk = (fi <= i) ? srk[j] : 0.f; const unsigned pk = cvtpk(nrb, rk);
            arimg[((fi >> 2) * 16 + i) * 8 + (fi & 3)] = (unsigned short)(pk & 0xffffu); arimg[((fi >> 2) * 16 + i) * 8 + 4 + (fi & 3)] = (unsigned short)(pk >> 16); }
        LDS_WAIT(); asm volatile("" ::: "memory");
        *(GAS v4u*)(rec + REC_AR + lane * 16) = *(const LAS v4u*)(pw + PW_BH + lane * 16);
        float tc[16];
#pragma unroll
        for (int i = 0; i < 16; ++i) { float acc = (i == fi) ? 1.f : 0.f;
#pragma unroll
            for (int j4 = 0; j4 < i; j4 += 4) { const f32x4_ ar_ = *(const LAS f32x4_*)(Aab + i * 20 + j4);
#pragma unroll
                for (int u = 0; u < 4; ++u) if (j4 + u < i) acc -= ar_[u] * tc[j4 + u]; }
            tc[i] = acc; }
        if (fg == 0) {
#pragma unroll
            for (int i = 0; i < 16; ++i) Tm[i * 20 + fi] = tc[i]; }
        LDS_WAIT(); asm volatile("" ::: "memory");
        { LAS unsigned short* okap = (LAS unsigned short*)(pw + PW_KAP);
#pragma unroll
        for (int i = 0; i < 16; ++i) { float acc = 0.f;
#pragma unroll
            for (int j4 = 0; j4 <= i; j4 += 4) { const f32x4_ tr_ = *(const LAS f32x4_*)(Tm + i * 20 + j4);
#pragma unroll
                for (int u = 0; u < 4; ++u) if (j4 + u <= i) acc += tr_[u] * kap[j4 + u]; }
            okap[i * PWS + lane] = (unsigned short)(cvtpk(acc, 0.f) & 0xffffu); } }
        { const int i = lane >> 2, q = lane & 3; f32x4_ acc = {0.f, 0.f, 0.f, 0.f};
#pragma unroll
          for (int j4 = 0; j4 < 16; j4 += 4) { const f32x4_ tr_ = *(const LAS f32x4_*)(Tm + i * 20 + j4);
#pragma unroll
              for (int u = 0; u < 4; ++u) acc += tr_[u] * *(const LAS f32x4_*)(Aak + (j4 + u) * 20 + 4 * q); }
          *(GAS unsigned long long*)(rec + REC_MAK + (q * 16 + i) * 8) = (unsigned long long)cvtpk(acc[0], acc[1]) | ((unsigned long long)cvtpk(acc[2], acc[3]) << 32); }
        LDS_WAIT(); asm volatile("" ::: "memory");
#pragma unroll
        for (int ks = 0; ks < 2; ++ks) { const int off = (fi * PWS + ks * 32 + 4 * fg) * 2;
            const unsigned long long w0_ = *(const LAS unsigned long long*)(pw + PW_KAP + off), w1_ = *(const LAS unsigned long long*)(pw + PW_KAP + off + 32);
            const unsigned long long r0_ = *(const LAS unsigned long long*)(pw + PW_RH + off), r1_ = *(const LAS unsigned long long*)(pw + PW_RH + off + 32);
            v4u o; o.x = (unsigned)w0_; o.y = (unsigned)(w0_ >> 32); o.z = (unsigned)w1_; o.w = (unsigned)(w1_ >> 32);
            *(GAS v4u*)(rec + REC_WA + ks * 1024 + lane * 16) = o;
            o.x = (unsigned)r0_; o.y = (unsigned)(r0_ >> 32); o.z = (unsigned)r1_; o.w = (unsigned)(r1_ >> 32);
            *(GAS v4u*)(rec + REC_RA + ks * 1024 + lane * 16) = o; }
        LDS_WAIT(); asm volatile("" ::: "memory");
    }
}
constexpr int SCAN_NS = 8;
__device__ __forceinline__ void p4_scan(Frame& F) {
    typedef float f32x4_ __attribute__((ext_vector_type(4)));
    const int si = (int)blockIdx.x;
    if (si >= BATCH * RW_H) return;
    const int b = si / RW_H, h = si % RW_H, lane = F.lane, w = F.wave;
    const unsigned lds0 = (unsigned)(uintptr_t)(F.lds + RING_OFF);
    if (w >= 4) {
        const int lw = w - 4;
#define SCAN_ISSUE(n) do { const int n_ = (n) < NCHUNK ? (n) : NCHUNK - 1; const unsigned char* rp = rec_ptr(F.ws, b, h, n_); const unsigned sb = lds0 + (unsigned)(((n) % SCAN_NS) * REC_BYTES); \
            glds16f(rp + lw * 1024 + lane * 16, (unsigned)__builtin_amdgcn_readfirstlane(sb + lw * 1024)); glds16f(rp + (lw + 4) * 1024 + lane * 16, (unsigned)__builtin_amdgcn_readfirstlane(sb + (lw + 4) * 1024)); \
            if (lw < 3) { glds16f(rp + (lw + 8) * 1024 + lane * 16, (unsigned)__builtin_amdgcn_readfirstlane(sb + (lw + 8) * 1024)); glds4f(rp + 11264 + lw * 256 + lane * 4, (unsigned)__builtin_amdgcn_readfirstlane(sb + 11264 + lw * 256)); } } while (0)
        for (int n = 0; n < SCAN_NS - 1; ++n) SCAN_ISSUE(n);
        for (int n = 0; n < NCHUNK; ++n) {
            if (lw < 3) asm volatile("s_waitcnt vmcnt(24)" ::: "memory"); else asm volatile("s_waitcnt vmcnt(12)" ::: "memory");
            __builtin_amdgcn_s_barrier(); asm volatile("" ::: "memory");
            SCAN_ISSUE(n + SCAN_NS - 1);
        }
        asm volatile("s_waitcnt vmcnt(0)" ::: "memory");
        __builtin_amdgcn_s_barrier();
#undef SCAN_ISSUE
        return;
    }
    bf16* Orw = (bf16*)(F.ws + WS_ORW);
    const int fc = lane & 15, fg = lane >> 4;
    f32x4_ H[4];
#pragma unroll
    for (int mt = 0; mt < 4; ++mt) H[mt] = (f32x4_){0.f, 0.f, 0.f, 0.f};
    bf16x8 hb0 = {0, 0, 0, 0, 0, 0, 0, 0}, hb1 = hb0;
    bf16* orow = Orw + ((size_t)b * T + 4 * fg) * 512 + h * 64 + 16 * w + fc;
    for (int n = 0; n < NCHUNK; ++n) {
        LDS_WAIT(); __builtin_amdgcn_s_barrier(); asm volatile("" ::: "memory");
        const LAS unsigned char* sb = F.lds + RING_OFF + (n % SCAN_NS) * REC_BYTES;
        typedef unsigned u32x2_ __attribute__((ext_vector_type(2)));
        const bf16x8 wa0 = *(const LAS bf16x8*)(sb + REC_WA + lane * 16), wa1 = *(const LAS bf16x8*)(sb + REC_WA + 1024 + lane * 16);
        const u32x2_ mk = *(const LAS u32x2_*)(sb + REC_MAK + lane * 8);
        const bf16x8 ra0 = *(const LAS bf16x8*)(sb + REC_RA + lane * 16), ra1 = *(const LAS bf16x8*)(sb + REC_RA + 1024 + lane * 16), ar = *(const LAS bf16x8*)(sb + REC_AR + lane * 16);
        bf16x8 bk[4]; f32x4_ gm[4];
#pragma unroll
        for (int mt = 0; mt < 4; ++mt) { bk[mt] = *(const LAS bf16x8*)(sb + REC_BK + mt * 1024 + lane * 16); gm[mt] = *(const LAS f32x4_*)(sb + REC_G + fg * 64 + mt * 16); }
        const u32x2_ vt = *(const LAS u32x2_*)(sb + REC_VT + w * 512 + lane * 8);
        const bf16x8 vz = __builtin_bit_cast(bf16x8, (v4u){0u, 0u, vt.x, vt.y}), mak = __builtin_bit_cast(bf16x8, (v4u){0u, 0u, mk.x, mk.y});
        f32x4_ U = {0.f, 0.f, 0.f, 0.f}, O = {0.f, 0.f, 0.f, 0.f};
        U = __builtin_amdgcn_mfma_f32_16x16x32_bf16(wa0, hb0, U, 0, 0, 0);
        U = __builtin_amdgcn_mfma_f32_16x16x32_bf16(wa1, hb1, U, 0, 0, 0);
        U = __builtin_amdgcn_mfma_f32_16x16x32_bf16(mak, vz, U, 0, 0, 0);
        O = __builtin_amdgcn_mfma_f32_16x16x32_bf16(ra0, hb0, O, 0, 0, 0);
        O = __builtin_amdgcn_mfma_f32_16x16x32_bf16(ra1, hb1, O, 0, 0, 0);
#pragma unroll
        for (int mt = 0; mt < 4; ++mt) H[mt] = H[mt] * gm[mt];
        const bf16x8 uv = __builtin_bit_cast(bf16x8, (v4u){cvtpk(U[0], U[1]), cvtpk(U[2], U[3]), vt.x, vt.y});
#pragma unroll
        for (int mt = 0; mt < 4; ++mt) H[mt] = __builtin_amdgcn_mfma_f32_16x16x32_bf16(bk[mt], uv, H[mt], 0, 0, 0);
        O = __builtin_amdgcn_mfma_f32_16x16x32_bf16(ar, uv, O, 0, 0, 0);
        hb0 = __builtin_bit_cast(bf16x8, (v4u){cvtpk(H[0][0], H[0][1]), cvtpk(H[0][2], H[0][3]), cvtpk(H[1][0], H[1][1]), cvtpk(H[1][2], H[1][3])});
        hb1 = __builtin_bit_cast(bf16x8, (v4u){cvtpk(H[2][0], H[2][1]), cvtpk(H[2][2], H[2][3]), cvtpk(H[3][0], H[3][1]), cvtpk(H[3][2], H[3][3])});
        bf16* op = orow + (size_t)n * 16 * 512;
#pragma unroll
        for (int j = 0; j < 4; ++j) op[(size_t)j * 512] = (bf16)(cvtpk(O[j], 0.f) & 0xffffu);
    }
    LDS_WAIT(); __builtin_amdgcn_s_barrier();
}
__device__ __forceinline__ void p6_assemble(Frame& F) {
    const int gw = F.vcu * NWAVES + F.wave, NGW = F.G * NWAVES;
    const bf16* Orw = (const bf16*)(F.ws + WS_ORW); const bf16* Uvg = (const bf16*)(F.ws + WS_UVG); const bf16* Uqg = (const bf16*)(F.ws + WS_UQG); const bf16* O0 = (const bf16*)(F.ws + WS_URK); const bf16* O1 = O0 + 512;
    const float* BON = (const float*)(F.ws + WS_BONUS); bf16* Y = (bf16*)(F.ws + WS_Y);
    const float lam = __expf(wave_sum(F.in[I_LQ1][F.lane] * F.in[I_LK1][F.lane])) - __expf(wave_sum(F.in[I_LQ2][F.lane] * F.in[I_LK2][F.lane])) + LAMBDA_INIT;
    const int c0 = 8 * F.lane;
    float lw[8], lb[8], muv[8], sw[8];
#pragma unroll
    for (int i = 0; i < 8; ++i) { lw[i] = F.in[I_LNW][c0 + i]; lb[i] = F.in[I_LNB][c0 + i]; muv[i] = F.in[I_MU][1024 + c0 + i]; sw[i] = F.in[I_SUBLN][(c0 + i) & 127] * (1.f - LAMBDA_INIT); }
    for (int m = gw; m < M; m += NGW) {
        const bool first = (m % T == 0);
        const v4u ow = *(const GAS v4u*)(Orw + (size_t)m * 512 + c0), vw = *(const GAS v4u*)(Uvg + (size_t)m * UP + c0), gw_ = *(const GAS v4u*)(Uvg + (size_t)m * UP + 512 + c0);
        v4u pw = {0u, 0u, 0u, 0u}; if (!first) pw = *(const GAS v4u*)(Uvg + (size_t)(m - 1) * UP + c0);
        float o[8], v[8], g[8];
#pragma unroll
        for (int i = 0; i < 4; ++i) { o[2 * i] = bflo(ow[i]); o[2 * i + 1] = bfhi(ow[i]); g[2 * i] = bflo(gw_[i]); g[2 * i + 1] = bfhi(gw_[i]);
            v[2 * i] = tshift(bflo(vw[i]), bflo(pw[i]), muv[2 * i]); v[2 * i + 1] = tshift(bfhi(vw[i]), bfhi(pw[i]), muv[2 * i + 1]); }
        float s = 0.f;
#pragma unroll
        for (int i = 0; i < 8; ++i) s += o[i];
        s += __shfl_xor(s, 1); s += __shfl_xor(s, 2); s += __shfl_xor(s, 4);
        const float mean = s * (1.f / 64.f); float q = 0.f;
#pragma unroll
        for (int i = 0; i < 8; ++i) { o[i] -= mean; q += o[i] * o[i]; }
        q += __shfl_xor(q, 1); q += __shfl_xor(q, 2); q += __shfl_xor(q, 4);
        const float rstd = 1.f / sqrtf(q * (1.f / 64.f) + GN_EPS), bon = BON[m * 8 + (F.lane >> 3)];
        float y[8];
#pragma unroll
        for (int i = 0; i < 8; ++i) y[i] = (o[i] * rstd * lw[i] + lb[i] + bon * v[i]) * siluf_(g[i]);
        v4u yo; yo.x = pk2(y[0], y[1]); yo.y = pk2(y[2], y[3]); yo.z = pk2(y[4], y[5]); yo.w = pk2(y[6], y[7]);
        *(GAS v4u*)(Y + (size_t)m * D + c0) = yo;
        const v4u a0 = *(const GAS v4u*)(O0 + (size_t)m * 1024 + c0), a1 = *(const GAS v4u*)(O1 + (size_t)m * 1024 + c0), dgw = *(const GAS v4u*)(Uqg + (size_t)m * 1024 + 512 + c0);
        float d[8]; float ms = 0.f;
#pragma unroll
        for (int i = 0; i < 4; ++i) { d[2 * i] = bflo(a0[i]) - lam * bflo(a1[i]); d[2 * i + 1] = bfhi(a0[i]) - lam * bfhi(a1[i]); g[2 * i] = bflo(dgw[i]); g[2 * i + 1] = bfhi(dgw[i]); }
#pragma unroll
        for (int i = 0; i < 8; ++i) ms += d[i] * d[i];
        ms += __shfl_xor(ms, 1); ms += __shfl_xor(ms, 2); ms += __shfl_xor(ms, 4); ms += __shfl_xor(ms, 8);
        const float rs = 1.f / sqrtf(ms * (1.f / 128.f) + SUBLN_EPS);
#pragma unroll
        for (int i = 0; i < 8; ++i) y[i] = d[i] * rs * sw[i] * siluf_(g[i]);
        yo.x = pk2(y[0], y[1]); yo.y = pk2(y[2], y[3]); yo.z = pk2(y[4], y[5]); yo.w = pk2(y[6], y[7]);
        *(GAS v4u*)(Y + (size_t)m * D + 512 + c0) = yo;
    }
}
__device__ __forceinline__ void p67_fused(Frame& F) {
    typedef float f32x4_ __attribute__((ext_vector_type(4)));
    const bf16* Orw = (const bf16*)(F.ws + WS_ORW); const bf16* Uvg = (const bf16*)(F.ws + WS_UVG); const bf16* Uqg = (const bf16*)(F.ws + WS_UQG); const bf16* O0 = (const bf16*)(F.ws + WS_URK); const bf16* O1 = O0 + 512;
    const float* BON = (const float*)(F.ws + WS_BONUS); const unsigned char* Wimg = (const unsigned char*)(F.ws + WS_WOUT);
    const float* x = F.in[I_X]; const float* gpost = F.in[I_GPOST]; const float* mod = (const float*)(F.ws + WS_MOD);
    const int lane = F.lane, w = F.wave, fr = lane & 15, fq = lane >> 4;
    const float lam = __expf(wave_sum(F.in[I_LQ1][lane] * F.in[I_LK1][lane])) - __expf(wave_sum(F.in[I_LQ2][lane] * F.in[I_LK2][lane])) + LAMBDA_INIT;
    LAS unsigned char* A = F.lds + RING_OFF;
    {
        const int unit = F.vcu; const int r0 = unit * 64, bb = r0 / T;
        {
            const int c0 = 8 * lane;
            float lw[8], lb[8], muv[8], sw[8];
#pragma unroll
            for (int i = 0; i < 8; ++i) { lw[i] = F.in[I_LNW][c0 + i]; lb[i] = F.in[I_LNB][c0 + i]; muv[i] = F.in[I_MU][1024 + c0 + i]; sw[i] = F.in[I_SUBLN][(c0 + i) & 127] * (1.f - LAMBDA_INIT); }
            LAS unsigned char* arow = A + ((lane >> 2) * 4 + (w >> 1)) * 1024 + ((lane & 3) * 16 + 8 * (w & 1)) * 16;
#pragma unroll 2
            for (int j = 0; j < 8; ++j) { const int m = r0 + 8 * w + j; const bool first = (m % T == 0);
                const v4u ow = *(const GAS v4u*)(Orw + (size_t)m * 512 + c0), vw = *(const GAS v4u*)(Uvg + (size_t)m * UP + c0), gw_ = *(const GAS v4u*)(Uvg + (size_t)m * UP + 512 + c0);
                v4u pw = {0u, 0u, 0u, 0u}; if (!first) pw = *(const GAS v4u*)(Uvg + (size_t)(m - 1) * UP + c0);
                const v4u a0 = *(const GAS v4u*)(O0 + (size_t)m * 1024 + c0), a1 = *(const GAS v4u*)(O1 + (size_t)m * 1024 + c0), dgw = *(const GAS v4u*)(Uqg + (size_t)m * 1024 + 512 + c0);
                const float bon = BON[m * 8 + (lane >> 3)];
                float o[8], v[8], g[8];
#pragma unroll
                for (int i = 0; i < 4; ++i) { o[2 * i] = bflo(ow[i]); o[2 * i + 1] = bfhi(ow[i]); g[2 * i] = bflo(gw_[i]); g[2 * i + 1] = bfhi(gw_[i]);
                    v[2 * i] = tshift(bflo(vw[i]), bflo(pw[i]), muv[2 * i]); v[2 * i + 1] = tshift(bfhi(vw[i]), bfhi(pw[i]), muv[2 * i + 1]); }
                float s = 0.f;
#pragma unroll
                for (int i = 0; i < 8; ++i) s += o[i];
                s = sum8_dpp(s);
                const float mean = s * (1.f / 64.f); float q = 0.f;
#pragma unroll
                for (int i = 0; i < 8; ++i) { o[i] -= mean; q += o[i] * o[i]; }
                q = sum8_dpp(q);
                const float rstd = __builtin_amdgcn_rsqf(q * (1.f / 64.f) + GN_EPS);
                float y[8];
#pragma unroll
                for (int i = 0; i < 8; ++i) y[i] = (o[i] * rstd * lw[i] + lb[i] + bon * v[i]) * silu_fast(g[i]);
                *(LAS v4u*)(arow + j * 16) = (v4u){cvtpk(y[0], y[1]), cvtpk(y[2], y[3]), cvtpk(y[4], y[5]), cvtpk(y[6], y[7])};
                float d[8]; float ms = 0.f;
#pragma unroll
                for (int i = 0; i < 4; ++i) { d[2 * i] = bflo(a0[i]) - lam * bflo(a1[i]); d[2 * i + 1] = bfhi(a0[i]) - lam * bfhi(a1[i]); g[2 * i] = bflo(dgw[i]); g[2 * i + 1] = bfhi(dgw[i]); }
#pragma unroll
                for (int i = 0; i < 8; ++i) ms += d[i] * d[i];
                ms = sum16_dpp(ms);
                const float rs = __builtin_amdgcn_rsqf(ms * (1.f / 128.f) + SUBLN_EPS);
#pragma unroll
                for (int i = 0; i < 8; ++i) y[i] = d[i] * rs * sw[i] * silu_fast(g[i]);
                *(LAS v4u*)(arow + 65536 + j * 16) = (v4u){cvtpk(y[0], y[1]), cvtpk(y[2], y[3]), cvtpk(y[4], y[5]), cvtpk(y[6], y[7])}; }
        }
        __syncthreads();
        f32x4_ acc[4][8];
#pragma unroll
        for (int rt = 0; rt < 4; ++rt)
#pragma unroll
            for (int nt = 0; nt < 8; ++nt) acc[rt][nt] = (f32x4_){0.f, 0.f, 0.f, 0.f};
        const unsigned char* bp = Wimg + ((size_t)(8 * w) * 32 * 64 + lane) * 16;
        bf16x8 b0_[8], b1_[8];
#pragma unroll
        for (int nt = 0; nt < 8; ++nt) b0_[nt] = *(const bf16x8*)(bp + nt * 32768);
#define P67_STEP(BC, BN, ks_) do { \
            if ((ks_) + 1 < 32) { _Pragma("unroll") for (int nt = 0; nt < 8; ++nt) BN[nt] = *(const bf16x8*)(bp + nt * 32768 + ((ks_) + 1) * 1024); } \
            bf16x8 af[4]; _Pragma("unroll") for (int rt = 0; rt < 4; ++rt) af[rt] = *(const LAS bf16x8*)(A + ((ks_) * 4 + rt) * 1024 + lane * 16); \
            _Pragma("unroll") for (int nt = 0; nt < 8; ++nt) _Pragma("unroll") for (int rt = 0; rt < 4; ++rt) acc[rt][nt] = __builtin_amdgcn_mfma_f32_16x16x32_bf16(BC[nt], af[rt], acc[rt][nt], 0, 0, 0); } while (0)
        for (int ks = 0; ks < 32; ks += 2) { P67_STEP(b0_, b1_, ks); P67_STEP(b1_, b0_, ks + 1); }
#undef P67_STEP
        float ss[4];
#pragma unroll
        for (int rt = 0; rt < 4; ++rt) { float s_ = 0.f;
#pragma unroll
            for (int nt = 0; nt < 8; ++nt) { const f32x4_ a_ = acc[rt][nt]; s_ += (a_[0] * a_[0] + a_[1] * a_[1]) + (a_[2] * a_[2] + a_[3] * a_[3]); }
            s_ += __shfl_xor(s_, 16); s_ += __shfl_xor(s_, 32); ss[rt] = s_; }
        __syncthreads();
        LAS float* P = (LAS float*)A;
        if (fq == 0) {
#pragma unroll
            for (int rt = 0; rt < 4; ++rt) P[(rt * 16 + fr) * 8 + w] = ss[rt]; }
        __syncthreads();
        const float* grow = mod + (size_t)bb * 3072 + 2048;
        float rstd[4];
#pragma unroll
        for (int rt = 0; rt < 4; ++rt) { const int row = rt * 16 + fr; const f32x4_ p0_ = *(const LAS f32x4_*)(P + row * 8), p1_ = *(const LAS f32x4_*)(P + row * 8 + 4);
            rstd[rt] = 1.f / sqrtf(((p0_[0] + p0_[1]) + (p0_[2] + p0_[3]) + (p1_[0] + p1_[1]) + (p1_[2] + p1_[3])) * (1.f / D) + RMS_EPS); }
        LAS unsigned char* tb = A + 4096 + w * 8448;
        const int rr = lane >> 5, c4 = lane & 31, colr = 128 * w + 4 * c4;
        const f32x4_ cfr = *(const f32x4_*)(grow + colr) * *(const f32x4_*)(gpost + colr);
#pragma unroll
        for (int rt = 0; rt < 4; ++rt) {
            f32x4_ xr[8];
#pragma unroll
            for (int k = 0; k < 8; ++k) xr[k] = __builtin_nontemporal_load((const f32x4_*)(x + (size_t)(r0 + rt * 16 + 2 * k + rr) * D + colr));
#pragma unroll
            for (int nt = 0; nt < 8; ++nt) *(LAS f32x4_*)(tb + fr * 528 + (16 * nt + 4 * fq) * 4) = acc[rt][nt] * rstd[rt];
            LDS_WAIT(); asm volatile("" ::: "memory");
#pragma unroll
            for (int k = 0; k < 8; ++k) { const f32x4_ t_ = *(const LAS f32x4_*)(tb + (2 * k + rr) * 528 + c4 * 16);
                *(f32x4_*)(F.out + (size_t)(r0 + rt * 16 + 2 * k + rr) * D + colr) = xr[k] + t_ * cfr; }
            LDS_WAIT(); asm volatile("" ::: "memory");
        }
        __syncthreads();
    }
}
__device__ __forceinline__ void nan_rows_f32(Frame& F, float* out) {
    const int gw = F.vcu * NWAVES + F.wave, NGW = F.G * NWAVES; const float q = __builtin_nanf("");
    for (int m = gw; m < M; m += NGW) { GAS f32x4* o = (GAS f32x4*)(out + (size_t)m * D) + F.lane;
#pragma unroll
        for (int j = 0; j < 4; ++j) o[64 * j] = (f32x4){q, q, q, q}; }
}
__device__ __forceinline__ void wrong_grid_word(Frame& F) {
    if (blockIdx.x == 0 && F.tid == 0) { unsigned expect = 0u; __hip_atomic_compare_exchange_strong((unsigned*)(F.ctl + CW_CODE), &expect, 0x7f0u, __ATOMIC_RELAXED, __ATOMIC_RELAXED, __HIP_MEMORY_SCOPE_AGENT);
        __hip_atomic_store(F.ctl + CW_TMO, 1u, RLX_AGENT); }
}

struct Args { const float* in[23]; float* out; unsigned char* ws; int ph_lo, ph_hi, li, pad; };
__global__ void __launch_bounds__(NWAVES * 64, 2) skel_fwd(Args args) {
    extern __shared__ __attribute__((aligned(16))) unsigned char lds[];
    Frame F;
    F.lds = (LAS unsigned char*)lds;
    F.MISC = (volatile LAS unsigned*)(F.lds + MISC_OFF);
    F.tid = threadIdx.x; F.lane = F.tid & 63; F.wave = __builtin_amdgcn_readfirstlane(F.tid >> 6);
    F.G = gridDim.x; { const int bx = blockIdx.x; F.vcu = (F.G % 8 == 0) ? (bx % 8) * (F.G / 8) + bx / 8 : bx; }
#define GRID_BAR(seam) do { if (N_LAUNCHES == PER_PHASE) { if (F.tid == 0) __hip_atomic_store(F.ctl + CW_TMO, 0xBADBA0u | (unsigned)(seam), RLX_AGENT); } \
    else { xcd_barrier(bar); } } while (0)
    unsigned char* ws = args.ws; F.ws = ws;
    F.ctl = (gu32*)(ws + WS_CTL);
#pragma unroll
    for (int i = 0; i < 23; ++i) F.in[i] = args.in[i];
    F.out = args.out;
    for (int u = F.tid; u < (LDS_BYTES - LDSCTL_OFF) / 4; u += NWAVES * 64) ((LAS unsigned*)(F.lds + LDSCTL_OFF))[u] = 0u;
    __syncthreads();
    XcdBarrier bar; bar.bar = (unsigned*)(F.ctl + CW_BAR); bar.x = 0; bar.st = nullptr;
    if (N_LAUNCHES != PER_PHASE) bar = xcd_barrier_post((unsigned*)(F.ctl + CW_BAR), F.MISC + 8);

    const int lo = args.ph_lo, hi = args.ph_hi;
#define IN(k) (lo <= (k) && (k) < hi)
#define BOTH(k) (IN(k) && IN((k) + 1))

#ifndef PROBE_PHASE
#define PROBE_PHASE -1
#endif
#ifndef PROBE_REPS
#define PROBE_REPS 2
#endif
#define REPS(k) ((k) == PROBE_PHASE ? PROBE_REPS : 1)
    if (IN(0)) { for (int rep = 0; rep < REPS(0); ++rep) p0_prologue(F); if (BOTH(0)) GRID_BAR(0); }
    if (IN(1)) { for (int rep = 0; rep < REPS(1); ++rep) p1_rows(F); if (BOTH(1)) GRID_BAR(1); }
    if (PROBE_PHASE == 9) { for (int rep = 0; rep < 16; ++rep) GRID_BAR(9); }
    if (IN(2)) {
        pg8::Gemm g{(const pg8::bf16_t*)(ws + WS_XN), (const pg8::bf16_t*)(ws + WS_WIN), M, NMAIN, D}; pg8::StaticOrder S; S.init(M, NMAIN, F.G, (int)blockIdx.x);
        pg8::EpiU E{(pg8::bf16_t*)(ws + WS_URK), (pg8::bf16_t*)(ws + WS_UVG), (pg8::bf16_t*)(ws + WS_UQG), (pg8::bf16_t*)(ws + WS_KIMG), (pg8::bf16_t*)(ws + WS_VIMG), attn_body::C2, T};
        for (int rep = 0; rep < REPS(2); ++rep) pg8::gemm_phase<pg8::EpiU, pg8::StaticOrder, PG8_ALIGN, PG8_SP2>(F.lds + RING_OFF, g, S, E);
        for (int rep = 0; rep < REPS(8); ++rep) p2_lora(F);
        if (BOTH(2)) GRID_BAR(2);
    }
    if (IN(3)) { for (int rep = 0; rep < REPS(3); ++rep) p3_prep(F); if (BOTH(3)) GRID_BAR(3); }
    if (IN(4)) {
        for (int rep = 0; rep < REPS(4); ++rep) p4_scan(F);
        const attn_body::AttnTensors AT{(const attn_body::bf16*)(ws + WS_UQG), (const attn_body::bf16*)(ws + WS_KIMG), (const attn_body::bf16*)(ws + WS_VIMG), (attn_body::bf16*)(ws + WS_URK), (attn_body::bf16*)(ws + WS_URK) + 512};
        if (F.G == 256) attn_body::attn_phase_queue((char*)lds + RING_OFF, AT, (unsigned*)(F.ctl + CW_QUEUE), (int)(xb_xcc_id() & 7u), F.MISC + 16);
        if (PROBE_PHASE == 5) { GRID_BAR(5); attn_body::attn_phase_queue((char*)lds + RING_OFF, AT, (unsigned*)(F.ctl + CW_QUEUE + 512 + 64 * ((int)blockIdx.x & 7)), (int)blockIdx.x & 7, F.MISC + 16); }
        if (BOTH(4)) GRID_BAR(4);
    }
    if (IN(6)) { }
    if (IN(7)) { if (F.G == 256) p67_fused(F); else { nan_rows_f32(F, F.out); wrong_grid_word(F); } }
#undef IN
#undef BOTH
}

extern "C" void kernel_launch(void* const* d_in, const int* in_sizes, int n_in, void* d_out, int out_size, void* d_ws, size_t ws_size, hipStream_t stream) {
    static int grid = 0;
    if (grid == 0) {
        if (n_in != 23 || in_sizes[0] != M * D || out_size != M * D || ws_size < WS_END) { fprintf(stderr, "kernel_launch: built for 23 inputs, x and out of %d floats, >= %zu bytes of workspace; got n_in %d, in0 %d, out %d, ws %zu; nothing launched\n", M * D, (size_t)WS_END, n_in, n_in > 0 ? in_sizes[0] : -1, out_size, ws_size); grid = -1; return; }
        int dev = 0, cus = 0, per_cu = 0;
        if (hipGetDevice(&dev) != hipSuccess || hipDeviceGetAttribute(&cus, hipDeviceAttributeMultiprocessorCount, dev) != hipSuccess) { fprintf(stderr, "kernel_launch: hipGetDevice / hipDeviceGetAttribute failed; nothing launched\n"); grid = -1; return; }
        if (hipFuncSetAttribute((const void*)skel_fwd, hipFuncAttributeMaxDynamicSharedMemorySize, LDS_BYTES) != hipSuccess) { fprintf(stderr, "kernel_launch: hipFuncSetAttribute failed\n"); grid = -1; return; }
        if (hipOccupancyMaxActiveBlocksPerMultiprocessor(&per_cu, (const void*)skel_fwd, NWAVES * 64, LDS_BYTES) != hipSuccess || per_cu < 1)
            fprintf(stderr, "kernel_launch: note: the occupancy query reports %d workgroups per CU\n", per_cu);
        (void)hipGetLastError();
        grid = cus;
        if (grid != 256) fprintf(stderr, "kernel_launch: launching %d workgroups; the fused phases need exactly 256\n", grid);
    }
    if (grid < 0) return;
    if (hipMemsetAsync((char*)d_ws + WS_CTL, 0, CTL_ZERO_BYTES, stream) != hipSuccess) { fprintf(stderr, "kernel_launch: hipMemsetAsync of the control words failed; nothing launched\n"); return; }
    Args a{};
    for (int i = 0; i < 23; ++i) a.in[i] = (const float*)d_in[i];
    a.out = (float*)d_out; a.ws = (unsigned char*)d_ws;
    for (int li = 0; li < N_LAUNCHES; ++li) {
        a.ph_lo = (N_LAUNCHES == PER_PHASE) ? li : 0; a.ph_hi = (N_LAUNCHES == PER_PHASE) ? li + 1 : PER_PHASE; a.li = li;
        hipLaunchKernelGGL(skel_fwd, dim3(grid), dim3(NWAVES * 64), LDS_BYTES, stream, a);
        const hipError_t le = hipPeekAtLastError();
        if (le != hipSuccess) { fprintf(stderr, "kernel_launch: launch %d failed: %s\n", li, hipGetErrorName(le)); break; }
    }
}
```

```cpp
#include <hip/hip_runtime.h>
#include <cstdio>
#include <cstdint>
namespace pg8 {
#define PG8_LAS __attribute__((address_space(3)))
typedef unsigned short bf16_t;
typedef short bf16x8 __attribute__((ext_vector_type(8)));
typedef float f32x4 __attribute__((ext_vector_type(4)));
typedef unsigned u32x4 __attribute__((ext_vector_type(4)));
constexpr int BM = 256, BK = 64, HALF = 128, HTB = HALF * BK * 2  , STAGE_BYTES = 8 * HTB, NXCD = 8, WGM = 8;

__host__ __device__ __forceinline__ int lds_byte(int r, int c) { const int st = (r >> 4) * 2 + (c >> 5), rr = r & 15, cc = c & 31, ob = rr * 64 + cc * 2; return st * 1024 + (ob ^ (((ob >> 9) & 1) << 5)); }
__host__ __device__ __forceinline__ void stage_rc(int b, int& R, int& C) { const int st = b / 1024, sb = b % 1024, swz = sb ^ (((sb >> 9) & 1) << 5); R = (st >> 1) * 16 + swz / 64; C = (st & 1) * 32 + (swz % 64) / 2; }
__host__ __device__ __forceinline__ int perm32(int rho) { const int n = rho >> 4, i = rho & 15; return 8 * (i >> 2) + 4 * n + (i & 3); }

struct Unit { int pm, pn; };
struct Gemm { const bf16_t* A; const bf16_t* Bt; int M, N, K; };

struct StaticOrder {
    int nM, nN, nwg, G, c;
    __host__ __device__ void init(int M, int N, int G_, int c_) { nM = M / BM; nN = N / BM; nwg = nM * nN; G = G_; c = c_; }
    __host__ __device__ bool next(int i, Unit& u) const {
        const long L = (long)i * G + c; if (L >= nwg) return false;
        int wgid = (int)L; { const int q = nwg / NXCD, r = nwg % NXCD, xcd = wgid % NXCD, off = wgid / NXCD; wgid = (xcd < r ? xcd * (q + 1) : r * (q + 1) + (xcd - r) * q) + off; }
        const int nig = WGM * nN, gid = wgid / nig, fm = gid * WGM, gsz = (nM - fm) < WGM ? (nM - fm) : WGM;
        u.pm = fm + ((wgid % nig) % gsz); u.pn = (wgid % nig) / gsz; return true;
    }
    __device__ __forceinline__ void a_ready(const Unit&) const {}
    __device__ __forceinline__ void done(const Unit&) const {}
};

__device__ __forceinline__ unsigned cvt_pk_bf16(float lo, float hi) { unsigned r; asm volatile("v_cvt_pk_bf16_f32 %0, %1, %2" : "=v"(r) : "v"(lo), "v"(hi)); return r; }
typedef float f32x2 __attribute__((ext_vector_type(2)));
struct EpiU {
    static constexpr bool PERM = true, AFTER_DRAIN = false;
    bf16_t* Urk; bf16_t* Uvg; bf16_t* Uqg; bf16_t* Kimg; bf16_t* Vimg; float qscale; int seq;
    __device__ __forceinline__ void operator()(const f32x4 (&acc)[2][2][4][2], const Unit& u, int wr, int wc, int fr, int fq) const {
        const int row0 = u.pm * BM + wr * 64 + fr;
        const float sc = (u.pn == 8 || u.pn == 9) ? qscale : 1.f;
        const bool img = (u.pn >= 10 && u.pn <= 13);
        bf16_t* base = (u.pn < 4) ? (Urk + u.pn * BM) : (u.pn < 8 ? (Uvg + (u.pn - 4) * BM) : (u.pn < 10 ? (Uqg + (u.pn - 8) * BM) : (Uqg + 512 + (u.pn - 14) * BM)));
        const int col0 = wc * 32 + 8 * fq;
#pragma unroll
        for (int ai = 0; ai < 2; ++ai)
#pragma unroll
            for (int m = 0; m < 4; ++m) { const int r = row0 + ai * HALF + m * 16; bf16_t* rowp = base + (size_t)r * 1024 + col0;
                const int bb = r / seq, t = r % seq;
#pragma unroll
                for (int bj = 0; bj < 2; ++bj) { f32x4 v0 = acc[ai][bj][m][0] * sc, v1 = acc[ai][bj][m][1] * sc;
                    u32x4 w; w.x = cvt_pk_bf16(v0[0], v0[1]); w.y = cvt_pk_bf16(v0[2], v0[3]); w.z = cvt_pk_bf16(v1[0], v1[1]); w.w = cvt_pk_bf16(v1[2], v1[3]);
                    if (!img) *(u32x4*)(rowp + bj * HALF) = w;
                    else if (u.pn < 12) { const int hh = 4 * (u.pn - 10) + 2 * bj + (wc >> 1), dch = 4 * (wc & 1) + fq;
                        *(u32x4*)((char*)Kimg + ((size_t)((bb * 8 + hh) * (seq / 64) + (t >> 6)) * 8192 + dch * 1024 + (t & 63) * 16)) = w; }
                    else { const int h = 2 * (u.pn - 12) + bj;
                        *(u32x4*)((char*)Vimg + ((size_t)((bb * 4 + h) * (seq / 64) + (t >> 6)) * 16384 + (wc * 4 + ((t & 63) >> 4)) * 1024 + ((t & 15) * 4 + fq) * 16)) = w; } } }
    }
};

struct PanelStats {
    unsigned* xbuf;
    unsigned* cnt;
    unsigned* tmo;
    int ntn; float eps;
    bool rms;
    unsigned code;
    __device__ __forceinline__ bool run(const f32x4 (&v)[2][2][4][2], const Unit& u, int wr, int wc, int fr, int fq, PG8_LAS unsigned char* lds, int wid, int lane) const {
        typedef float f32x2v __attribute__((ext_vector_type(2)));
        PG8_LAS f32x2v* P = (PG8_LAS f32x2v*)lds;
        PG8_LAS f32x2v* S = (PG8_LAS f32x2v*)(lds + 8192);
        PG8_LAS unsigned* flag = (PG8_LAS unsigned*)(lds + 8192 + 2048);
#pragma unroll
        for (int ai = 0; ai < 2; ++ai)
#pragma unroll
            for (int m = 0; m < 4; ++m) {
                float s = 0.f;
#pragma unroll
                for (int bj = 0; bj < 2; ++bj)
#pragma unroll
                    for (int n = 0; n < 2; ++n) { const f32x4 x = v[ai][bj][m][n]; s += (x[0] + x[1]) + (x[2] + x[3]); }
                s += __shfl_xor(s, 16); s += __shfl_xor(s, 32);
                const float mw = s * (1.0f / 64.0f); float q = 0.f;
#pragma unroll
                for (int bj = 0; bj < 2; ++bj)
#pragma unroll
                    for (int n = 0; n < 2; ++n) { const f32x4 d = v[ai][bj][m][n] - mw; q += (d[0] * d[0] + d[1] * d[1]) + (d[2] * d[2] + d[3] * d[3]); }
                q += __shfl_xor(q, 16); q += __shfl_xor(q, 32);
                if (fq == 0) P[(ai * HALF + wr * 64 + m * 16 + fr) * 4 + wc] = (f32x2v){mw, q};
            }
        asm volatile("s_waitcnt lgkmcnt(0)" ::: "memory"); __builtin_amdgcn_s_barrier(); asm volatile("" ::: "memory");
#if defined(BROKEN_EXCHANGE_NO_WAIT)
#warning BROKEN CONTROL BUILD: the row-statistics exchange does not wait; results are wrong by design
        if (blockIdx.x >= 64) { const long long t0_ = clock64(); while (clock64() - t0_ < 60000) __builtin_amdgcn_s_sleep(8); }
#endif
        const int row = wid * 32 + (lane & 31);
        if (lane < 32) {
            const f32x2v a = P[row * 4 + 0], b = P[row * 4 + 1], c = P[row * 4 + 2], d = P[row * 4 + 3];
            const float mt = (a.x + b.x + c.x + d.x) * 0.25f;
            const float da = a.x - mt, db = b.x - mt, dc = c.x - mt, dd = d.x - mt;
            const float m2 = (a.y + b.y) + (c.y + d.y) + 64.0f * ((da * da + db * db) + (dc * dc + dd * dd));
            unsigned long long* slot = (unsigned long long*)xbuf + ((size_t)(u.pm * BM + row) * 4 + u.pn);
            __hip_atomic_store(slot, ((unsigned long long)__float_as_uint(m2) << 32) | __float_as_uint(mt), __ATOMIC_RELAXED, __HIP_MEMORY_SCOPE_AGENT);
        }
        asm volatile("s_waitcnt vmcnt(0)" ::: "memory");
        if (lane == 0) __hip_atomic_fetch_add(cnt + 64 * u.pm, 1u, __ATOMIC_RELAXED, __HIP_MEMORY_SCOPE_AGENT);
        if (wid == 0) {
            bool dead = false; const unsigned long long t0 = __builtin_amdgcn_s_memrealtime(); const unsigned want = 8u * (unsigned)ntn;
            for (;;) {
#if defined(BROKEN_EXCHANGE_NO_WAIT)
                break;
#endif
                if ((unsigned)__builtin_amdgcn_readfirstlane(__hip_atomic_load(cnt + 64 * u.pm, __ATOMIC_RELAXED, __HIP_MEMORY_SCOPE_AGENT)) >= want) break;
                if (__builtin_amdgcn_s_memrealtime() - t0 > 2000000ull) {
                    if (lane == 0) { unsigned expect = 0u; __hip_atomic_compare_exchange_strong(tmo + 1, &expect, code | (unsigned)(u.pm & 0xff), __ATOMIC_RELAXED, __ATOMIC_RELAXED, __HIP_MEMORY_SCOPE_AGENT);
                                     __hip_atomic_store(tmo, 1u, __ATOMIC_RELAXED, __HIP_MEMORY_SCOPE_AGENT); }
                    dead = true; break; }
                __builtin_amdgcn_s_sleep(2);
            }
            __builtin_amdgcn_fence(__ATOMIC_ACQUIRE, "agent");
            if (lane == 0) flag[0] = dead ? 1u : 0u;
        }
        asm volatile("s_waitcnt vmcnt(0) lgkmcnt(0)" ::: "memory"); __builtin_amdgcn_s_barrier(); asm volatile("" ::: "memory");
        const bool bad = flag[0] != 0u;
        if (lane < 32) {
            const unsigned long long* slot = (const unsigned long long*)xbuf + (size_t)(u.pm * BM + row) * 4; float mt[4], m2[4]; float ms = 0.f;
#pragma unroll
            for (int t = 0; t < 4; ++t) { if (t < ntn) { const unsigned long long w = __hip_atomic_load(slot + t, __ATOMIC_RELAXED, __HIP_MEMORY_SCOPE_AGENT); mt[t] = __uint_as_float((unsigned)w); m2[t] = __uint_as_float((unsigned)(w >> 32)); } else { mt[t] = 0.f; m2[t] = 0.f; } ms += mt[t]; }
            const float mean = ms / (float)ntn; float q = 0.f;
#pragma unroll
            for (int t = 0; t < 4; ++t) if (t < ntn) { const float dm = mt[t] - mean; q += m2[t] + 256.0f * dm * dm; }
            S[row] = (f32x2v){mean, 1.0f / sqrtf(q / (256.0f * (float)ntn) + (rms ? mean * mean : 0.f) + eps)};
        }
        asm volatile("s_waitcnt lgkmcnt(0)" ::: "memory"); __builtin_amdgcn_s_barrier(); asm volatile("" ::: "memory");
        return bad;
    }
};
struct EpiRmsRes {
    static constexpr bool PERM = false, AFTER_DRAIN = true;
    const float* base; float* out; int ldc; const float* gate; int gate_pitch; int rows_per_batch; const float* gpost; PanelStats st; unsigned poison;
    __device__ __forceinline__ void fused(f32x4 (&acc)[2][2][4][2], const Unit& u, int wr, int wc, int fr, int fq, PG8_LAS unsigned char* lds, int wid, int lane) const {
        typedef float f32x2v __attribute__((ext_vector_type(2)));
        const PG8_LAS f32x2v* S = (const PG8_LAS f32x2v*)(lds + 8192);
        const int col0 = u.pn * BM + wc * 32 + 4 * fq;
        const float* grow = gate + (size_t)((u.pm * BM) / rows_per_batch) * gate_pitch;
        f32x4 cf[2][2];
#pragma unroll
        for (int bj = 0; bj < 2; ++bj)
#pragma unroll
            for (int n = 0; n < 2; ++n) cf[bj][n] = *(const f32x4*)(grow + col0 + bj * HALF + n * 16) * *(const f32x4*)(gpost + col0 + bj * HALF + n * 16);
        f32x4 pre[2][2][2];
#pragma unroll
        for (int m = 0; m < 2; ++m) { const size_t off = (size_t)(u.pm * BM + wr * 64 + m * 16 + fr) * ldc + col0;
#pragma unroll
            for (int bj = 0; bj < 2; ++bj)
#pragma unroll
                for (int n = 0; n < 2; ++n) pre[m][bj][n] = *(const f32x4*)(base + off + bj * HALF + n * 16); }
        const bool bad = st.run(acc, u, wr, wc, fr, fq, lds, wid, lane) || poison != 0u;
        const float qnan = __builtin_nanf("");
#pragma unroll
        for (int ai = 0; ai < 2; ++ai)
#pragma unroll
            for (int m = 0; m < 4; ++m) { const int r = ai * HALF + wr * 64 + m * 16 + fr; const f32x2v sr = S[r]; const size_t off = (size_t)(u.pm * BM + r) * ldc + col0;
#pragma unroll
                for (int bj = 0; bj < 2; ++bj)
#pragma unroll
                    for (int n = 0; n < 2; ++n) { const f32x4 bs = (ai == 0 && m < 2) ? pre[m & 1][bj][n] : *(const f32x4*)(base + off + bj * HALF + n * 16); f32x4 o = bs + acc[ai][bj][m][n] * sr.y * cf[bj][n];
                        if (bad) o = (f32x4){qnan, qnan, qnan, qnan}; *(f32x4*)(out + off + bj * HALF + n * 16) = o; }
                if (m & 1) asm volatile("" ::: "memory"); }
    }
};

template <class Epi, class Sched, bool ALIGN_EPI = false, bool SP2 = false>
__device__ __forceinline__ void gemm_phase(PG8_LAS unsigned char* lds, const Gemm g, const Sched& S, const Epi& E) {
    const int tid = threadIdx.x, wid = __builtin_amdgcn_readfirstlane(tid >> 6), lane = tid & 63, wr = wid >> 2, wc = wid & 3, fr = lane & 15, fq = lane >> 4;
    const int K = g.K, nt = K / BK;
    unsigned voffA[2], voffB[2];
#pragma unroll
    for (int i = 0; i < 2; ++i) { int R, C; stage_rc(tid * 16 + i * 8192, R, C); const int Rb = Epi::PERM ? ((R & ~31) + perm32(R & 31)) : R;
        voffA[i] = (unsigned)(R * K + C) * 2u; voffB[i] = (unsigned)(Rb * K + C) * 2u; }
    const size_t kstep = (size_t)(BK * 2);
    const size_t hstep = (size_t)HALF * K * 2;
    const size_t tstep = 2 * hstep;
    const unsigned ldsw = (unsigned)wid * 1024u;
    const int aoff = lds_byte(wr * 64 + fr, fq * 8), boff = lds_byte(wc * 32 + fr, fq * 8);
#define PG8_SA(b, h) (((b) * 2 + (h)) * HTB)
#define PG8_SB(b, h) ((4 + (b) * 2 + (h)) * HTB)
#define PG8_STAGE(bufoff, gbase, voff) do { _Pragma("unroll") for (int _i = 0; _i < 2; ++_i) \
        __builtin_amdgcn_global_load_lds((const unsigned*)((const char*)(gbase) + (voff)[_i]), (PG8_LAS unsigned*)(lds + (bufoff) + ldsw + _i * 8192), 16, 0, 0); } while (0)
#define PG8_LDA(dst, b, h) do { _Pragma("unroll") for (int m = 0; m < 4; ++m) _Pragma("unroll") for (int k = 0; k < 2; ++k) dst[m][k] = *(const PG8_LAS bf16x8*)(lds + PG8_SA(b, h) + aoff + m * 2048 + k * 1024); } while (0)
#define PG8_LDB(dst, b, h) do { _Pragma("unroll") for (int n = 0; n < 2; ++n) _Pragma("unroll") for (int k = 0; k < 2; ++k) dst[n][k] = *(const PG8_LAS bf16x8*)(lds + PG8_SB(b, h) + boff + n * 2048 + k * 1024); } while (0)
#define PG8_MMA(ai, bj, At, Bt) do { __builtin_amdgcn_s_setprio(1); _Pragma("unroll") for (int m = 0; m < 4; ++m) _Pragma("unroll") for (int n = 0; n < 2; ++n) _Pragma("unroll") for (int k = 0; k < 2; ++k) \
        acc[ai][bj][m][n] = __builtin_amdgcn_mfma_f32_16x16x32_bf16(Bt[n][k], At[m][k], acc[ai][bj][m][n], 0, 0, 0); __builtin_amdgcn_s_setprio(0); } while (0)
#define PG8_WAIT_V(n) asm volatile("s_waitcnt vmcnt(" #n ")" ::: "memory")
#define PG8_WAIT_L(n) asm volatile("s_waitcnt lgkmcnt(" #n ")" ::: "memory")
#define PG8_BAR __builtin_amdgcn_s_barrier()
#define PG8_SCHED __builtin_amdgcn_sched_barrier(0)
    Unit cur, nxt; int ui = 0;
    if (!S.next(0, cur)) return;
    f32x4 acc[2][2][4][2];
#pragma unroll
    for (int a = 0; a < 2; ++a)
#pragma unroll
        for (int b = 0; b < 2; ++b)
#pragma unroll
            for (int m = 0; m < 4; ++m)
#pragma unroll
                for (int n = 0; n < 2; ++n) acc[a][b][m][n] = (f32x4){0.f, 0.f, 0.f, 0.f};
    bf16x8 At[4][2], B0[2][2], B1[2][2];
    const char* cA = (const char*)g.A + (size_t)cur.pm * tstep; const char* cB = (const char*)g.Bt + (size_t)cur.pn * tstep;
    S.a_ready(cur);
    if constexpr (SP2) {
        PG8_STAGE(PG8_SB(0, 0), cB, voffB); PG8_STAGE(PG8_SB(0, 1), cB + hstep, voffB); PG8_STAGE(PG8_SA(0, 0), cA, voffA); PG8_STAGE(PG8_SA(0, 1), cA + hstep, voffA);
        if (wr == 1) PG8_BAR;
        PG8_WAIT_V(2); PG8_BAR;
        PG8_STAGE(PG8_SB(1, 0), cB + kstep, voffB); PG8_STAGE(PG8_SA(1, 0), cA + kstep, voffA); PG8_STAGE(PG8_SB(1, 1), cB + hstep + kstep, voffB);
        PG8_WAIT_V(6); PG8_BAR;
    } else {
        PG8_STAGE(PG8_SB(0, 0), cB, voffB); PG8_STAGE(PG8_SA(0, 0), cA, voffA); PG8_STAGE(PG8_SB(0, 1), cB + hstep, voffB); PG8_STAGE(PG8_SA(0, 1), cA + hstep, voffA);
        if (wr == 1) PG8_BAR;
        PG8_WAIT_V(4); PG8_BAR;
        PG8_STAGE(PG8_SB(1, 0), cB + kstep, voffB); PG8_STAGE(PG8_SA(1, 0), cA + kstep, voffA); PG8_STAGE(PG8_SB(1, 1), cB + hstep + kstep, voffB);
        PG8_WAIT_V(6); PG8_BAR;
    }
    for (;;) {
        const bool has_next = S.next(ui + 1, nxt);
        const char* nA = has_next ? (const char*)g.A + (size_t)nxt.pm * tstep : cA; const char* nB = has_next ? (const char*)g.Bt + (size_t)nxt.pn * tstep : cB;
        for (int t = 0; t < nt; t += 2) {
            const bool last = (t == nt - 2);
            const char* a1 = cA + (size_t)(t + 1) * kstep;
            const char* a2 = last ? nA : cA + (size_t)(t + 2) * kstep; const char* b2 = last ? nB : cB + (size_t)(t + 2) * kstep;
            const char* a3 = a2 + kstep; const char* b3 = b2 + kstep;
            if (last && has_next) S.a_ready(nxt);
            if constexpr (SP2) {
            PG8_LDB(B0, 0, 0); PG8_LDB(B1, 0, 1); PG8_SCHED; PG8_LDA(At, 0, 0); PG8_STAGE(PG8_SA(1, 1), a1 + hstep, voffA);
            PG8_WAIT_V(8); PG8_WAIT_L(0); PG8_BAR; PG8_MMA(0, 0, At, B0); PG8_MMA(0, 1, At, B1); PG8_BAR; PG8_SCHED;
            PG8_LDA(At, 0, 1); PG8_STAGE(PG8_SB(0, 0), b2, voffB); PG8_STAGE(PG8_SB(0, 1), b2 + hstep, voffB); PG8_STAGE(PG8_SA(0, 0), a2, voffA);
            PG8_WAIT_V(8); PG8_WAIT_L(0); PG8_BAR; PG8_MMA(1, 0, At, B0); PG8_MMA(1, 1, At, B1); PG8_BAR; PG8_SCHED;
            PG8_LDB(B0, 1, 0); PG8_LDB(B1, 1, 1); PG8_SCHED; PG8_LDA(At, 1, 0); PG8_STAGE(PG8_SA(0, 1), a2 + hstep, voffA);
            PG8_WAIT_V(8); PG8_WAIT_L(0); PG8_BAR; PG8_MMA(0, 0, At, B0); PG8_MMA(0, 1, At, B1); PG8_BAR; PG8_SCHED;
            PG8_LDA(At, 1, 1); PG8_STAGE(PG8_SB(1, 0), b3, voffB); PG8_STAGE(PG8_SB(1, 1), b3 + hstep, voffB); PG8_STAGE(PG8_SA(1, 0), a3, voffA);
            PG8_WAIT_V(8); PG8_WAIT_L(0); PG8_BAR; PG8_MMA(1, 0, At, B0); PG8_MMA(1, 1, At, B1); PG8_BAR; PG8_SCHED;
            } else {
            PG8_LDB(B0, 0, 0); PG8_SCHED; PG8_LDA(At, 0, 0); PG8_STAGE(PG8_SA(1, 1), a1 + hstep, voffA);
            PG8_WAIT_L(8); PG8_BAR; PG8_WAIT_L(0); PG8_MMA(0, 0, At, B0); PG8_BAR; PG8_SCHED;
            PG8_LDB(B1, 0, 1); PG8_STAGE(PG8_SB(0, 0), b2, voffB);
            PG8_BAR; PG8_WAIT_L(0); PG8_MMA(0, 1, At, B1); PG8_BAR;
            PG8_LDA(At, 0, 1); PG8_STAGE(PG8_SA(0, 0), a2, voffA);
            PG8_BAR; PG8_WAIT_L(0); PG8_MMA(1, 0, At, B0); PG8_BAR; PG8_SCHED;
            PG8_STAGE(PG8_SB(0, 1), b2 + hstep, voffB);
            PG8_WAIT_V(6); PG8_BAR; PG8_MMA(1, 1, At, B1); PG8_BAR;
            PG8_LDB(B0, 1, 0); PG8_SCHED; PG8_LDA(At, 1, 0); PG8_STAGE(PG8_SA(0, 1), a2 + hstep, voffA);
            PG8_WAIT_L(8); PG8_BAR; PG8_WAIT_L(0); PG8_MMA(0, 0, At, B0); PG8_BAR; PG8_SCHED;
            PG8_LDB(B1, 1, 1); PG8_STAGE(PG8_SB(1, 0), b3, voffB);
            PG8_BAR; PG8_WAIT_L(0); PG8_MMA(0, 1, At, B1); PG8_BAR;
            PG8_LDA(At, 1, 1); PG8_STAGE(PG8_SA(1, 0), a3, voffA);
            PG8_BAR; PG8_WAIT_L(0); PG8_MMA(1, 0, At, B0); PG8_BAR; PG8_SCHED;
            PG8_STAGE(PG8_SB(1, 1), b3 + hstep, voffB);
            PG8_WAIT_V(6); PG8_BAR; PG8_MMA(1, 1, At, B1); PG8_BAR;
            }
        }
        if constexpr (ALIGN_EPI) { if (wr == 0) PG8_BAR; }
        if constexpr (!Epi::AFTER_DRAIN) { E(acc, cur, wr, wc, fr, fq); S.done(cur); }
        if (!has_next) break;
#pragma unroll
        for (int a = 0; a < 2; ++a)
#pragma unroll
            for (int b = 0; b < 2; ++b)
#pragma unroll
                for (int m = 0; m < 4; ++m)
#pragma unroll
                    for (int n = 0; n < 2; ++n) acc[a][b][m][n] = (f32x4){0.f, 0.f, 0.f, 0.f};
        cur = nxt; cA = nA; cB = nB; ++ui;
        if constexpr (ALIGN_EPI) { if (wr == 1) PG8_BAR; }
    }
    PG8_WAIT_V(0);
    if constexpr (!ALIGN_EPI) { if (wr == 0) PG8_BAR; }
    PG8_BAR;
    if constexpr (Epi::AFTER_DRAIN) { E.fused(acc, cur, wr, wc, fr, fq, lds, wid, lane); S.done(cur); }
#undef PG8_SA
#undef PG8_SB
#undef PG8_STAGE
#undef PG8_LDA
#undef PG8_LDB
#undef PG8_MMA
#undef PG8_WAIT_V
#undef PG8_WAIT_L
#undef PG8_BAR
#undef PG8_SCHED
}
}

#ifndef PG8_SP2
#define PG8_SP2 true
#endif
#ifndef PG8_ALIGN
#define PG8_ALIGN true
#endif
#include <hip/hip_bf16.h>
#include <cmath>
namespace attn_body {
using bf16=__hip_bfloat16;
using bf16x8=__attribute__((ext_vector_type(8)))short;
using s16x4=__attribute__((ext_vector_type(4)))short;
using f32x16=__attribute__((ext_vector_type(16)))float;
using u32x4=__attribute__((ext_vector_type(4)))unsigned;
constexpr int SEQ=4096,D=64,PQ=1024,PO=1024;
constexpr int KT=4096,VT=8192;
constexpr int NW=8,QBLK=32,QB=QBLK*NW,KVBLK=64,NQB=SEQ/QB;
constexpr int ATTN_UNIT_ROWS=QB;
__device__ __forceinline__ int crow(int r,int hi){return (r&3)+8*(r>>2)+4*hi;}
#define SBAR() __builtin_amdgcn_sched_barrier(0)
__device__ __forceinline__ void cmask(f32x16&p0,f32x16&p1,int jb,int qrel,int hi){
  const float NEG=-INFINITY;
  if(jb>(qrel>>6)){
  #pragma unroll
  for(int r=0;r<16;++r){p0[r]=NEG;p1[r]=NEG;}}
}

constexpr int NSLOT=3, SLOTB=8192;
constexpr int LDS_K=0, LDS_V=NSLOT*SLOTB, LDS_WS=LDS_V+NSLOT*2*SLOTB, LDS_OST=LDS_WS+NW*64*4, LDS_BYTES=LDS_OST+NW*4096;
constexpr float C2=0.125f*1.4426950408889634f;
__device__ __forceinline__ void glds16(const void*gsrc,unsigned lds_dst){unsigned keep;
  asm volatile("s_mov_b32 %0, m0\n\ts_mov_b32 m0, %2\n\ts_nop 0\n\tglobal_load_lds_dwordx4 %1, off\n\ts_mov_b32 m0, %0":"=&s"(keep):"v"(gsrc),"s"(lds_dst):"memory");}
__device__ __forceinline__ void glds16s(const void*sbase,unsigned voff,unsigned lds_dst){unsigned keep;
  asm volatile("s_mov_b32 %0, m0\n\ts_mov_b32 m0, %3\n\ts_nop 0\n\tglobal_load_lds_dwordx4 %1, %2\n\ts_mov_b32 m0, %0":"=&s"(keep):"v"(voff),"s"(sbase),"s"(lds_dst):"memory");}
__device__ __forceinline__ float max3f(float a,float b,float c){float r;asm("v_max3_f32 %0, %1, %2, %3":"=v"(r):"v"(a),"v"(b),"v"(c));return r;}
__device__ __forceinline__ float max2f(float a,float b){float r;asm("v_max_f32_e32 %0, %1, %2":"=v"(r):"v"(a),"v"(b));return r;}
__device__ __forceinline__ float fadd_s(float a,float b){float r;asm("v_add_f32_e32 %0, %1, %2":"=v"(r):"v"(a),"v"(b));return r;}
__device__ __forceinline__ float fsub_s(float a,float b){float r;asm("v_sub_f32_e32 %0, %1, %2":"=v"(r):"v"(a),"v"(b));return r;}
typedef float f32x2_t __attribute__((ext_vector_type(2))); typedef __bf16 bf16x2_t __attribute__((ext_vector_type(2)));
__device__ __forceinline__ unsigned cvtpk_s(float lo,float hi){f32x2_t v={lo,hi};bf16x2_t b=__builtin_convertvector(v,bf16x2_t);return __builtin_bit_cast(unsigned,b);}
#define WAIT_BAR(N) asm volatile("s_waitcnt vmcnt(" #N ") lgkmcnt(0)\n\ts_barrier":::"memory")

__device__ __forceinline__ void qkt(f32x16&p0,f32x16&p1,const char*Kslot,const bf16x8*qr,const f32x16&negm,int r32,int hi){
  const char*kb=Kslot+hi*1024+r32*16;
  #pragma unroll
  for(int d0=0;d0<4;++d0){
    const bf16x8 b0=*reinterpret_cast<const bf16x8*>(kb+d0*2048);
    const bf16x8 b1=*reinterpret_cast<const bf16x8*>(kb+d0*2048+512);
    if(d0==0){p0=__builtin_amdgcn_mfma_f32_32x32x16_bf16(b0,qr[0],negm,0,0,0);p1=__builtin_amdgcn_mfma_f32_32x32x16_bf16(b1,qr[0],negm,0,0,0);}
    else{p0=__builtin_amdgcn_mfma_f32_32x32x16_bf16(b0,qr[d0],p0,0,0,0);p1=__builtin_amdgcn_mfma_f32_32x32x16_bf16(b1,qr[d0],p1,0,0,0);}}
}
typedef __attribute__((address_space(3))) const char* lds_cptr;
typedef short v4i16_t __attribute__((ext_vector_type(4)));
__device__ __forceinline__ void kload8(bf16x8*kf,lds_cptr kp){
  kf[0]=*(const __attribute__((address_space(3))) bf16x8*)(kp);      kf[1]=*(const __attribute__((address_space(3))) bf16x8*)(kp+512);
  kf[2]=*(const __attribute__((address_space(3))) bf16x8*)(kp+2048); kf[3]=*(const __attribute__((address_space(3))) bf16x8*)(kp+2560);
  kf[4]=*(const __attribute__((address_space(3))) bf16x8*)(kp+4096); kf[5]=*(const __attribute__((address_space(3))) bf16x8*)(kp+4608);
  kf[6]=*(const __attribute__((address_space(3))) bf16x8*)(kp+6144); kf[7]=*(const __attribute__((address_space(3))) bf16x8*)(kp+6656);
}
__device__ __forceinline__ void kload2(bf16x8*kf,lds_cptr kp,int j){ kf[2*j]=*(const __attribute__((address_space(3))) bf16x8*)(kp+j*2048); kf[2*j+1]=*(const __attribute__((address_space(3))) bf16x8*)(kp+j*2048+512); }
__device__ __forceinline__ s16x4 vtr(lds_cptr p){ return __builtin_bit_cast(s16x4,__builtin_amdgcn_ds_read_tr16_b64_v4i16((__attribute__((address_space(3))) v4i16_t*)p)); }
__device__ __forceinline__ float rowmax(const f32x16&p0,const f32x16&p1){
  float a=max3f(p0[0],p0[1],p1[0]),b=max3f(p0[2],p0[3],p1[1]);a=max3f(a,p1[2],p1[3]);
  #pragma unroll
  for(int r=4;r<16;r+=4){a=max3f(a,p0[r],p0[r+1]);b=max3f(b,p0[r+2],p0[r+3]);a=max3f(a,p1[r],p1[r+1]);b=max3f(b,p1[r+2],p1[r+3]);}
  const float m=max2f(a,b);
  auto rr=__builtin_amdgcn_permlane32_swap(__float_as_uint(m),__float_as_uint(m),false,false);
  return max2f(__uint_as_float(rr[0]),__uint_as_float(rr[1]));
}
__device__ __forceinline__ void pv(f32x16*o,int vb,bf16x8 pa0,bf16x8 pa1,bf16x8 pa2,bf16x8 pa3){
  #pragma unroll
  for(int d0=0;d0<4;++d0){s16x4 lo[4],hi[4];
    #pragma unroll
    for(int ks=0;ks<4;++ks){
      asm volatile("ds_read_b64_tr_b16 %0,%1 offset:%c2":"=&v"(lo[ks]):"v"(vb),"i"(d0*4096+ks*1024):"memory");
      asm volatile("ds_read_b64_tr_b16 %0,%1 offset:%c2":"=&v"(hi[ks]):"v"(vb),"i"(d0*4096+ks*1024+512):"memory");}
    asm volatile("s_waitcnt lgkmcnt(0)":::"memory");SBAR();
    #define PK(k) (bf16x8){lo[k][0],lo[k][1],lo[k][2],lo[k][3],hi[k][0],hi[k][1],hi[k][2],hi[k][3]}
    o[d0]=__builtin_amdgcn_mfma_f32_32x32x16_bf16(pa0,PK(0),o[d0],0,0,0);
    o[d0]=__builtin_amdgcn_mfma_f32_32x32x16_bf16(pa1,PK(1),o[d0],0,0,0);
    o[d0]=__builtin_amdgcn_mfma_f32_32x32x16_bf16(pa2,PK(2),o[d0],0,0,0);
    o[d0]=__builtin_amdgcn_mfma_f32_32x32x16_bf16(pa3,PK(3),o[d0],0,0,0);
    #undef PK
  }
}

#ifndef ATTN_STORE16
#define ATTN_STORE16(p,v) (*(u32x4*)(p)=(v))
#endif
template<int THRL> __device__ __forceinline__ void attn_unit(int qb,const bf16*Q,const bf16*__restrict__ K,const bf16*__restrict__ V,bf16*O,char*shm){
  const int tid=threadIdx.x,lane=tid&63,r32=lane&31,hi=lane>>5; const int wid=__builtin_amdgcn_readfirstlane(tid>>6);
  const int q0=qb*QB;
  const bf16*Qw=Q+(long)(q0+wid*QBLK)*PQ;
  const bf16*Kh=K,*Vh=V;
  const unsigned lds0=(unsigned)(uintptr_t)shm;
  float*wsf=(float*)(shm+LDS_WS)+wid*64;
  const unsigned koff=(unsigned)(wid*1024+lane*16);
  const unsigned voffv=koff;
  const unsigned kdst=lds0+LDS_K+wid*1024, vdst=lds0+LDS_V+wid*1024;
  #define DMA_K(t,slot) glds16s(Kh+(long)(t)*KT,koff,(unsigned)__builtin_amdgcn_readfirstlane(kdst+(slot)))
  #define DMA_V(t,slot) do{ glds16s(Vh+(long)(t)*VT,voffv,(unsigned)__builtin_amdgcn_readfirstlane(vdst+2*(slot))); glds16s(Vh+4096+(long)(t)*VT,voffv,(unsigned)__builtin_amdgcn_readfirstlane(vdst+8192+2*(slot))); }while(0)
  const int vb0=(int)(lds0+LDS_V)+((lane>>4)&1)*32+(lane&3)*8+(4*hi+((lane&15)>>2))*64;
  const char*Kbase=shm+LDS_K; bf16x8 kf[8];
  const lds_cptr shm3=(lds_cptr)shm; const lds_cptr kp0=shm3+LDS_K+hi*1024+r32*16; const lds_cptr vp0=shm3+LDS_V+((lane>>4)&1)*32+(lane&3)*8+(4*hi+((lane&15)>>2))*64;
  const int NT=(q0+QB)/KVBLK;
  DMA_K(0,0);DMA_V(0,0);DMA_K(1,SLOTB);
  bf16x8 qr[4];
  #pragma unroll
  for(int d0=0;d0<4;++d0)qr[d0]=*reinterpret_cast<const bf16x8*>(&Qw[(long)r32*PQ+d0*16+hi*8]);
  float mhat=0.f,l_reg=0.f;f32x16 o[4];o[0]=f32x16{};o[1]=f32x16{};o[2]=f32x16{};o[3]=f32x16{};
  const int qrel=wid*QBLK+r32;
  #define CMASK(P0,P1,t) do{int jb_=(t)-(NT-4); if(jb_>=0)cmask(P0,P1,jb_,qrel,hi);}while(0)
  bool resc=false;
  #define START(P0,P1) do{ const float rm=rowmax(P0,P1); resc=false; \
    { const float dl=rm; mhat=fadd_s(mhat,dl); \
      _Pragma("unroll") for(int r=0;r<16;++r){P0[r]=fsub_s(P0[r],dl);P1[r]=fsub_s(P1[r],dl);} } \
    _Pragma("unroll") for(int r=0;r<16;++r)P0[r]=__builtin_amdgcn_exp2f(P0[r]); }while(0)
  #define RESC() do{ if(resc){ asm volatile("s_waitcnt lgkmcnt(0)":::"memory"); \
      _Pragma("unroll") for(int d_=0;d_<4;++d_) _Pragma("unroll") for(int r=0;r<16;++r)o[d_][r]*=wsf[crow(r,hi)]; } }while(0)
  f32x16 pA0,pA1,pB0,pB1;
  int sl_prev=0,sl_cur=0,sl_next=SLOTB;
  #define ROT() do{sl_prev=sl_cur;sl_cur=sl_next;sl_next=(sl_next==(NSLOT-1)*SLOTB)?0:sl_next+SLOTB;}while(0)
  DMA_K(2,2*SLOTB);
  WAIT_BAR(4);
  { const f32x16 zero16=f32x16{}; qkt(pA0,pA1,Kbase,qr,zero16,r32,hi); }asm volatile("s_nop 15\n\ts_nop 7":"+v"(pA0),"+v"(pA1));CMASK(pA0,pA1,0);
  START(pA0,pA1);
  _Pragma("unroll") for(int r=0;r<16;++r)pA1[r]=__builtin_amdgcn_exp2f(pA1[r]);
  WAIT_BAR(0);
  DMA_K(3,0);DMA_V(1,SLOTB);
  ROT();
  kload8(kf,kp0+sl_cur);
  WAIT_BAR(3);
  s16x4 vlo[8],vhi[8]; u32x4 pw0,pw1,pw2,pw3;
  #define PKW(P,B) cvtpk_s(P[B],P[B+1])
  #define PAF(k) __builtin_bit_cast(bf16x8,pw##k)
  #define VFR(i) (bf16x8){vlo[i][0],vlo[i][1],vlo[i][2],vlo[i][3],vhi[i][0],vhi[i][1],vhi[i][2],vhi[i][3]}
  #define PIN(x) asm volatile("":"+v"(x))
  #define MX3(a,b,c) __builtin_fmaxf(__builtin_fmaxf((a),(b)),(c))
  #define GAPA(MF,A0,A1,A2,A3,W0,W1,PW) do{ MF; sacc+=A0; sacc+=A1; sacc+=A2; sacc+=A3; PIN(sacc); W0; W1; PIN(PW); SBAR(); }while(0)
  #define EX(v) __builtin_amdgcn_exp2f(v)
  #define GAPM(MF,X,B) do{ MF; X[B]-=mhat; X[B+1]-=mhat; X[B+2]-=mhat; X[B+3]-=mhat; PIN(X); }while(0)
  #define GAPB(MF,X,B) do{ MF; X[B]=EX(X[B]); X[B+1]=EX(X[B+1]); X[B+2]=EX(X[B+2]); X[B+3]=EX(X[B+3]); PIN(X); SBAR(); }while(0)
  #define VRD(i) do{ vlo[i]=vtr(vp_+(((i)>>2)*4096+((i)&3)*1024)); vhi[i]=vtr(vp_+(((i)>>2)*4096+((i)&3)*1024+512)); }while(0)
  #define VRD2(i) do{ vlo[i]=vtr(vp_+((2+((i)>>2))*4096+((i)&3)*1024)); vhi[i]=vtr(vp_+((2+((i)>>2))*4096+((i)&3)*1024+512)); }while(0)
  #define KRD(G,j) do{ if(G){ kload2(kf,kp0+sl_next,j); SBAR(); } }while(0)
  #define STEP(C0,C1,P0,P1,t,GK,GV,GL) do{ SBAR(); \
    const lds_cptr vp_=vp0+2*sl_prev; \
    VRD(0); SBAR(); float sacc=(P0[0]+P0[1]); \
    GAPA(C0=__builtin_amdgcn_mfma_f32_32x32x16_bf16(kf[0],qr[0],f32x16{},0,0,0), P0[2],P0[3],P0[4],P0[5],     pw0[0]=PKW(P0,0), pw0[1]=PKW(P0,2), pw0); \
    VRD(4); SBAR(); GAPA(C1=__builtin_amdgcn_mfma_f32_32x32x16_bf16(kf[1],qr[0],f32x16{},0,0,0), P0[6],P0[7],P0[8],P0[9],     pw0[2]=PKW(P0,4), pw0[3]=PKW(P0,6), pw0); \
    VRD(1); SBAR(); GAPA(C0=__builtin_amdgcn_mfma_f32_32x32x16_bf16(kf[2],qr[1],C0,0,0,0),   P0[10],P0[11],P0[12],P0[13], pw1[0]=PKW(P0,8), pw1[1]=PKW(P0,10), pw1); \
    VRD(5); SBAR(); GAPA(C1=__builtin_amdgcn_mfma_f32_32x32x16_bf16(kf[3],qr[1],C1,0,0,0),   P0[14],P0[15],P1[0],P1[1],   pw1[2]=PKW(P0,12),pw1[3]=PKW(P0,14), pw1); \
    VRD(2); SBAR(); GAPA(C0=__builtin_amdgcn_mfma_f32_32x32x16_bf16(kf[4],qr[2],C0,0,0,0),   P1[2],P1[3],P1[4],P1[5],     pw2[0]=PKW(P1,0), pw2[1]=PKW(P1,2), pw2); \
    VRD(6); SBAR(); GAPA(C1=__builtin_amdgcn_mfma_f32_32x32x16_bf16(kf[5],qr[2],C1,0,0,0),   P1[6],P1[7],P1[8],P1[9],     pw2[2]=PKW(P1,4), pw2[3]=PKW(P1,6), pw2); \
    VRD(3); SBAR(); GAPA(C0=__builtin_amdgcn_mfma_f32_32x32x16_bf16(kf[6],qr[3],C0,0,0,0),   P1[10],P1[11],P1[12],P1[13], pw3[0]=PKW(P1,8), pw3[1]=PKW(P1,10), pw3); \
    VRD(7); SBAR(); GAPA(C1=__builtin_amdgcn_mfma_f32_32x32x16_bf16(kf[7],qr[3],C1,0,0,0),   P1[14],P1[15],0.f,0.f,       pw3[2]=PKW(P1,12),pw3[3]=PKW(P1,14), pw3); \
    l_reg+=sacc; \
    if(GK){DMA_K((t)+3,sl_cur);} if(GV){DMA_V((t)+1,sl_next);} \
    GAPM(o[0]=__builtin_amdgcn_mfma_f32_32x32x16_bf16(PAF(0),VFR(0),o[0],0,0,0), C0,0);  VRD2(0); SBAR(); \
    GAPM(o[1]=__builtin_amdgcn_mfma_f32_32x32x16_bf16(PAF(0),VFR(4),o[1],0,0,0), C0,4);  VRD2(4); SBAR(); \
    GAPM(o[0]=__builtin_amdgcn_mfma_f32_32x32x16_bf16(PAF(1),VFR(1),o[0],0,0,0), C0,8);  VRD2(1); SBAR(); \
    GAPM(o[1]=__builtin_amdgcn_mfma_f32_32x32x16_bf16(PAF(1),VFR(5),o[1],0,0,0), C0,12); VRD2(5); SBAR(); \
    GAPM(o[0]=__builtin_amdgcn_mfma_f32_32x32x16_bf16(PAF(2),VFR(2),o[0],0,0,0), C1,0);  VRD2(2); SBAR(); \
    GAPM(o[1]=__builtin_amdgcn_mfma_f32_32x32x16_bf16(PAF(2),VFR(6),o[1],0,0,0), C1,4);  VRD2(6); SBAR(); \
    GAPM(o[0]=__builtin_amdgcn_mfma_f32_32x32x16_bf16(PAF(3),VFR(3),o[0],0,0,0), C1,8);  VRD2(3); SBAR(); \
    GAPM(o[1]=__builtin_amdgcn_mfma_f32_32x32x16_bf16(PAF(3),VFR(7),o[1],0,0,0), C1,12); VRD2(7); SBAR(); \
    CMASK(C0,C1,t); \
    { float a=MX3(C0[0],C0[1],C1[0]),b=MX3(C0[2],C0[3],C1[1]); a=MX3(a,C1[2],C1[3]); \
      _Pragma("unroll") for(int r=4;r<16;r+=4){a=MX3(a,C0[r],C0[r+1]);b=MX3(b,C0[r+2],C0[r+3]);a=MX3(a,C1[r],C1[r+1]);b=MX3(b,C1[r+2],C1[r+3]);} \
      float rm=__builtin_fmaxf(a,b); { auto rr=__builtin_amdgcn_permlane32_swap(__float_as_uint(rm),__float_as_uint(rm),false,false); rm=__builtin_fmaxf(__uint_as_float(rr[0]),__uint_as_float(rr[1])); } \
      resc=false; \
      if(__builtin_expect(__any(rm>(float)THRL),0)){ const float dl=__builtin_fmaxf(rm,0.f); mhat+=dl; \
        _Pragma("unroll") for(int r=0;r<16;++r){C0[r]-=dl;C1[r]-=dl;} \
        const float f=__builtin_amdgcn_exp2f(-dl); l_reg*=f; if(hi==0)wsf[r32]=f; resc=true; } } \
    SBAR(); \
    GAPB(o[2]=__builtin_amdgcn_mfma_f32_32x32x16_bf16(PAF(0),VFR(0),o[2],0,0,0), C0,0); \
    GAPB(o[3]=__builtin_amdgcn_mfma_f32_32x32x16_bf16(PAF(0),VFR(4),o[3],0,0,0), C0,4); \
    KRD(GL,0); GAPB(o[2]=__builtin_amdgcn_mfma_f32_32x32x16_bf16(PAF(1),VFR(1),o[2],0,0,0), C0,8); \
    KRD(GL,1); GAPB(o[3]=__builtin_amdgcn_mfma_f32_32x32x16_bf16(PAF(1),VFR(5),o[3],0,0,0), C0,12); \
    KRD(GL,2); GAPB(o[2]=__builtin_amdgcn_mfma_f32_32x32x16_bf16(PAF(2),VFR(2),o[2],0,0,0), C1,0); \
    KRD(GL,3); GAPB(o[3]=__builtin_amdgcn_mfma_f32_32x32x16_bf16(PAF(2),VFR(6),o[3],0,0,0), C1,4); \
    GAPB(o[2]=__builtin_amdgcn_mfma_f32_32x32x16_bf16(PAF(3),VFR(3),o[2],0,0,0), C1,8); \
    GAPB(o[3]=__builtin_amdgcn_mfma_f32_32x32x16_bf16(PAF(3),VFR(7),o[3],0,0,0), C1,12); \
    }while(0)
  int t=1;
  #undef CMASK
  #define CMASK(P0,P1,t) do{}while(0)
  for(;t+5<NT;t+=2){
    STEP(pB0,pB1,pA0,pA1,t,true,true,true);     WAIT_BAR(3); RESC(); ROT();
    STEP(pA0,pA1,pB0,pB1,t+1,true,true,true);   WAIT_BAR(3); RESC(); ROT();
  }
  #undef CMASK
  #define CMASK(P0,P1,t) do{int jb_=(t)-(NT-4); if(jb_>=0)cmask(P0,P1,jb_,qrel,hi);}while(0)
  #define ENDW(tt) do{ if((tt)+3<NT){WAIT_BAR(3);} else if((tt)+2<NT){WAIT_BAR(2);} else {WAIT_BAR(0);} }while(0)
  for(;t+1<NT;t+=2){
    STEP(pB0,pB1,pA0,pA1,t,(t+3<NT),(t+1<NT),(t+1<NT));       ENDW(t);   RESC(); ROT();
    STEP(pA0,pA1,pB0,pB1,t+1,(t+4<NT),(t+2<NT),(t+2<NT));     ENDW(t+1); RESC(); ROT();
  }
  STEP(pB0,pB1,pA0,pA1,NT-1,false,false,false); RESC();
  { float sacc=pB0[0]+pB0[1]; _Pragma("unroll") for(int r=2;r<16;++r)sacc+=pB0[r]; _Pragma("unroll") for(int r=0;r<16;++r)sacc+=pB1[r]; l_reg+=sacc;
    pw0=(u32x4){PKW(pB0,0),PKW(pB0,2),PKW(pB0,4),PKW(pB0,6)};pw1=(u32x4){PKW(pB0,8),PKW(pB0,10),PKW(pB0,12),PKW(pB0,14)};pw2=(u32x4){PKW(pB1,0),PKW(pB1,2),PKW(pB1,4),PKW(pB1,6)};pw3=(u32x4){PKW(pB1,8),PKW(pB1,10),PKW(pB1,12),PKW(pB1,14)};
    SBAR(); pv(o,vb0+2*sl_cur,PAF(0),PAF(1),PAF(2),PAF(3)); }
  #undef PKW
  #undef PAF
  #undef VFR
  #undef PIN
  #undef MX3
  #undef GAPA
  #undef GAPB
  #undef GAPM
  #undef EX
  #undef VRD
  #undef VRD2
  #undef KRD
  #undef STEP
  #undef ENDW
  {auto rr=__builtin_amdgcn_permlane32_swap(__float_as_uint(l_reg),__float_as_uint(l_reg),false,false);l_reg=__uint_as_float(rr[0])+__uint_as_float(rr[1]);}
  if(hi==0)wsf[32+r32]=l_reg;asm volatile("s_waitcnt lgkmcnt(0)":::"memory");
  float rli[16];
  #pragma unroll
  for(int r=0;r<16;++r)rli[r]=__builtin_amdgcn_rcpf(wsf[32+crow(r,hi)]);
  bf16*Ow=O+(long)(q0+wid*QBLK)*PO;
  { bf16*stg=(bf16*)(shm+LDS_OST)+wid*2048;
    #pragma unroll
    for(int p=0;p<2;++p){
    #pragma unroll
    for(int r=0;r<16;++r){const int orow=crow(r,hi);
      #pragma unroll
      for(int d0=0;d0<2;++d0)stg[orow*64+d0*32+r32]=__float2bfloat16(o[2*p+d0][r]*rli[r]);}
    asm volatile("s_waitcnt lgkmcnt(0)":::"memory");
    #pragma unroll
    for(int i=0;i<4;++i){const int row=i*8+(lane>>3),ch=lane&7; const u32x4 v=*(const u32x4*)(stg+row*64+ch*8); ATTN_STORE16(Ow+(long)row*PO+p*64+ch*8,v);}
    asm volatile("s_waitcnt lgkmcnt(0)":::"memory"); } }
  asm volatile("s_waitcnt lgkmcnt(0)\n\ts_barrier":::"memory");
  #undef DMA_K
  #undef DMA_V
  #undef CMASK
  #undef START
  #undef RESC
  #undef ROT
}
constexpr int ATTN_LDS_BYTES=LDS_BYTES;
struct AttnTensors { const bf16* Q; const bf16* Kimg; const bf16* Vimg; bf16* O0; bf16* O1; };
struct AttnUnit { int vh; int qb; };
struct StaticOrder {
  int vcu;
  __device__ __forceinline__ explicit StaticOrder(int vcu_):vcu(vcu_){}
  __device__ __forceinline__ bool next(int i,AttnUnit&u)const{ if(i>=4)return false; const int s=vcu&3; u.vh=vcu>>2; u.qb=(i==0)?s:(i==1)?7-s:(i==2)?8+s:15-s; return true; }
  __device__ __forceinline__ void a_ready(const AttnUnit&)const{}
  __device__ __forceinline__ void done(const AttnUnit&)const{}
};
template<int ABL=0> __device__ __forceinline__ void attn_run(const AttnTensors&T,int vh,int qb,char*lds){
  const int comp=vh&1,h=(vh>>1)&3,b=vh>>3;
  attn_unit<8>(qb,T.Q+(long)b*SEQ*PQ+h*128+comp*64,T.Kimg+(long)((b*8+h*2+comp)*(SEQ/64))*KT,T.Vimg+(long)((b*4+h)*(SEQ/64))*VT,(comp?T.O1:T.O0)+(long)b*SEQ*PO+h*128,lds);
}
__device__ __forceinline__ unsigned q_take(unsigned*qheads,int&cq){
  for(int tries=0;tries<8;++tries){
    const unsigned idx=__hip_atomic_fetch_add(qheads+cq,1u,__ATOMIC_RELAXED,__HIP_MEMORY_SCOPE_AGENT);
    if(idx<64u)return (unsigned)cq*64u+idx;
    int found=-1;
    #pragma unroll
    for(int j=1;j<8;++j){const int q=(cq+j)&7; if(found<0&&__hip_atomic_load(qheads+q,__ATOMIC_RELAXED,__HIP_MEMORY_SCOPE_AGENT)<64u)found=q;}
    if(found<0)return 0xffffffffu;
    cq=found;}
  return 0xffffffffu;
}
template<int ABL=0> __device__ __forceinline__ void attn_phase_queue(char*lds,const AttnTensors&T,unsigned*qheads,int xq,volatile __attribute__((address_space(3))) unsigned*mbox){
  const bool t0=(threadIdx.x==0); int cq=xq&7;
  if(t0)mbox[0]=q_take(qheads,cq);
  asm volatile("s_waitcnt vmcnt(0) lgkmcnt(0)\n\ts_barrier":::"memory");
  unsigned ticket=(unsigned)__builtin_amdgcn_readfirstlane(mbox[0]); int par=0;
  while(ticket!=0xffffffffu){
    unsigned nxt=0u; if(t0)nxt=__hip_atomic_fetch_add(qheads+cq,1u,__ATOMIC_RELAXED,__HIP_MEMORY_SCOPE_AGENT);
    attn_run<ABL>(T,4*(int)(ticket>>6)+(int)(ticket&3u),15-(int)((ticket&63u)>>2),lds);
    par^=1; if(t0)mbox[par]=(nxt<64u)?(unsigned)cq*64u+nxt:q_take(qheads,cq);
    asm volatile("s_waitcnt vmcnt(0) lgkmcnt(0)\n\ts_barrier":::"memory");
    ticket=(unsigned)__builtin_amdgcn_readfirstlane(mbox[par]);
  }
}
#undef SBAR
#undef WAIT_BAR
}

constexpr int NWAVES = 8;
#ifndef MK_N_LAUNCHES
#define MK_N_LAUNCHES 1
#endif
constexpr int PER_PHASE = 8;
constexpr int N_LAUNCHES = MK_N_LAUNCHES;

constexpr int BATCH = 4, T = 4096, D = 1024;
constexpr int M = BATCH * T;
constexpr int RW_W = 512, RW_H = 8, RW_N = 64, DA_W = 512;
constexpr int RW_SHIFTED = 1664, RW_COLS = 2176, D_IN = 4224;
constexpr int NMAIN = 4096;
constexpr float RMS_EPS = 1e-6f, GN_EPS = 64e-5f, SUBLN_EPS = 1e-5f;
constexpr float LAMBDA_INIT = 0.2f;
constexpr float LOG2E = 1.4426950408889634f;

constexpr size_t MiB = 1u << 20, KiB = 1u << 10;
constexpr size_t WS_CTL = 0, CTL_ZERO_BYTES = 128 * KiB;
constexpr size_t WS_MOD = 128 * KiB;
constexpr size_t WS_W2T = 256 * KiB;
constexpr size_t WS_BONUS = 512 * KiB;
constexpr size_t WS_X = 1 * MiB;
constexpr size_t WS_WOUT = 1 * MiB + 512 * KiB;
constexpr size_t WS_WIN = 3 * MiB + 512 * KiB;
constexpr size_t WS_XN = 11 * MiB + 768 * KiB;
constexpr size_t WS_REC1 = WS_XN;
constexpr size_t WS_Y = WS_XN;
constexpr size_t WS_URK = WS_XN + 32 * MiB;
constexpr size_t WS_UVG = WS_URK + 32 * MiB;
constexpr size_t WS_UQG = WS_UVG + 32 * MiB;
constexpr size_t WS_KIMG = WS_UQG + 32 * MiB;
constexpr size_t WS_VIMG = WS_KIMG + 16 * MiB;
constexpr size_t WS_REC2 = WS_VIMG + 16 * MiB;
constexpr size_t WS_LO = WS_REC2 + 65 * MiB;
constexpr size_t WS_ORW = WS_LO;
constexpr size_t WS_END = WS_ORW + 16 * MiB;
static_assert(WS_END <= 256 * MiB, "d_ws map");
constexpr int UP = 1024;
constexpr int CW_TMO = 0, CW_CODE = 1;
constexpr int CW_BAR = 4096;
constexpr int CW_SEAM = 16384;
constexpr int CW_QUEUE = 24576;
static_assert((CW_QUEUE + 1024 + 16 * 64) * 4 <= (int)CTL_ZERO_BYTES, "CTL words inside the memset region");

constexpr int RING_OFF = 0, RING_BYTES = 131072;
constexpr int LDSCTL_OFF = RING_BYTES, MISC_OFF = LDSCTL_OFF + 320;
constexpr int LDS_BYTES = 147456;
static_assert(MISC_OFF + 128 <= LDS_BYTES, "LDS map");

#define GAS __attribute__((address_space(1)))
#define LAS __attribute__((address_space(3)))
typedef unsigned short bf16;
typedef unsigned v4u __attribute__((ext_vector_type(4)));
typedef float f32x4 __attribute__((ext_vector_type(4)));
typedef short bf16x8 __attribute__((ext_vector_type(8)));
typedef GAS unsigned gu32;
typedef GAS unsigned long long gu64;
#define RLX_AGENT __ATOMIC_RELAXED, __HIP_MEMORY_SCOPE_AGENT
#define LDS_WAIT() asm volatile("s_waitcnt lgkmcnt(0)" ::: "memory")
#define VM_WAIT() asm volatile("s_waitcnt vmcnt(0)" ::: "memory")
__device__ __forceinline__ unsigned long long rt() { return __builtin_amdgcn_s_memrealtime(); }
__device__ __forceinline__ unsigned f2bf(float f) { unsigned u = __builtin_bit_cast(unsigned, f); return (u + 0x7fffu + ((u >> 16) & 1u)) >> 16; }
__device__ __forceinline__ unsigned pk2(float lo, float hi) { return f2bf(lo) | (f2bf(hi) << 16); }

#define XB_TMO      128
#define XB_XCNT(j)  (256  + 64 * (j))
#define XB_XSUB(j)  (1280 + 64 * (j))
#define XB_XGEN(j)  (2304 + 64 * (j))
#define XB_TOP      3328
#define XB_TOPGEN   3392
#define XCD_BAR_WORDS 3456
#define XB_SPIN_CAP (1u << 18)

__device__ __forceinline__ unsigned xb_ld(unsigned* p)              { return __hip_atomic_load(p, __ATOMIC_RELAXED, __HIP_MEMORY_SCOPE_AGENT); }
__device__ __forceinline__ unsigned xb_add(unsigned* p, unsigned v) { return __hip_atomic_fetch_add(p, v, __ATOMIC_RELAXED, __HIP_MEMORY_SCOPE_AGENT); }
__device__ __forceinline__ unsigned xb_xcc_id() { return (unsigned)__builtin_amdgcn_s_getreg((3 << 11) | 20) & 0xFu; }
#define XB_SPIN(cond, bar) do { unsigned _sp = 0; while (cond) { __builtin_amdgcn_s_sleep(1); \
    if ((++_sp & 255u) == 0u) { if (xb_ld(&(bar)[XB_TMO])) break; if (_sp > XB_SPIN_CAP) { atomicAdd(&(bar)[XB_TMO], 1u); break; } } } } while (0)

struct XcdBarrier {
    unsigned* bar; unsigned x;
    volatile LAS unsigned* st;
};

__device__ __forceinline__ XcdBarrier xcd_barrier_post(unsigned* bar, volatile LAS unsigned* st) {
    XcdBarrier b; b.bar = bar; b.x = xb_xcc_id(); b.st = st;
    if (threadIdx.x == 0) (void)xb_add(&bar[XB_XCNT(b.x)], 1u);
    return b;
}
__device__ __forceinline__ void xcd_barrier_complete(unsigned* bar, unsigned x, unsigned& nloc, unsigned& nx) {
    const unsigned G = gridDim.x * gridDim.y * gridDim.z;
    unsigned sum, cnt, mine, sp = 0u;
    for (;;) {
        sum = 0u; cnt = 0u; mine = 0u;
#pragma unroll
        for (unsigned j = 0; j < 16; ++j) { const unsigned c = xb_ld(&bar[XB_XCNT(j)]); sum += c; cnt += (c > 0u) ? 1u : 0u; mine = (j == x) ? c : mine; }
        if (sum == G) break;
        __builtin_amdgcn_s_sleep(1);
        if ((++sp & 255u) == 0u) { if (xb_ld(&bar[XB_TMO])) break; if (sp > XB_SPIN_CAP) { atomicAdd(&bar[XB_TMO], 1u); break; } }
    }
    nloc = mine > 0u ? mine : 1u; nx = cnt > 0u ? cnt : 1u;
}

__device__ __forceinline__ void xcd_barrier(const XcdBarrier& b) {
    asm volatile("s_waitcnt vmcnt(0)" ::: "memory");
    __syncthreads();
    if (threadIdx.x == 0) {
        unsigned* bar = b.bar;
        __builtin_amdgcn_s_waitcnt(0);
        unsigned nloc = b.st[0], nx = b.st[1];
        if (nloc == 0u) { xcd_barrier_complete(bar, b.x, nloc, nx); b.st[0] = nloc; b.st[1] = nx; }
        const unsigned old = xb_add(&bar[XB_XSUB(b.x)], 1u);
        const unsigned gen = old / nloc;
        if (old + 1u == (gen + 1u) * nloc) {
            __builtin_amdgcn_fence(__ATOMIC_RELEASE, "agent");
            asm volatile("s_waitcnt vmcnt(0)" ::: "memory");
            const unsigned og = xb_add(&bar[XB_TOP], 1u);
            const unsigned tg = og / nx;
            if (og + 1u == (tg + 1u) * nx) xb_add(&bar[XB_TOPGEN], 1u);
            else XB_SPIN(xb_ld(&bar[XB_TOPGEN]) == tg, bar);
            __builtin_amdgcn_fence(__ATOMIC_ACQUIRE, "agent");
            xb_add(&bar[XB_XGEN(b.x)], 1u);
            asm volatile("s_waitcnt vmcnt(0)" ::: "memory");
        } else {
            XB_SPIN(xb_ld(&bar[XB_XGEN(b.x)]) == gen, bar);
            __builtin_amdgcn_fence(__ATOMIC_ACQUIRE, "agent");
            asm volatile("s_waitcnt vmcnt(0)" ::: "memory");
        }
    }
    __syncthreads();
}
struct Frame {
    LAS unsigned char* lds;
    volatile LAS unsigned* MISC;
    gu32* ctl;
    int tid, lane, wave;
    int vcu, G;
    const float* in[23]; float* out; unsigned char* ws;
};
enum { I_X = 0, I_C, I_WADA, I_BADA, I_GPRE, I_GPOST, I_WIN, I_WOUT, I_MU, I_W0, I_WW2, I_A0, I_WA2, I_KK, I_KA, I_RK, I_LNW, I_LNB, I_LQ1, I_LK1, I_LQ2, I_LK2, I_SUBLN };

typedef float f32x2c_t __attribute__((ext_vector_type(2))); typedef __bf16 bf16x2c_t __attribute__((ext_vector_type(2)));
__device__ __forceinline__ unsigned cvtpk(float lo, float hi) { f32x2c_t v = {lo, hi}; bf16x2c_t b = __builtin_convertvector(v, bf16x2c_t); return __builtin_bit_cast(unsigned, b); }
__device__ __forceinline__ float bf2f(unsigned short v) { return __builtin_bit_cast(float, (unsigned)v << 16); }
__device__ __forceinline__ float bflo(unsigned v) { return __builtin_bit_cast(float, v << 16); }
__device__ __forceinline__ float bfhi(unsigned v) { return __builtin_bit_cast(float, v & 0xffff0000u); }
__device__ __forceinline__ float sigmoidf_(float x) { return 1.f / (1.f + __expf(-x)); }
__device__ __forceinline__ float siluf_(float x) { return x / (1.f + __expf(-x)); }
__device__ __forceinline__ float silu_fast(float x) { return x * __builtin_amdgcn_rcpf(1.f + __builtin_amdgcn_exp2f(-1.4426950408889634f * x)); }

__device__ __forceinline__ float wave_sum(float v) {
#pragma unroll
    for (int o = 1; o < 64; o <<= 1) v += __shfl_xor(v, o);
    return v;
}
__device__ __forceinline__ float sum8_dpp(float v) { v += __builtin_bit_cast(float, __builtin_amdgcn_update_dpp(0, __builtin_bit_cast(int, v), 0xB1, 0xf, 0xf, true)); v += __builtin_bit_cast(float, __builtin_amdgcn_update_dpp(0, __builtin_bit_cast(int, v), 0x4E, 0xf, 0xf, true));
    v += __builtin_bit_cast(float, __builtin_amdgcn_update_dpp(0, __builtin_bit_cast(int, v), 0x141, 0xf, 0xf, true)); return v; }
__device__ __forceinline__ float sum16_dpp(float v) { v = sum8_dpp(v); v += __builtin_bit_cast(float, __builtin_amdgcn_update_dpp(0, __builtin_bit_cast(int, v), 0x140, 0xf, 0xf, true)); return v; }
__device__ __forceinline__ int win_col(int n) { return n < 1536 ? n : (n < 2048 ? 1664 + (n - 1536) : (n < 4096 ? 2176 + (n - 2048) : 1536 + (n - 4096))); }
template <bool IMG = false> __device__ __forceinline__ void p0_transpose_item(const float* W, int K, int N, bf16* WT, int k0, int src_col0, int dst_row0, LAS float* scr, int lane) {
#pragma unroll 8
    for (int i = 0; i < 32; ++i) { const int kk = 2 * i + (lane >> 5); scr[kk * 33 + (lane & 31)] = W[(size_t)(k0 + kk) * N + src_col0 + (lane & 31)]; }
    LDS_WAIT(); asm volatile("" ::: "memory");
    const int c = lane & 7;
#pragma unroll
    for (int j = 0; j < 4; ++j) { const int n = (lane >> 3) + 8 * j; const LAS float* s = scr + (8 * c) * 33 + n;
        v4u o; o.x = pk2(s[0 * 33], s[1 * 33]); o.y = pk2(s[2 * 33], s[3 * 33]); o.z = pk2(s[4 * 33], s[5 * 33]); o.w = pk2(s[6 * 33], s[7 * 33]);
        if (IMG) { const int nn = dst_row0 + n, kk_ = k0 + 8 * c; *(GAS v4u*)((char*)WT + ((size_t)(((nn >> 4) * 32 + (kk_ >> 5)) * 64 + ((kk_ >> 3) & 3) * 16 + (nn & 15))) * 16) = o; }
        else *(GAS v4u*)(WT + (size_t)(dst_row0 + n) * K + k0 + 8 * c) = o; }
    LDS_WAIT(); asm volatile("" ::: "memory");
}
__device__ __forceinline__ void p0_mod_item(Frame& F, int item) {
    const float* c = F.in[I_C]; const float* wada = F.in[I_WADA]; const float* bada = F.in[I_BADA]; float* mod = (float*)(F.ws + WS_MOD);
    const int col = item * 4;
    f32x4 acc[4] = {{0.f, 0.f, 0.f, 0.f}, {0.f, 0.f, 0.f, 0.f}, {0.f, 0.f, 0.f, 0.f}, {0.f, 0.f, 0.f, 0.f}};
    f32x4 wv[16];
#pragma unroll
    for (int i = 0; i < 16; ++i) wv[i] = *(const f32x4*)(wada + (size_t)(F.lane + 64 * i) * 3072 + col);
#pragma unroll
    for (int i = 0; i < 16; ++i) { const int k = F.lane + 64 * i;
#pragma unroll
        for (int b = 0; b < 4; ++b) acc[b] += siluf_(c[b * D + k]) * wv[i]; }
#pragma unroll
    for (int b = 0; b < 4; ++b)
#pragma unroll
        for (int i = 0; i < 4; ++i) acc[b][i] = wave_sum(acc[b][i]);
    if (F.lane == 0) {
        const f32x4 bv = *(const f32x4*)(bada + col);
#pragma unroll
        for (int b = 0; b < 4; ++b) *(f32x4*)(mod + b * 3072 + col) = acc[b] + bv;
    }
}
__device__ __forceinline__ void p0_prologue(Frame& F) {
    LAS float* scr = (LAS float*)(F.lds + RING_OFF + F.wave * 16384);
    const int gw = F.vcu * NWAVES + F.wave, NGW = F.G * NWAVES;
    constexpr int I_MOD = 3072 / 4, I_IN = (D / 64) * (D_IN / 32), I_OUT = (D / 64) * (D / 32), I_W2 = 512 / 32;
    constexpr int NITEMS = I_MOD + I_IN + I_OUT + 2 * I_W2;
    bf16* WinT = (bf16*)(F.ws + WS_WIN); bf16* WoutT = (bf16*)(F.ws + WS_WOUT);
    for (int it = gw; it < NITEMS; it += NGW) {
        int r = it;
        if (r < I_MOD) { p0_mod_item(F, r); continue; } r -= I_MOD;
        if (r < I_IN) { const int nblk = D_IN / 32, kb = r / nblk, nb = r % nblk; p0_transpose_item(F.in[I_WIN], D, D_IN, WinT, 64 * kb, win_col(32 * nb), 32 * nb, scr, F.lane); continue; } r -= I_IN;
        if (r < I_OUT) { const int nblk = D / 32, kb = r / nblk, nb = r % nblk; p0_transpose_item<true>(F.in[I_WOUT], D, D, WoutT, 64 * kb, 32 * nb, 32 * nb, scr, F.lane); continue; } r -= I_OUT;
        { const int which = r / I_W2, nb = r % I_W2; p0_transpose_item(F.in[which ? I_WA2 : I_WW2], 64, 512, (bf16*)(F.ws + WS_W2T) + (size_t)which * 512 * 64, 0, 32 * nb, 32 * nb, scr, F.lane); }
    }
}
__device__ __forceinline__ void p1_rows(Frame& F) {
    const int gw = F.vcu * NWAVES + F.wave, NGW = F.G * NWAVES;
    const float* x = F.in[I_X]; const float* gpre = F.in[I_GPRE]; const float* mod = (const float*)(F.ws + WS_MOD); bf16* XN = (bf16*)(F.ws + WS_XN);
    for (int m0 = gw; m0 < M; m0 += 8 * NGW) {
        f32x4 v[8][4];
#pragma unroll
        for (int r = 0; r < 8; ++r) { const int m = m0 + r * NGW; if (m < M) { const GAS f32x4* xr = (const GAS f32x4*)(x + (size_t)m * D) + F.lane;
#pragma unroll
            for (int j = 0; j < 4; ++j) v[r][j] = __builtin_nontemporal_load(xr + 64 * j); } }
#pragma unroll
        for (int r = 0; r < 8; ++r) { const int m = m0 + r * NGW; if (m < M) { const int b = m / T; float s = 0.f;
#pragma unroll
            for (int j = 0; j < 4; ++j) s += (v[r][j].x * v[r][j].x + v[r][j].y * v[r][j].y) + (v[r][j].z * v[r][j].z + v[r][j].w * v[r][j].w);
            const float rstd = 1.f / sqrtf(wave_sum(s) * (1.f / D) + RMS_EPS);
            GAS unsigned long long* o8 = (GAS unsigned long long*)(XN + (size_t)m * D) + F.lane;
#pragma unroll
            for (int j = 0; j < 4; ++j) { const int col = 4 * F.lane + 256 * j;
                const f32x4 g = *(const f32x4*)(gpre + col), sh = *(const f32x4*)(mod + b * 3072 + col), sc = *(const f32x4*)(mod + b * 3072 + 1024 + col);
                const f32x4 h = v[r][j] * rstd * g * (sc + 1.f) + sh;
                o8[64 * j] = (unsigned long long)pk2(h.x, h.y) | ((unsigned long long)pk2(h.z, h.w) << 32); } } }
    }
}
__device__ __forceinline__ void glds16f(const void* gsrc, unsigned lds_dst) { unsigned keep;
    asm volatile("s_mov_b32 %0, m0\n\ts_mov_b32 m0, %2\n\ts_nop 0\n\tglobal_load_lds_dwordx4 %1, off\n\ts_mov_b32 m0, %0" : "=&s"(keep) : "v"(gsrc), "s"(lds_dst) : "memory"); }
__device__ __forceinline__ void glds4f(const void* gsrc, unsigned lds_dst) { unsigned keep;
    asm volatile("s_mov_b32 %0, m0\n\ts_mov_b32 m0, %2\n\ts_nop 0\n\tglobal_load_lds_dword %1, off\n\ts_mov_b32 m0, %0" : "=&s"(keep) : "v"(gsrc), "s"(lds_dst) : "memory"); }
__device__ __forceinline__ void p2_lora(Frame& F) {
    typedef float f32x4_ __attribute__((ext_vector_type(4)));
    const bf16* XN = (const bf16*)(F.ws + WS_XN); const bf16* Wl = (const bf16*)(F.ws + WS_WIN) + (size_t)NMAIN * D; bf16* LO = (bf16*)(F.ws + WS_LO);
    const int fr = F.lane & 15, fq = F.lane >> 4, w = F.wave;
    const unsigned lds0 = (unsigned)(uintptr_t)(F.lds + RING_OFF);
    for (int unit = F.vcu; unit < M / 64; unit += F.G) {
        const int row0 = unit * 64;
        const bf16* bp = Wl + (size_t)(w * 16 + fr) * D + fq * 8;
        bf16x8 bb[32];
#pragma unroll
        for (int k = 0; k < 32; ++k) bb[k] = *(const bf16x8*)(bp + k * 32);
#pragma unroll
        for (int j = 0; j < 16; ++j) { const int p = w + 8 * j, ks = p >> 2, rt = p & 3;
            glds16f(XN + (size_t)(row0 + rt * 16 + fr) * D + ks * 32 + fq * 8, (unsigned)__builtin_amdgcn_readfirstlane(lds0 + p * 1024)); }
        f32x4_ acc[4] = {{0.f, 0.f, 0.f, 0.f}, {0.f, 0.f, 0.f, 0.f}, {0.f, 0.f, 0.f, 0.f}, {0.f, 0.f, 0.f, 0.f}};
#define LORA_STAGE(s_, cnt_) do { asm volatile("s_waitcnt vmcnt(" #cnt_ ")" ::: "memory"); __builtin_amdgcn_s_barrier(); asm volatile("" ::: "memory"); \
            _Pragma("unroll") for (int k = 0; k < 8; ++k) { const int ks = (s_) * 8 + k; \
                _Pragma("unroll") for (int rt = 0; rt < 4; ++rt) { const bf16x8 a = *(const LAS bf16x8*)(F.lds + RING_OFF + (4 * ks + rt) * 1024 + F.lane * 16); \
                    acc[rt] = __builtin_amdgcn_mfma_f32_16x16x32_bf16(bb[ks], a, acc[rt], 0, 0, 0); } } } while (0)
        LORA_STAGE(0, 12); LORA_STAGE(1, 8); LORA_STAGE(2, 4); LORA_STAGE(3, 0);
#undef LORA_STAGE
#pragma unroll
        for (int rt = 0; rt < 4; ++rt) { const unsigned long long o = (unsigned long long)cvtpk(acc[rt][0], acc[rt][1]) | ((unsigned long long)cvtpk(acc[rt][2], acc[rt][3]) << 32);
            *(GAS unsigned long long*)(LO + (size_t)(row0 + rt * 16 + fr) * 128 + w * 16 + 4 * fq) = o; }
        LDS_WAIT(); __builtin_amdgcn_s_barrier();
    }
}
__device__ __forceinline__ float tshift(float cur, float prev, float mu) { return cur + (prev - cur) * mu; }

constexpr int REC_WA = 0, REC_RA = 2048, REC_AR = 4096, REC_BK = 5120, REC_VT = 9216, REC_MAK = 11264, REC_G = 11776, REC_BYTES = 12032;
constexpr int NCHUNK = T / 16;
constexpr int REC1_N = (int)((32 * MiB) / REC_BYTES);
static_assert((size_t)(BATCH * RW_H * NCHUNK - REC1_N) * REC_BYTES <= 65 * MiB, "record regions");
__device__ __forceinline__ unsigned char* rec_ptr(unsigned char* ws, int b, int h, int chunk) {
    const int idx = (b * RW_H + h) * NCHUNK + chunk;
    return idx < REC1_N ? ws + WS_REC1 + (size_t)idx * REC_BYTES : ws + WS_REC2 + (size_t)(idx - REC1_N) * REC_BYTES;
}
constexpr int PW_KAP = 0, PW_RH = 2304, PW_BH = 4608, PW_KH = 6912, PW_AAB = 9216, PW_AAK = 10496, PW_TM = 11776;
constexpr int PWS = 72;
static_assert(PW_TM + 16 * 20 * 4 <= 13312 && 2 * 16 * 68 * 4 <= PW_AAB, "prep scratch");

constexpr int PWB = 13312;
constexpr int PT_S = 68;
__device__ __forceinline__ float fast_exp(float x) { return __builtin_amdgcn_exp2f(x * LOG2E); }
__device__ __forceinline__ float fast_sigmoid(float x) { return __builtin_amdgcn_rcpf(1.f + fast_exp(-x)); }
__device__ __forceinline__ float fast_tanh(float x) { const float e = fast_exp(-2.f * fabsf(x)); const float t = (1.f - e) * __builtin_amdgcn_rcpf(1.f + e); return x < 0.f ? -t : t; }
__device__ __forceinline__ void p3_prep(Frame& F) {
    typedef float f32x4_ __attribute__((ext_vector_type(4)));
    const bf16* LO = (const bf16*)(F.ws + WS_LO); const bf16* Urk = (const bf16*)(F.ws + WS_URK); const bf16* Uvg = (const bf16*)(F.ws + WS_UVG); float* BON = (float*)(F.ws + WS_BONUS);
    const bf16* W2T = (const bf16*)(F.ws + WS_W2T);
    const float* mu = F.in[I_MU];
    LAS unsigned char* pw = F.lds + RING_OFF + F.wave * PWB;
    const int c = F.tid, lane = F.lane, h = F.wave, fi = lane & 15, fg = lane >> 4;
    const float k_k = F.in[I_KK][c], k_a = F.in[I_KA][c], r_k = F.in[I_RK][c], mu_r = mu[c], mu_k = mu[512 + c], mu_v = mu[1024 + c];
    float w0c[4], a0c[4];
#pragma unroll
    for (int nt = 0; nt < 4; ++nt) { w0c[nt] = F.in[I_W0][h * 64 + nt * 16 + fi]; a0c[nt] = F.in[I_A0][h * 64 + nt * 16 + fi]; }
    for (int tile = F.vcu; tile < M / 16; tile += F.G) {
        const int m0 = tile * 16, b = m0 / T, chunk = (m0 % T) / 16; const bool firstc = (chunk == 0);
        unsigned char* rec = rec_ptr(F.ws, b, h, chunk);
        unsigned short rw_[17], kw_[17], vw_[17];
#pragma unroll
        for (int i = 0; i < 17; ++i) { const size_t m = (size_t)(m0 + i - 1);
            if (i == 0 && firstc) { rw_[0] = 0; kw_[0] = 0; vw_[0] = 0; }
            else { rw_[i] = Urk[m * UP + c]; kw_[i] = Urk[m * UP + 512 + c]; vw_[i] = Uvg[m * UP + c]; } }
        float lw2[16], av[16];
        {
            bf16x8 fw[2], fa[2];
#pragma unroll
            for (int ks = 0; ks < 2; ++ks) {
                const bf16* lp = LO + (size_t)(m0 + fi) * 128 + ks * 32 + fg * 8; const bool nz = !(firstc && fi == 0);
                const v4u cw_ = *(const GAS v4u*)lp, ca_ = *(const GAS v4u*)(lp + 64);
                v4u pw_ = {0u, 0u, 0u, 0u}, pa_ = pw_; if (nz) { pw_ = *(const GAS v4u*)(lp - 128); pa_ = *(const GAS v4u*)(lp - 64); }
                const f32x4_ m0w = *(const f32x4_*)(mu + 1536 + ks * 32 + fg * 8), m1w = *(const f32x4_*)(mu + 1536 + ks * 32 + fg * 8 + 4), m0a = *(const f32x4_*)(mu + 1600 + ks * 32 + fg * 8), m1a = *(const f32x4_*)(mu + 1600 + ks * 32 + fg * 8 + 4);
                v4u ow, oa;
#pragma unroll
                for (int u = 0; u < 4; ++u) { const float mwl = (u < 2 ? m0w : m1w)[(2 * u) & 3], mwh = (u < 2 ? m0w : m1w)[(2 * u + 1) & 3], mal = (u < 2 ? m0a : m1a)[(2 * u) & 3], mah = (u < 2 ? m0a : m1a)[(2 * u + 1) & 3];
                    ow[u] = cvtpk(fast_tanh(tshift(bflo(cw_[u]), bflo(pw_[u]), mwl)), fast_tanh(tshift(bfhi(cw_[u]), bfhi(pw_[u]), mwh)));
                    oa[u] = cvtpk(tshift(bflo(ca_[u]), bflo(pa_[u]), mal), tshift(bfhi(ca_[u]), bfhi(pa_[u]), mah)); }
                fw[ks] = __builtin_bit_cast(bf16x8, ow); fa[ks] = __builtin_bit_cast(bf16x8, oa); }
            f32x4_ cw[4], ca[4];
#pragma unroll
            for (int nt = 0; nt < 4; ++nt) { cw[nt] = (f32x4_){0.f, 0.f, 0.f, 0.f}; ca[nt] = cw[nt]; }
#pragma unroll
            for (int nt = 0; nt < 4; ++nt)
#pragma unroll
                for (int ks = 0; ks < 2; ++ks) { const size_t o = (size_t)(h * 64 + nt * 16 + fi) * 64 + ks * 32 + fg * 8;
                    const bf16x8 bw = *(const bf16x8*)(W2T + o), ba = *(const bf16x8*)(W2T + 512 * 64 + o);
                    cw[nt] = __builtin_amdgcn_mfma_f32_16x16x32_bf16(fw[ks], bw, cw[nt], 0, 0, 0); ca[nt] = __builtin_amdgcn_mfma_f32_16x16x32_bf16(fa[ks], ba, ca[nt], 0, 0, 0); }
            LAS float* t1 = (LAS float*)pw; LAS float* t2 = t1 + 16 * PT_S;
#pragma unroll
            for (int nt = 0; nt < 4; ++nt)
#pragma unroll
                for (int j = 0; j < 4; ++j) { const float x_ = w0c[nt] + cw[nt][j];
                    t1[(4 * fg + j) * PT_S + nt * 16 + fi] = -0.8750403856f * fast_sigmoid(x_);
                    t2[(4 * fg + j) * PT_S + nt * 16 + fi] = fast_sigmoid(a0c[nt] + ca[nt][j]); }
            LDS_WAIT(); asm volatile("" ::: "memory");
#pragma unroll
            for (int i = 0; i < 16; ++i) { lw2[i] = t1[i * PT_S + lane]; av[i] = t2[i * PT_S + lane]; }
            LDS_WAIT(); asm volatile("" ::: "memory");
        }
        float kap[16], cl[16];
        {
        float rr[16], kt[16], kk[16], bb[16];
        LAS float* r1 = (LAS float*)pw; LAS float* r2 = r1 + 16 * PT_S; LAS float* s1 = (LAS float*)(pw + PW_TM);
        {
        float vv[16];
#pragma unroll
        for (int i = 0; i < 16; ++i) {
            const float r = tshift(bf2f(rw_[i + 1]), bf2f(rw_[i]), mu_r), k = tshift(bf2f(kw_[i + 1]), bf2f(kw_[i]), mu_k);
            vv[i] = tshift(bf2f(vw_[i + 1]), bf2f(vw_[i]), mu_v);
            const float kkr = k * k_k; kk[i] = kkr; kt[i] = k * (1.f + (av[i] - 1.f) * k_a); rr[i] = r;
            r1[i * PT_S + lane] = kkr * kkr; r2[i * PT_S + lane] = r * kt[i] * r_k; }
#pragma unroll
        for (int g = 0; g < 4; ++g) { const unsigned long long o = (unsigned long long)cvtpk(vv[4 * g], vv[4 * g + 1]) | ((unsigned long long)cvtpk(vv[4 * g + 2], vv[4 * g + 3]) << 32);
            *(GAS unsigned long long*)(rec + REC_VT + (lane >> 4) * 512 + (g * 16 + (lane & 15)) * 8) = o; }
        }
        LDS_WAIT(); asm volatile("" ::: "memory");
        { const int i = lane >> 2, q = lane & 3; float sa = 0.f, sb = 0.f;
#pragma unroll
          for (int u = 0; u < 4; ++u) { const f32x4_ x = *(const LAS f32x4_*)(r1 + i * PT_S + 16 * q + 4 * u), y = *(const LAS f32x4_*)(r2 + i * PT_S + 16 * q + 4 * u); sa += (x[0] + x[1]) + (x[2] + x[3]); sb += (y[0] + y[1]) + (y[2] + y[3]); }
          sa += __shfl_xor(sa, 1); sa += __shfl_xor(sa, 2); sb += __shfl_xor(sb, 1); sb += __shfl_xor(sb, 2);
          if (q == 0) { s1[i] = sa; BON[(m0 + i) * 8 + h] = sb; } }
        LDS_WAIT(); asm volatile("" ::: "memory");
        float run = 0.f;
#pragma unroll
        for (int i = 0; i < 16; ++i) { kk[i] = kk[i] * __builtin_amdgcn_rcpf(fmaxf(__builtin_amdgcn_sqrtf(s1[i]), 1e-12f)); bb[i] = av[i] * kk[i]; run += lw2[i]; cl[i] = run; }
        LDS_WAIT(); asm volatile("" ::: "memory");
        LAS unsigned short* okap = (LAS unsigned short*)(pw + PW_KAP); LAS unsigned short* orh = (LAS unsigned short*)(pw + PW_RH);
        LAS unsigned short* obh = (LAS unsigned short*)(pw + PW_BH); LAS unsigned short* okh = (LAS unsigned short*)(pw + PW_KH);
        const float cl15 = cl[15];
#pragma unroll
        for (int g = 0; g < 4; ++g) { float kd[4], nbd[4];
#pragma unroll
            for (int u = 0; u < 4; ++u) { const int i = 4 * g + u;
                const float e = __builtin_amdgcn_exp2f(cl[i]), em1 = (i == 0) ? 1.f : __builtin_amdgcn_exp2f(cl[i - 1]), inv = __builtin_amdgcn_exp2f(-cl[i]), eL = __builtin_amdgcn_exp2f(cl15 - cl[i]);
                kap[i] = kk[i] * em1; const float rh = rr[i] * e, kh = kt[i] * inv, bh = bb[i] * inv; kd[u] = kt[i] * eL; nbd[u] = -bb[i] * eL;
                okap[i * PWS + lane] = (unsigned short)(cvtpk(kap[i], 0.f) & 0xffffu); orh[i * PWS + lane] = (unsigned short)(cvtpk(rh, 0.f) & 0xffffu); obh[i * PWS + lane] = (unsigned short)(cvtpk(bh, 0.f) & 0xffffu); okh[i * PWS + lane] = (unsigned short)(cvtpk(kh, 0.f) & 0xffffu); }
            v4u o; o.x = cvtpk(nbd[0], nbd[1]); o.y = cvtpk(nbd[2], nbd[3]); o.z = cvtpk(kd[0], kd[1]); o.w = cvtpk(kd[2], kd[3]);
            *(GAS v4u*)(rec + REC_BK + (lane >> 4) * 1024 + (g * 16 + (lane & 15)) * 16) = o; }
        }
        *(GAS float*)(rec + REC_G + ((((lane >> 2) & 3) * 4 + (lane >> 4)) * 4 + (lane & 3)) * 4) = __builtin_amdgcn_exp2f(cl[15]);
        LDS_WAIT(); asm volatile("" ::: "memory");
        f32x4_ sab = {0.f, 0.f, 0.f, 0.f}, sak = sab, srb = sab, srk = sab;
#pragma unroll
        for (int ks = 0; ks < 2; ++ks) { const int off = (fi * PWS + ks * 32 + fg * 8) * 2;
            const bf16x8 fk = *(const LAS bf16x8*)(pw + PW_KAP + off), fr_ = *(const LAS bf16x8*)(pw + PW_RH + off), fb = *(const LAS bf16x8*)(pw + PW_BH + off), fh = *(const LAS bf16x8*)(pw + PW_KH + off);
            sab = __builtin_amdgcn_mfma_f32_16x16x32_bf16(fk, fb, sab, 0, 0, 0); sak = __builtin_amdgcn_mfma_f32_16x16x32_bf16(fk, fh, sak, 0, 0, 0);
            srb = __builtin_amdgcn_mfma_f32_16x16x32_bf16(fr_, fb, srb, 0, 0, 0); srk = __builtin_amdgcn_mfma_f32_16x16x32_bf16(fr_, fh, srk, 0, 0, 0); }
        LAS float* Aab = (LAS float*)(pw + PW_AAB); LAS float* Aak = (LAS float*)(pw + PW_AAK); LAS float* Tm = (LAS float*)(pw + PW_TM);
        LAS unsigned short* arimg = (LAS unsigned short*)(pw + PW_BH);
        asm volatile("" ::: "memory");
#pragma unroll
        for (int j = 0; j < 4; ++j) { const int i = 4 * fg + j;
            Aab[i * 20 + fi] = (fi < i) ? sab[j] : 0.f; Aak[i * 20 + fi] = (fi < i) ? sak[j] : 0.f;
            const float nrb = (fi <= i) ? -srb[j] : 0.f, rk = (fi <= i) ? srk[j] : 0.f; const unsigned pk = cvtpk(nrb, rk);
            arimg[((fi >> 2) * 16 + i) * 8 + (fi & 3)] = (unsigned short)(pk & 0xffffu); arimg[((fi >> 2) * 16 + i) * 8 + 4 + (fi & 3)] = (unsigned short)(pk >> 16); }
        LDS_WAIT(); asm volatile("" ::: "memory");
        *(GAS v4u*)(rec + REC_AR + lane * 16) = *(const LAS v4u*)(pw + PW_BH + lane * 16);
        float tc[16];
#pragma unroll
        for (int i = 0; i < 16; ++i) { float acc = (i == fi) ? 1.f : 0.f;
#pragma unroll
            for (int j4 = 0; j4 < i; j4 += 4) { const f32x4_ ar_ = *(const LAS f32x4_*)(Aab + i * 20 + j4);
#pragma unroll
                for (int u = 0; u < 4; ++u) if (j4 + u < i) acc -= ar_[u] * tc[j4 + u]; }
            tc[i] = acc; }
        if (fg == 0) {
#pragma unroll
            for (int i = 0; i < 16; ++i) Tm[i * 20 + fi] = tc[i]; }
        LDS_WAIT(); asm volatile("" ::: "memory");
        { LAS unsigned short* okap = (LAS unsigned short*)(pw + PW_KAP);
#pragma unroll
        for (int i = 0; i < 16; ++i) { float acc = 0.f;
#pragma unroll
            for (int j4 = 0; j4 <= i; j4 += 4) { const f32x4_ tr_ = *(const LAS f32x4_*)(Tm + i * 20 + j4);
#pragma unroll
                for (int u = 0; u < 4; ++u) if (j4 + u <= i) acc += tr_[u] * kap[j4 + u]; }
            okap[i * PWS + lane] = (unsigned short)(cvtpk(acc, 0.f) & 0xffffu); } }
        { const int i = lane >> 2, q = lane & 3; f32x4_ acc = {0.f, 0.f, 0.f, 0.f};
#pragma unroll
          for (int j4 = 0; j4 < 16; j4 += 4) { const f32x4_ tr_ = *(const LAS f32x4_*)(Tm + i * 20 + j4);
#pragma unroll
              for (int u = 0; u < 4; ++u) acc += tr_[u] * *(const LAS f32x4_*)(Aak + (j4 + u) * 20 + 4 * q); }
          *(GAS unsigned long long*)(rec + REC_MAK + (q * 16 + i) * 8) = (unsigned long long)cvtpk(acc[0], acc[1]) | ((unsigned long long)cvtpk(acc[2], acc[3]) << 32); }
        LDS_WAIT(); asm volatile("" ::: "memory");
#pragma unroll
        for (int ks = 0; ks < 2; ++ks) { const int off = (fi * PWS + ks * 32 + 4 * fg) * 2;
            const unsigned long long w0_ = *(const LAS unsigned long long*)(pw + PW_KAP + off), w1_ = *(const LAS unsigned long long*)(pw + PW_KAP + off + 32);
            const unsigned long long r0_ = *(const LAS unsigned long long*)(pw + PW_RH + off), r1_ = *(const LAS unsigned long long*)(pw + PW_RH + off + 32);
            v4u o; o.x = (unsigned)w0_; o.y = (unsigned)(w0_ >> 32); o.z = (unsigned)w1_; o.w = (unsigned)(w1_ >> 32);
            *(GAS v4u*)(rec + REC_WA + ks * 1024 + lane * 16) = o;
            o.x = (unsigned)r0_; o.y = (unsigned)(r0_ >> 32); o.z = (unsigned)r1_; o.w = (unsigned)(r1_ >> 32);
            *(GAS v4u*)(rec + REC_RA + ks * 1024 + lane * 16) = o; }
        LDS_WAIT(); asm volatile("" ::: "memory");
    }
}
constexpr int SCAN_NS = 8;
__device__ __forceinline__ void p4_scan(Frame& F) {
    typedef float f32x4_ __attribute__((ext_vector_type(4)));
    const int si = (int)blockIdx.x;
    if (si >= BATCH * RW_H) return;
    const int b = si / RW_H, h = si % RW_H, lane = F.lane, w = F.wave;
    const unsigned lds0 = (unsigned)(uintptr_t)(F.lds + RING_OFF);
    if (w >= 4) {
        const int lw = w - 4;
#define SCAN_ISSUE(n) do { const int n_ = (n) < NCHUNK ? (n) : NCHUNK - 1; const unsigned char* rp = rec_ptr(F.ws, b, h, n_); const unsigned sb = lds0 + (unsigned)(((n) % SCAN_NS) * REC_BYTES); \
            glds16f(rp + lw * 1024 + lane * 16, (unsigned)__builtin_amdgcn_readfirstlane(sb + lw * 1024)); glds16f(rp + (lw + 4) * 1024 + lane * 16, (unsigned)__builtin_amdgcn_readfirstlane(sb + (lw + 4) * 1024)); \
            if (lw < 3) { glds16f(rp + (lw + 8) * 1024 + lane * 16, (unsigned)__builtin_amdgcn_readfirstlane(sb + (lw + 8) * 1024)); glds4f(rp + 11264 + lw * 256 + lane * 4, (unsigned)__builtin_amdgcn_readfirstlane(sb + 11264 + lw * 256)); } } while (0)
        for (int n = 0; n < SCAN_NS - 1; ++n) SCAN_ISSUE(n);
        for (int n = 0; n < NCHUNK; ++n) {
            if (lw < 3) asm volatile("s_waitcnt vmcnt(24)" ::: "memory"); else asm volatile("s_waitcnt vmcnt(12)" ::: "memory");
            __builtin_amdgcn_s_barrier(); asm volatile("" ::: "memory");
            SCAN_ISSUE(n + SCAN_NS - 1);
        }
        asm volatile("s_waitcnt vmcnt(0)" ::: "memory");
        __builtin_amdgcn_s_barrier();
#undef SCAN_ISSUE
        return;
    }
    bf16* Orw = (bf16*)(F.ws + WS_ORW);
    const int fc = lane & 15, fg = lane >> 4;
    f32x4_ H[4];
#pragma unroll
    for (int mt = 0; mt < 4; ++mt) H[mt] = (f32x4_){0.f, 0.f, 0.f, 0.f};
    bf16x8 hb0 = {0, 0, 0, 0, 0, 0, 0, 0}, hb1 = hb0;
    bf16* orow = Orw + ((size_t)b * T + 4 * fg) * 512 + h * 64 + 16 * w + fc;
    for (int n = 0; n < NCHUNK; ++n) {
        LDS_WAIT(); __builtin_amdgcn_s_barrier(); asm volatile("" ::: "memory");
        const LAS unsigned char* sb = F.lds + RING_OFF + (n % SCAN_NS) * REC_BYTES;
        typedef unsigned u32x2_ __attribute__((ext_vector_type(2)));
        const bf16x8 wa0 = *(const LAS bf16x8*)(sb + REC_WA + lane * 16), wa1 = *(const LAS bf16x8*)(sb + REC_WA + 1024 + lane * 16);
        const u32x2_ mk = *(const LAS u32x2_*)(sb + REC_MAK + lane * 8);
        const bf16x8 ra0 = *(const LAS bf16x8*)(sb + REC_RA + lane * 16), ra1 = *(const LAS bf16x8*)(sb + REC_RA + 1024 + lane * 16), ar = *(const LAS bf16x8*)(sb + REC_AR + lane * 16);
        bf16x8 bk[4]; f32x4_ gm[4];
#pragma unroll
        for (int mt = 0; mt < 4; ++mt) { bk[mt] = *(const LAS bf16x8*)(sb + REC_BK + mt * 1024 + lane * 16); gm[mt] = *(const LAS f32x4_*)(sb + REC_G + fg * 64 + mt * 16); }
        const u32x2_ vt = *(const LAS u32x2_*)(sb + REC_VT + w * 512 + lane * 8);
        const bf16x8 vz = __builtin_bit_cast(bf16x8, (v4u){0u, 0u, vt.x, vt.y}), mak = __builtin_bit_cast(bf16x8, (v4u){0u, 0u, mk.x, mk.y});
        f32x4_ U = {0.f, 0.f, 0.f, 0.f}, O = {0.f, 0.f, 0.f, 0.f};
        U = __builtin_amdgcn_mfma_f32_16x16x32_bf16(wa0, hb0, U, 0, 0, 0);
        U = __builtin_amdgcn_mfma_f32_16x16x32_bf16(wa1, hb1, U, 0, 0, 0);
        U = __builtin_amdgcn_mfma_f32_16x16x32_bf16(mak, vz, U, 0, 0, 0);
        O = __builtin_amdgcn_mfma_f32_16x16x32_bf16(ra0, hb0, O, 0, 0, 0);
        O = __builtin_amdgcn_mfma_f32_16x16x32_bf16(ra1, hb1, O, 0, 0, 0);
#pragma unroll
        for (int mt = 0; mt < 4; ++mt) H[mt] = H[mt] * gm[mt];
        const bf16x8 uv = __builtin_bit_cast(bf16x8, (v4u){cvtpk(U[0], U[1]), cvtpk(U[2], U[3]), vt.x, vt.y});
#pragma unroll
        for (int mt = 0; mt < 4; ++mt) H[mt] = __builtin_amdgcn_mfma_f32_16x16x32_bf16(bk[mt], uv, H[mt], 0, 0, 0);
        O = __builtin_amdgcn_mfma_f32_16x16x32_bf16(ar, uv, O, 0, 0, 0);
        hb0 = __builtin_bit_cast(bf16x8, (v4u){cvtpk(H[0][0], H[0][1]), cvtpk(H[0][2], H[0][3]), cvtpk(H[1][0], H[1][1]), cvtpk(H[1][2], H[1][3])});
        hb1 = __builtin_bit_cast(bf16x8, (v4u){cvtpk(H[2][0], H[2][1]), cvtpk(H[2][2], H[2][3]), cvtpk(H[3][0], H[3][1]), cvtpk(H[3][2], H[3][3])});
        bf16* op = orow + (size_t)n * 16 * 512;
#pragma unroll
        for (int j = 0; j < 4; ++j) op[(size_t)j * 512] = (bf16)(cvtpk(O[j], 0.f) & 0xffffu);
    }
    LDS_WAIT(); __builtin_amdgcn_s_barrier();
}
__device__ __forceinline__ void p6_assemble(Frame& F) {
    const int gw = F.vcu * NWAVES + F.wave, NGW = F.G * NWAVES;
    const bf16* Orw = (const bf16*)(F.ws + WS_ORW); const bf16* Uvg = (const bf16*)(F.ws + WS_UVG); const bf16* Uqg = (const bf16*)(F.ws + WS_UQG); const bf16* O0 = (const bf16*)(F.ws + WS_URK); const bf16* O1 = O0 + 512;
    const float* BON = (const float*)(F.ws + WS_BONUS); bf16* Y = (bf16*)(F.ws + WS_Y);
    const float lam = __expf(wave_sum(F.in[I_LQ1][F.lane] * F.in[I_LK1][F.lane])) - __expf(wave_sum(F.in[I_LQ2][F.lane] * F.in[I_LK2][F.lane])) + LAMBDA_INIT;
    const int c0 = 8 * F.lane;
    float lw[8], lb[8], muv[8], sw[8];
#pragma unroll
    for (int i = 0; i < 8; ++i) { lw[i] = F.in[I_LNW][c0 + i]; lb[i] = F.in[I_LNB][c0 + i]; muv[i] = F.in[I_MU][1024 + c0 + i]; sw[i] = F.in[I_SUBLN][(c0 + i) & 127] * (1.f - LAMBDA_INIT); }
    for (int m = gw; m < M; m += NGW) {
        const bool first = (m % T == 0);
        const v4u ow = *(const GAS v4u*)(Orw + (size_t)m * 512 + c0), vw = *(const GAS v4u*)(Uvg + (size_t)m * UP + c0), gw_ = *(const GAS v4u*)(Uvg + (size_t)m * UP + 512 + c0);
        v4u pw = {0u, 0u, 0u, 0u}; if (!first) pw = *(const GAS v4u*)(Uvg + (size_t)(m - 1) * UP + c0);
        float o[8], v[8], g[8];
#pragma unroll
        for (int i = 0; i < 4; ++i) { o[2 * i] = bflo(ow[i]); o[2 * i + 1] = bfhi(ow[i]); g[2 * i] = bflo(gw_[i]); g[2 * i + 1] = bfhi(gw_[i]);
            v[2 * i] = tshift(bflo(vw[i]), bflo(pw[i]), muv[2 * i]); v[2 * i + 1] = tshift(bfhi(vw[i]), bfhi(pw[i]), muv[2 * i + 1]); }
        float s = 0.f;
#pragma unroll
        for (int i = 0; i < 8; ++i) s += o[i];
        s += __shfl_xor(s, 1); s += __shfl_xor(s, 2); s += __shfl_xor(s, 4);
        const float mean = s * (1.f / 64.f); float q = 0.f;
#pragma unroll
        for (int i = 0; i < 8; ++i) { o[i] -= mean; q += o[i] * o[i]; }
        q += __shfl_xor(q, 1); q += __shfl_xor(q, 2); q += __shfl_xor(q, 4);
        const float rstd = 1.f / sqrtf(q * (1.f / 64.f) + GN_EPS), bon = BON[m * 8 + (F.lane >> 3)];
        float y[8];
#pragma unroll
        for (int i = 0; i < 8; ++i) y[i] = (o[i] * rstd * lw[i] + lb[i] + bon * v[i]) * siluf_(g[i]);
        v4u yo; yo.x = pk2(y[0], y[1]); yo.y = pk2(y[2], y[3]); yo.z = pk2(y[4], y[5]); yo.w = pk2(y[6], y[7]);
        *(GAS v4u*)(Y + (size_t)m * D + c0) = yo;
        const v4u a0 = *(const GAS v4u*)(O0 + (size_t)m * 1024 + c0), a1 = *(const GAS v4u*)(O1 + (size_t)m * 1024 + c0), dgw = *(const GAS v4u*)(Uqg + (size_t)m * 1024 + 512 + c0);
        float d[8]; float ms = 0.f;
#pragma unroll
        for (int i = 0; i < 4; ++i) { d[2 * i] = bflo(a0[i]) - lam * bflo(a1[i]); d[2 * i + 1] = bfhi(a0[i]) - lam * bfhi(a1[i]); g[2 * i] = bflo(dgw[i]); g[2 * i + 1] = bfhi(dgw[i]); }
#pragma unroll
        for (int i = 0; i < 8; ++i) ms += d[i] * d[i];
        ms += __shfl_xor(ms, 1); ms += __shfl_xor(ms, 2); ms += __shfl_xor(ms, 4); ms += __shfl_xor(ms, 8);
        const float rs = 1.f / sqrtf(ms * (1.f / 128.f) + SUBLN_EPS);
#pragma unroll
        for (int i = 0; i < 8; ++i) y[i] = d[i] * rs * sw[i] * siluf_(g[i]);
        yo.x = pk2(y[0], y[1]); yo.y = pk2(y[2], y[3]); yo.z = pk2(y[4], y[5]); yo.w = pk2(y[6], y[7]);
        *(GAS v4u*)(Y + (size_t)m * D + 512 + c0) = yo;
    }
}
__device__ __forceinline__ void p67_fused(Frame& F) {
    typedef float f32x4_ __attribute__((ext_vector_type(4)));
    const bf16* Orw = (const bf16*)(F.ws + WS_ORW); const bf16* Uvg = (const bf16*)(F.ws + WS_UVG); const bf16* Uqg = (const bf16*)(F.ws + WS_UQG); const bf16* O0 = (const bf16*)(F.ws + WS_URK); const bf16* O1 = O0 + 512;
    const float* BON = (const float*)(F.ws + WS_BONUS); const unsigned char* Wimg = (const unsigned char*)(F.ws + WS_WOUT);
    const float* x = F.in[I_X]; const float* gpost = F.in[I_GPOST]; const float* mod = (const float*)(F.ws + WS_MOD);
    const int lane = F.lane, w = F.wave, fr = lane & 15, fq = lane >> 4;
    const float lam = __expf(wave_sum(F.in[I_LQ1][lane] * F.in[I_LK1][lane])) - __expf(wave_sum(F.in[I_LQ2][lane] * F.in[I_LK2][lane])) + LAMBDA_INIT;
    LAS unsigned char* A = F.lds + RING_OFF;
    {
        const int unit = F.vcu; const int r0 = unit * 64, bb = r0 / T;
        {
            const int c0 = 8 * lane;
            float lw[8], lb[8], muv[8], sw[8];
#pragma unroll
            for (int i = 0; i < 8; ++i) { lw[i] = F.in[I_LNW][c0 + i]; lb[i] = F.in[I_LNB][c0 + i]; muv[i] = F.in[I_MU][1024 + c0 + i]; sw[i] = F.in[I_SUBLN][(c0 + i) & 127] * (1.f - LAMBDA_INIT); }
            LAS unsigned char* arow = A + ((lane >> 2) * 4 + (w >> 1)) * 1024 + ((lane & 3) * 16 + 8 * (w & 1)) * 16;
#pragma unroll 2
            for (int j = 0; j < 8; ++j) { const int m = r0 + 8 * w + j; const bool first = (m % T == 0);
                const v4u ow = *(const GAS v4u*)(Orw + (size_t)m * 512 + c0), vw = *(const GAS v4u*)(Uvg + (size_t)m * UP + c0), gw_ = *(const GAS v4u*)(Uvg + (size_t)m * UP + 512 + c0);
                v4u pw = {0u, 0u, 0u, 0u}; if (!first) pw = *(const GAS v4u*)(Uvg + (size_t)(m - 1) * UP + c0);
                const v4u a0 = *(const GAS v4u*)(O0 + (size_t)m * 1024 + c0), a1 = *(const GAS v4u*)(O1 + (size_t)m * 1024 + c0), dgw = *(const GAS v4u*)(Uqg + (size_t)m * 1024 + 512 + c0);
                const float bon = BON[m * 8 + (lane >> 3)];
                float o[8], v[8], g[8];
#pragma unroll
                for (int i = 0; i < 4; ++i) { o[2 * i] = bflo(ow[i]); o[2 * i + 1] = bfhi(ow[i]); g[2 * i] = bflo(gw_[i]); g[2 * i + 1] = bfhi(gw_[i]);
                    v[2 * i] = tshift(bflo(vw[i]), bflo(pw[i]), muv[2 * i]); v[2 * i + 1] = tshift(bfhi(vw[i]), bfhi(pw[i]), muv[2 * i + 1]); }
                float s = 0.f;
#pragma unroll
                for (int i = 0; i < 8; ++i) s += o[i];
                s = sum8_dpp(s);
                const float mean = s * (1.f / 64.f); float q = 0.f;
#pragma unroll
                for (int i = 0; i < 8; ++i) { o[i] -= mean; q += o[i] * o[i]; }
                q = sum8_dpp(q);
                const float rstd = __builtin_amdgcn_rsqf(q * (1.f / 64.f) + GN_EPS);
                float y[8];
#pragma unroll
                for (int i = 0; i < 8; ++i) y[i] = (o[i] * rstd * lw[i] + lb[i] + bon * v[i]) * silu_fast(g[i]);
                *(LAS v4u*)(arow + j * 16) = (v4u){cvtpk(y[0], y[1]), cvtpk(y[2], y[3]), cvtpk(y[4], y[5]), cvtpk(y[6], y[7])};
                float d[8]; float ms = 0.f;
#pragma unroll
                for (int i = 0; i < 4; ++i) { d[2 * i] = bflo(a0[i]) - lam * bflo(a1[i]); d[2 * i + 1] = bfhi(a0[i]) - lam * bfhi(a1[i]); g[2 * i] = bflo(dgw[i]); g[2 * i + 1] = bfhi(dgw[i]); }
#pragma unroll
                for (int i = 0; i < 8; ++i) ms += d[i] * d[i];
                ms = sum16_dpp(ms);
                const float rs = __builtin_amdgcn_rsqf(ms * (1.f / 128.f) + SUBLN_EPS);
#pragma unroll
                for (int i = 0; i < 8; ++i) y[i] = d[i] * rs * sw[i] * silu_fast(g[i]);
                *(LAS v4u*)(arow + 65536 + j * 16) = (v4u){cvtpk(y[0], y[1]), cvtpk(y[2], y[3]), cvtpk(y[4], y[5]), cvtpk(y[6], y[7])}; }
        }
        __syncthreads();
        f32x4_ acc[4][8];
#pragma unroll
        for (int rt = 0; rt < 4; ++rt)
#pragma unroll
            for (int nt = 0; nt < 8; ++nt) acc[rt][nt] = (f32x4_){0.f, 0.f, 0.f, 0.f};
        const unsigned char* bp = Wimg + ((size_t)(8 * w) * 32 * 64 + lane) * 16;
        bf16x8 b0_[8], b1_[8];
#pragma unroll
        for (int nt = 0; nt < 8; ++nt) b0_[nt] = *(const bf16x8*)(bp + nt * 32768);
#define P67_STEP(BC, BN, ks_) do { \
            if ((ks_) + 1 < 32) { _Pragma("unroll") for (int nt = 0; nt < 8; ++nt) BN[nt] = *(const bf16x8*)(bp + nt * 32768 + ((ks_) + 1) * 1024); } \
            bf16x8 af[4]; _Pragma("unroll") for (int rt = 0; rt < 4; ++rt) af[rt] = *(const LAS bf16x8*)(A + ((ks_) * 4 + rt) * 1024 + lane * 16); \
            _Pragma("unroll") for (int nt = 0; nt < 8; ++nt) _Pragma("unroll") for (int rt = 0; rt < 4; ++rt) acc[rt][nt] = __builtin_amdgcn_mfma_f32_16x16x32_bf16(BC[nt], af[rt], acc[rt][nt], 0, 0, 0); } while (0)
        for (int ks = 0; ks < 32; ks += 2) { P67_STEP(b0_, b1_, ks); P67_STEP(b1_, b0_, ks + 1); }
#undef P67_STEP
        float ss[4];
#pragma unroll
        for (int rt = 0; rt < 4; ++rt) { float s_ = 0.f;
#pragma unroll
            for (int nt = 0; nt < 8; ++nt) { const f32x4_ a_ = acc[rt][nt]; s_ += (a_[0] * a_[0] + a_[1] * a_[1]) + (a_[2] * a_[2] + a_[3] * a_[3]); }
            s_ += __shfl_xor(s_, 16); s_ += __shfl_xor(s_, 32); ss[rt] = s_; }
        __syncthreads();
        LAS float* P = (LAS float*)A;
        if (fq == 0) {
#pragma unroll
            for (int rt = 0; rt < 4; ++rt) P[(rt * 16 + fr) * 8 + w] = ss[rt]; }
        __syncthreads();
        const float* grow = mod + (size_t)bb * 3072 + 2048;
        float rstd[4];
#pragma unroll
        for (int rt = 0; rt < 4; ++rt) { const int row = rt * 16 + fr; const f32x4_ p0_ = *(const LAS f32x4_*)(P + row * 8), p1_ = *(const LAS f32x4_*)(P + row * 8 + 4);
            rstd[rt] = 1.f / sqrtf(((p0_[0] + p0_[1]) + (p0_[2] + p0_[3]) + (p1_[0] + p1_[1]) + (p1_[2] + p1_[3])) * (1.f / D) + RMS_EPS); }
        LAS unsigned char* tb = A + 4096 + w * 8448;
        const int rr = lane >> 5, c4 = lane & 31, colr = 128 * w + 4 * c4;
        const f32x4_ cfr = *(const f32x4_*)(grow + colr) * *(const f32x4_*)(gpost + colr);
#pragma unroll
        for (int rt = 0; rt < 4; ++rt) {
            f32x4_ xr[8];
#pragma unroll
            for (int k = 0; k < 8; ++k) xr[k] = __builtin_nontemporal_load((const f32x4_*)(x + (size_t)(r0 + rt * 16 + 2 * k + rr) * D + colr));
#pragma unroll
            for (int nt = 0; nt < 8; ++nt) *(LAS f32x4_*)(tb + fr * 528 + (16 * nt + 4 * fq) * 4) = acc[rt][nt] * rstd[rt];
            LDS_WAIT(); asm volatile("" ::: "memory");
#pragma unroll
            for (int k = 0; k < 8; ++k) { const f32x4_ t_ = *(const LAS f32x4_*)(tb + (2 * k + rr) * 528 + c4 * 16);
                *(f32x4_*)(F.out + (size_t)(r0 + rt * 16 + 2 * k + rr) * D + colr) = xr[k] + t_ * cfr; }
            LDS_WAIT(); asm volatile("" ::: "memory");
        }
        __syncthreads();
    }
}
__device__ __forceinline__ void nan_rows_f32(Frame& F, float* out) {
    const int gw = F.vcu * NWAVES + F.wave, NGW = F.G * NWAVES; const float q = __builtin_nanf("");
    for (int m = gw; m < M; m += NGW) { GAS f32x4* o = (GAS f32x4*)(out + (size_t)m * D) + F.lane;
#pragma unroll
        for (int j = 0; j < 4; ++j) o[64 * j] = (f32x4){q, q, q, q}; }
}
__device__ __forceinline__ void wrong_grid_word(Frame& F) {
    if (blockIdx.x == 0 && F.tid == 0) { unsigned expect = 0u; __hip_atomic_compare_exchange_strong((unsigned*)(F.ctl + CW_CODE), &expect, 0x7f0u, __ATOMIC_RELAXED, __ATOMIC_RELAXED, __HIP_MEMORY_SCOPE_AGENT);
        __hip_atomic_store(F.ctl + CW_TMO, 1u, RLX_AGENT); }
}

struct Args { const float* in[23]; float* out; unsigned char* ws; int ph_lo, ph_hi, li, pad; };
__global__ void __launch_bounds__(NWAVES * 64, 2) skel_fwd(Args args) {
    extern __shared__ __attribute__((aligned(16))) unsigned char lds[];
    Frame F;
    F.lds = (LAS unsigned char*)lds;
    F.MISC = (volatile LAS unsigned*)(F.lds + MISC_OFF);
    F.tid = threadIdx.x; F.lane = F.tid & 63; F.wave = __builtin_amdgcn_readfirstlane(F.tid >> 6);
    F.G = gridDim.x; { const int bx = blockIdx.x; F.vcu = (F.G % 8 == 0) ? (bx % 8) * (F.G / 8) + bx / 8 : bx; }
#define GRID_BAR(seam) do { if (N_LAUNCHES == PER_PHASE) { if (F.tid == 0) __hip_atomic_store(F.ctl + CW_TMO, 0xBADBA0u | (unsigned)(seam), RLX_AGENT); } \
    else { xcd_barrier(bar); } } while (0)
    unsigned char* ws = args.ws; F.ws = ws;
    F.ctl = (gu32*)(ws + WS_CTL);
#pragma unroll
    for (int i = 0; i < 23; ++i) F.in[i] = args.in[i];
    F.out = args.out;
    for (int u = F.tid; u < (LDS_BYTES - LDSCTL_OFF) / 4; u += NWAVES * 64) ((LAS unsigned*)(F.lds + LDSCTL_OFF))[u] = 0u;
    __syncthreads();
    XcdBarrier bar; bar.bar = (unsigned*)(F.ctl + CW_BAR); bar.x = 0; bar.st = nullptr;
    if (N_LAUNCHES != PER_PHASE) bar = xcd_barrier_post((unsigned*)(F.ctl + CW_BAR), F.MISC + 8);

    const int lo = args.ph_lo, hi = args.ph_hi;
#define IN(k) (lo <= (k) && (k) < hi)
#define BOTH(k) (IN(k) && IN((k) + 1))

#ifndef PROBE_PHASE
#define PROBE_PHASE -1
#endif
#ifndef PROBE_REPS
#define PROBE_REPS 2
#endif
#define REPS(k) ((k) == PROBE_PHASE ? PROBE_REPS : 1)
    if (IN(0)) { for (int rep = 0; rep < REPS(0); ++rep) p0_prologue(F); if (BOTH(0)) GRID_BAR(0); }
    if (IN(1)) { for (int rep = 0; rep < REPS(1); ++rep) p1_rows(F); if (BOTH(1)) GRID_BAR(1); }
    if (PROBE_PHASE == 9) { for (int rep = 0; rep < 16; ++rep) GRID_BAR(9); }
    if (IN(2)) {
        pg8::Gemm g{(const pg8::bf16_t*)(ws + WS_XN), (const pg8::bf16_t*)(ws + WS_WIN), M, NMAIN, D}; pg8::StaticOrder S; S.init(M, NMAIN, F.G, (int)blockIdx.x);
        pg8::EpiU E{(pg8::bf16_t*)(ws + WS_URK), (pg8::bf16_t*)(ws + WS_UVG), (pg8::bf16_t*)(ws + WS_UQG), (pg8::bf16_t*)(ws + WS_KIMG), (pg8::bf16_t*)(ws + WS_VIMG), attn_body::C2, T};
        for (int rep = 0; rep < REPS(2); ++rep) pg8::gemm_phase<pg8::EpiU, pg8::StaticOrder, PG8_ALIGN, PG8_SP2>(F.lds + RING_OFF, g, S, E);
        for (int rep = 0; rep < REPS(8); ++rep) p2_lora(F);
        if (BOTH(2)) GRID_BAR(2);
    }
    if (IN(3)) { for (int rep = 0; rep < REPS(3); ++rep) p3_prep(F); if (BOTH(3)) GRID_BAR(3); }
    if (IN(4)) {
        for (int rep = 0; rep < REPS(4); ++rep) p4_scan(F);
        const attn_body::AttnTensors AT{(const attn_body::bf16*)(ws + WS_UQG), (const attn_body::bf16*)(ws + WS_KIMG), (const attn_body::bf16*)(ws + WS_VIMG), (attn_body::bf16*)(ws + WS_URK), (attn_body::bf16*)(ws + WS_URK) + 512};
        if (F.G == 256) attn_body::attn_phase_queue((char*)lds + RING_OFF, AT, (unsigned*)(F.ctl + CW_QUEUE), (int)(xb_xcc_id() & 7u), F.MISC + 16);
        if (PROBE_PHASE == 5) { GRID_BAR(5); attn_body::attn_phase_queue((char*)lds + RING_OFF, AT, (unsigned*)(F.ctl + CW_QUEUE + 512 + 64 * ((int)blockIdx.x & 7)), (int)blockIdx.x & 7, F.MISC + 16); }
        if (BOTH(4)) GRID_BAR(4);
    }
    if (IN(6)) { }
    if (IN(7)) { if (F.G == 256) p67_fused(F); else { nan_rows_f32(F, F.out); wrong_grid_word(F); } }
#undef IN
#undef BOTH
}

extern "C" void kernel_launch(void* const* d_in, const int* in_sizes, int n_in, void* d_out, int out_size, void* d_ws, size_t ws_size, hipStream_t stream) {
    static int grid = 0;
    if (grid == 0) {
        if (n_in != 23 || in_sizes[0] != M * D || out_size != M * D || ws_size < WS_END) { fprintf(stderr, "kernel_launch: built for 23 inputs, x and out of %d floats, >= %zu bytes of workspace; got n_in %d, in0 %d, out %d, ws %zu; nothing launched\n", M * D, (size_t)WS_END, n_in, n_in > 0 ? in_sizes[0] : -1, out_size, ws_size); grid = -1; return; }
        int dev = 0, cus = 0, per_cu = 0;
        if (hipGetDevice(&dev) != hipSuccess || hipDeviceGetAttribute(&cus, hipDeviceAttributeMultiprocessorCount, dev) != hipSuccess) { fprintf(stderr, "kernel_launch: hipGetDevice / hipDeviceGetAttribute failed; nothing launched\n"); grid = -1; return; }
        if (hipFuncSetAttribute((const void*)skel_fwd, hipFuncAttributeMaxDynamicSharedMemorySize, LDS_BYTES) != hipSuccess) { fprintf(stderr, "kernel_launch: hipFuncSetAttribute failed\n"); grid = -1; return; }
        if (hipOccupancyMaxActiveBlocksPerMultiprocessor(&per_cu, (const void*)skel_fwd, NWAVES * 64, LDS_BYTES) != hipSuccess || per_cu < 1)
            fprintf(stderr, "kernel_launch: note: the occupancy query reports %d workgroups per CU\n", per_cu);
        (void)hipGetLastError();
        grid = cus;
        if (grid != 256) fprintf(stderr, "kernel_launch: launching %d workgroups; the fused phases need exactly 256\n", grid);
    }
    if (grid < 0) return;
    if (hipMemsetAsync((char*)d_ws + WS_CTL, 0, CTL_ZERO_BYTES, stream) != hipSuccess) { fprintf(stderr, "kernel_launch: hipMemsetAsync of the control words failed; nothing launched\n"); return; }
    Args a{};
    for (int i = 0; i < 23; ++i) a.in[i] = (const float*)d_in[i];
    a.out = (float*)d_out; a.ws = (unsigned char*)d_ws;
    for (int li = 0; li < N_LAUNCHES; ++li) {
        a.ph_lo = (N_LAUNCHES == PER_PHASE) ? li : 0; a.ph_hi = (N_LAUNCHES == PER_PHASE) ? li + 1 : PER_PHASE; a.li = li;
        hipLaunchKernelGGL(skel_fwd, dim3(grid), dim3(NWAVES * 64), LDS_BYTES, stream, a);
        const hipError_t le = hipPeekAtLastError();
        if (le != hipSuccess) { fprintf(stderr, "kernel_launch: launch %d failed: %s\n", li, hipGetErrorName(le)); break; }
    }
}
```

```cpp
#include <hip/hip_runtime.h>
#include <cstdio>
#include <cstdint>
namespace pg8 {
#define PG8_LAS __attribute__((address_space(3)))
typedef unsigned short bf16_t;
typedef short bf16x8 __attribute__((ext_vector_type(8)));
typedef float f32x4 __attribute__((ext_vector_type(4)));
typedef unsigned u32x4 __attribute__((ext_vector_type(4)));
constexpr int BM = 256, BK = 64, HALF = 128, HTB = HALF * BK * 2  , STAGE_BYTES = 8 * HTB, NXCD = 8, WGM = 8;

__host__ __device__ __forceinline__ int lds_byte(int r, int c) { const int st = (r >> 4) * 2 + (c >> 5), rr = r & 15, cc = c & 31, ob = rr * 64 + cc * 2; return st * 1024 + (ob ^ (((ob >> 9) & 1) << 5)); }
__host__ __device__ __forceinline__ void stage_rc(int b, int& R, int& C) { const int st = b / 1024, sb = b % 1024, swz = sb ^ (((sb >> 9) & 1) << 5); R = (st >> 1) * 16 + swz / 64; C = (st & 1) * 32 + (swz % 64) / 2; }
__host__ __device__ __forceinline__ int perm32(int rho) { const int n = rho >> 4, i = rho & 15; return 8 * (i >> 2) + 4 * n + (i & 3); }

struct Unit { int pm, pn; };
struct Gemm { const bf16_t* A; const bf16_t* Bt; int M, N, K; };

struct StaticOrder {
    int nM, nN, nwg, G, c;
    __host__ __device__ void init(int M, int N, int G_, int c_) { nM = M / BM; nN = N / BM; nwg = nM * nN; G = G_; c = c_; }
    __host__ __device__ bool next(int i, Unit& u) const {
        const long L = (long)i * G + c; if (L >= nwg) return false;
        int wgid = (int)L; { const int q = nwg / NXCD, r = nwg % NXCD, xcd = wgid % NXCD, off = wgid / NXCD; wgid = (xcd < r ? xcd * (q + 1) : r * (q + 1) + (xcd - r) * q) + off; }
        const int nig = WGM * nN, gid = wgid / nig, fm = gid * WGM, gsz = (nM - fm) < WGM ? (nM - fm) : WGM;
        u.pm = fm + ((wgid % nig) % gsz); u.pn = (wgid % nig) / gsz; return true;
    }
    __device__ __forceinline__ void a_ready(const Unit&) const {}
    __device__ __forceinline__ void done(const Unit&) const {}
};

__device__ __forceinline__ unsigned cvt_pk_bf16(float lo, float hi) { unsigned r; asm volatile("v_cvt_pk_bf16_f32 %0, %1, %2" : "=v"(r) : "v"(lo), "v"(hi)); return r; }
typedef float f32x2 __attribute__((ext_vector_type(2)));
struct EpiU {
    static constexpr bool PERM = true, AFTER_DRAIN = false;
    bf16_t* Urk; bf16_t* Uvg; bf16_t* Uqg; bf16_t* Kimg; bf16_t* Vimg; float qscale; int seq;
    __device__ __forceinline__ void operator()(const f32x4 (&acc)[2][2][4][2], const Unit& u, int wr, int wc, int fr, int fq) const {
        const int row0 = u.pm * BM + wr * 64 + fr;
        const float sc = (u.pn == 8 || u.pn == 9) ? qscale : 1.f;
        const bool img = (u.pn >= 10 && u.pn <= 13);
        bf16_t* base = (u.pn < 4) ? (Urk + u.pn * BM) : (u.pn < 8 ? (Uvg + (u.pn - 4) * BM) : (u.pn < 10 ? (Uqg + (u.pn - 8) * BM) : (Uqg + 512 + (u.pn - 14) * BM)));
        const int col0 = wc * 32 + 8 * fq;
#pragma unroll
        for (int ai = 0; ai < 2; ++ai)
#pragma unroll
            for (int m = 0; m < 4; ++m) { const int r = row0 + ai * HALF + m * 16; bf16_t* rowp = base + (size_t)r * 1024 + col0;
                const int bb = r / seq, t = r % seq;
#pragma unroll
                for (int bj = 0; bj < 2; ++bj) { f32x4 v0 = acc[ai][bj][m][0] * sc, v1 = acc[ai][bj][m][1] * sc;
                    u32x4 w; w.x = cvt_pk_bf16(v0[0], v0[1]); w.y = cvt_pk_bf16(v0[2], v0[3]); w.z = cvt_pk_bf16(v1[0], v1[1]); w.w = cvt_pk_bf16(v1[2], v1[3]);
                    if (!img) *(u32x4*)(rowp + bj * HALF) = w;
                    else if (u.pn < 12) { const int hh = 4 * (u.pn - 10) + 2 * bj + (wc >> 1), dch = 4 * (wc & 1) + fq;
                        *(u32x4*)((char*)Kimg + ((size_t)((bb * 8 + hh) * (seq / 64) + (t >> 6)) * 8192 + dch * 1024 + (t & 63) * 16)) = w; }
                    else { const int h = 2 * (u.pn - 12) + bj;
                        *(u32x4*)((char*)Vimg + ((size_t)((bb * 4 + h) * (seq / 64) + (t >> 6)) * 16384 + (wc * 4 + ((t & 63) >> 4)) * 1024 + ((t & 15) * 4 + fq) * 16)) = w; } } }
    }
};

struct PanelStats {
    unsigned* xbuf;
    unsigned* cnt;
    unsigned* tmo;
    int ntn; float eps;
    bool rms;
    unsigned code;
    __device__ __forceinline__ bool run(const f32x4 (&v)[2][2][4][2], const Unit& u, int wr, int wc, int fr, int fq, PG8_LAS unsigned char* lds, int wid, int lane) const {
        typedef float f32x2v __attribute__((ext_vector_type(2)));
        PG8_LAS f32x2v* P = (PG8_LAS f32x2v*)lds;
        PG8_LAS f32x2v* S = (PG8_LAS f32x2v*)(lds + 8192);
        PG8_LAS unsigned* flag = (PG8_LAS unsigned*)(lds + 8192 + 2048);
#pragma unroll
        for (int ai = 0; ai < 2; ++ai)
#pragma unroll
            for (int m = 0; m < 4; ++m) {
                float s = 0.f;
#pragma unroll
                for (int bj = 0; bj < 2; ++bj)
#pragma unroll
                    for (int n = 0; n < 2; ++n) { const f32x4 x = v[ai][bj][m][n]; s += (x[0] + x[1]) + (x[2] + x[3]); }
                s += __shfl_xor(s, 16); s += __shfl_xor(s, 32);
                const float mw = s * (1.0f / 64.0f); float q = 0.f;
#pragma unroll
                for (int bj = 0; bj < 2; ++bj)
#pragma unroll
                    for (int n = 0; n < 2; ++n) { const f32x4 d = v[ai][bj][m][n] - mw; q += (d[0] * d[0] + d[1] * d[1]) + (d[2] * d[2] + d[3] * d[3]); }
                q += __shfl_xor(q, 16); q += __shfl_xor(q, 32);
                if (fq == 0) P[(ai * HALF + wr * 64 + m * 16 + fr) * 4 + wc] = (f32x2v){mw, q};
            }
        asm volatile("s_waitcnt lgkmcnt(0)" ::: "memory"); __builtin_amdgcn_s_barrier(); asm volatile("" ::: "memory");
#if defined(BROKEN_EXCHANGE_NO_WAIT)
#warning BROKEN CONTROL BUILD: the row-statistics exchange does not wait; results are wrong by design
        if (blockIdx.x >= 64) { const long long t0_ = clock64(); while (clock64() - t0_ < 60000) __builtin_amdgcn_s_sleep(8); }
#endif
        const int row = wid * 32 + (lane & 31);
        if (lane < 32) {
            const f32x2v a = P[row * 4 + 0], b = P[row * 4 + 1], c = P[row * 4 + 2], d = P[row * 4 + 3];
            const float mt = (a.x + b.x + c.x + d.x) * 0.25f;
            const float da = a.x - mt, db = b.x - mt, dc = c.x - mt, dd = d.x - mt;
            const float m2 = (a.y + b.y) + (c.y + d.y) + 64.0f * ((da * da + db * db) + (dc * dc + dd * dd));
            unsigned long long* slot = (unsigned long long*)xbuf + ((size_t)(u.pm * BM + row) * 4 + u.pn);
            __hip_atomic_store(slot, ((unsigned long long)__float_as_uint(m2) << 32) | __float_as_uint(mt), __ATOMIC_RELAXED, __HIP_MEMORY_SCOPE_AGENT);
        }
        asm volatile("s_waitcnt vmcnt(0)" ::: "memory");
        if (lane == 0) __hip_atomic_fetch_add(cnt + 64 * u.pm, 1u, __ATOMIC_RELAXED, __HIP_MEMORY_SCOPE_AGENT);
        if (wid == 0) {
            bool dead = false; const unsigned long long t0 = __builtin_amdgcn_s_memrealtime(); const unsigned want = 8u * (unsigned)ntn;
            for (;;) {
#if defined(BROKEN_EXCHANGE_NO_WAIT)
                break;
#endif
                if ((unsigned)__builtin_amdgcn_readfirstlane(__hip_atomic_load(cnt + 64 * u.pm, __ATOMIC_RELAXED, __HIP_MEMORY_SCOPE_AGENT)) >= want) break;
                if (__builtin_amdgcn_s_memrealtime() - t0 > 2000000ull) {
                    if (lane == 0) { unsigned expect = 0u; __hip_atomic_compare_exchange_strong(tmo + 1, &expect, code | (unsigned)(u.pm & 0xff), __ATOMIC_RELAXED, __ATOMIC_RELAXED, __HIP_MEMORY_SCOPE_AGENT);
                                     __hip_atomic_store(tmo, 1u, __ATOMIC_RELAXED, __HIP_MEMORY_SCOPE_AGENT); }
                    dead = true; break; }
                __builtin_amdgcn_s_sleep(2);
            }
            __builtin_amdgcn_fence(__ATOMIC_ACQUIRE, "agent");
            if (lane == 0) flag[0] = dead ? 1u : 0u;
        }
        asm volatile("s_waitcnt vmcnt(0) lgkmcnt(0)" ::: "memory"); __builtin_amdgcn_s_barrier(); asm volatile("" ::: "memory");
        const bool bad = flag[0] != 0u;
        if (lane < 32) {
            const unsigned long long* slot = (const unsigned long long*)xbuf + (size_t)(u.pm * BM + row) * 4; float mt[4], m2[4]; float ms = 0.f;
#pragma unroll
            for (int t = 0; t < 4; ++t) { if (t < ntn) { const unsigned long long w = __hip_atomic_load(slot + t, __ATOMIC_RELAXED, __HIP_MEMORY_SCOPE_AGENT); mt[t] = __uint_as_float((unsigned)w); m2[t] = __uint_as_float((unsigned)(w >> 32)); } else { mt[t] = 0.f; m2[t] = 0.f; } ms += mt[t]; }
            const float mean = ms / (float)ntn; float q = 0.f;
#pragma unroll
            for (int t = 0; t < 4; ++t) if (t < ntn) { const float dm = mt[t] - mean; q += m2[t] + 256.0f * dm * dm; }
            S[row] = (f32x2v){mean, 1.0f / sqrtf(q / (256.0f * (float)ntn) + (rms ? mean * mean : 0.f) + eps)};
        }
        asm volatile("s_waitcnt lgkmcnt(0)" ::: "memory"); __builtin_amdgcn_s_barrier(); asm volatile("" ::: "memory");
        return bad;
    }
};
struct EpiRmsRes {
    static constexpr bool PERM = false, AFTER_DRAIN = true;
    const float* base; float* out; int ldc; const float* gate; int gate_pitch; int rows_per_batch; const float* gpost; PanelStats st; unsigned poison;
    __device__ __forceinline__ void fused(f32x4 (&acc)[2][2][4][2], const Unit& u, int wr, int wc, int fr, int fq, PG8_LAS unsigned char* lds, int wid, int lane) const {
        typedef float f32x2v __attribute__((ext_vector_type(2)));
        const PG8_LAS f32x2v* S = (const PG8_LAS f32x2v*)(lds + 8192);
        const int col0 = u.pn * BM + wc * 32 + 4 * fq;
        const float* grow = gate + (size_t)((u.pm * BM) / rows_per_batch) * gate_pitch;
        f32x4 cf[2][2];
#pragma unroll
        for (int bj = 0; bj < 2; ++bj)
#pragma unroll
            for (int n = 0; n < 2; ++n) cf[bj][n] = *(const f32x4*)(grow + col0 + bj * HALF + n * 16) * *(const f32x4*)(gpost + col0 + bj * HALF + n * 16);
        f32x4 pre[2][2][2];
#pragma unroll
        for (int m = 0; m < 2; ++m) { const size_t off = (size_t)(u.pm * BM + wr * 64 + m * 16 + fr) * ldc + col0;
#pragma unroll
            for (int bj = 0; bj < 2; ++bj)
#pragma unroll
                for (int n = 0; n < 2; ++n) pre[m][bj][n] = *(const f32x4*)(base + off + bj * HALF + n * 16); }
        const bool bad = st.run(acc, u, wr, wc, fr, fq, lds, wid, lane) || poison != 0u;
        const float qnan = __builtin_nanf("");
#pragma unroll
        for (int ai = 0; ai < 2; ++ai)
#pragma unroll
            for (int m = 0; m < 4; ++m) { const int r = ai * HALF + wr * 64 + m * 16 + fr; const f32x2v sr = S[r]; const size_t off = (size_t)(u.pm * BM + r) * ldc + col0;
#pragma unroll
                for (int bj = 0; bj < 2; ++bj)
#pragma unroll
                    for (int n = 0; n < 2; ++n) { const f32x4 bs = (ai == 0 && m < 2) ? pre[m & 1][bj][n] : *(const f32x4*)(base + off + bj * HALF + n * 16); f32x4 o = bs + acc[ai][bj][m][n] * sr.y * cf[bj][n];
                        if (bad) o = (f32x4){qnan, qnan, qnan, qnan}; *(f32x4*)(out + off + bj * HALF + n * 16) = o; }
                if (m & 1) asm volatile("" ::: "memory"); }
    }
};

template <class Epi, class Sched, bool ALIGN_EPI = false, bool SP2 = false>
__device__ __forceinline__ void gemm_phase(PG8_LAS unsigned char* lds, const Gemm g, const Sched& S, const Epi& E) {
    const int tid = threadIdx.x, wid = __builtin_amdgcn_readfirstlane(tid >> 6), lane = tid & 63, wr = wid >> 2, wc = wid & 3, fr = lane & 15, fq = lane >> 4;
    const int K = g.K, nt = K / BK;
    unsigned voffA[2], voffB[2];
#pragma unroll
    for (int i = 0; i < 2; ++i) { int R, C; stage_rc(tid * 16 + i * 8192, R, C); const int Rb = Epi::PERM ? ((R & ~31) + perm32(R & 31)) : R;
        voffA[i] = (unsigned)(R * K + C) * 2u; voffB[i] = (unsigned)(Rb * K + C) * 2u; }
    const size_t kstep = (size_t)(BK * 2);
    const size_t hstep = (size_t)HALF * K * 2;
    const size_t tstep = 2 * hstep;
    const unsigned ldsw = (unsigned)wid * 1024u;
    const int aoff = lds_byte(wr * 64 + fr, fq * 8), boff = lds_byte(wc * 32 + fr, fq * 8);
#define PG8_SA(b, h) (((b) * 2 + (h)) * HTB)
#define PG8_SB(b, h) ((4 + (b) * 2 + (h)) * HTB)
#define PG8_STAGE(bufoff, gbase, voff) do { _Pragma("unroll") for (int _i = 0; _i < 2; ++_i) \
        __builtin_amdgcn_global_load_lds((const unsigned*)((const char*)(gbase) + (voff)[_i]), (PG8_LAS unsigned*)(lds + (bufoff) + ldsw + _i * 8192), 16, 0, 0); } while (0)
#define PG8_LDA(dst, b, h) do { _Pragma("unroll") for (int m = 0; m < 4; ++m) _Pragma("unroll") for (int k = 0; k < 2; ++k) dst[m][k] = *(const PG8_LAS bf16x8*)(lds + PG8_SA(b, h) + aoff + m * 2048 + k * 1024); } while (0)
#define PG8_LDB(dst, b, h) do { _Pragma("unroll") for (int n = 0; n < 2; ++n) _Pragma("unroll") for (int k = 0; k < 2; ++k) dst[n][k] = *(const PG8_LAS bf16x8*)(lds + PG8_SB(b, h) + boff + n * 2048 + k * 1024); } while (0)
#define PG8_MMA(ai, bj, At, Bt) do { __builtin_amdgcn_s_setprio(1); _Pragma("unroll") for (int m = 0; m < 4; ++m) _Pragma("unroll") for (int n = 0; n < 2; ++n) _Pragma("unroll") for (int k = 0; k < 2; ++k) \
        acc[ai][bj][m][n] = __builtin_amdgcn_mfma_f32_16x16x32_bf16(Bt[n][k], At[m][k], acc[ai][bj][m][n], 0, 0, 0); __builtin_amdgcn_s_setprio(0); } while (0)
#define PG8_WAIT_V(n) asm volatile("s_waitcnt vmcnt(" #n ")" ::: "memory")
#define PG8_WAIT_L(n) asm volatile("s_waitcnt lgkmcnt(" #n ")" ::: "memory")
#define PG8_BAR __builtin_amdgcn_s_barrier()
#define PG8_SCHED __builtin_amdgcn_sched_barrier(0)
    Unit cur, nxt; int ui = 0;
    if (!S.next(0, cur)) return;
    f32x4 acc[2][2][4][2];
#pragma unroll
    for (int a = 0; a < 2; ++a)
#pragma unroll
        for (int b = 0; b < 2; ++b)
#pragma unroll
            for (int m = 0; m < 4; ++m)
#pragma unroll
                for (int n = 0; n < 2; ++n) acc[a][b][m][n] = (f32x4){0.f, 0.f, 0.f, 0.f};
    bf16x8 At[4][2], B0[2][2], B1[2][2];
    const char* cA = (const char*)g.A + (size_t)cur.pm * tstep; const char* cB = (const char*)g.Bt + (size_t)cur.pn * tstep;
    S.a_ready(cur);
    if constexpr (SP2) {
        PG8_STAGE(PG8_SB(0, 0), cB, voffB); PG8_STAGE(PG8_SB(0, 1), cB + hstep, voffB); PG8_STAGE(PG8_SA(0, 0), cA, voffA); PG8_STAGE(PG8_SA(0, 1), cA + hstep, voffA);
        if (wr == 1) PG8_BAR;
        PG8_WAIT_V(2); PG8_BAR;
        PG8_STAGE(PG8_SB(1, 0), cB + kstep, voffB); PG8_STAGE(PG8_SA(1, 0), cA + kstep, voffA); PG8_STAGE(PG8_SB(1, 1), cB + hstep + kstep, voffB);
        PG8_WAIT_V(6); PG8_BAR;
    } else {
        PG8_STAGE(PG8_SB(0, 0), cB, voffB); PG8_STAGE(PG8_SA(0, 0), cA, voffA); PG8_STAGE(PG8_SB(0, 1), cB + hstep, voffB); PG8_STAGE(PG8_SA(0, 1), cA + hstep, voffA);
        if (wr == 1) PG8_BAR;
        PG8_WAIT_V(4); PG8_BAR;
        PG8_STAGE(PG8_SB(1, 0), cB + kstep, voffB); PG8_STAGE(PG8_SA(1, 0), cA + kstep, voffA); PG8_STAGE(PG8_SB(1, 1), cB + hstep + kstep, voffB);
        PG8_WAIT_V(6); PG8_BAR;
    }
    for (;;) {
        const bool has_next = S.next(ui + 1, nxt);
        const char* nA = has_next ? (const char*)g.A + (size_t)nxt.pm * tstep : cA; const char* nB = has_next ? (const char*)g.Bt + (size_t)nxt.pn * tstep : cB;
        for (int t = 0; t < nt; t += 2) {
            const bool last = (t == nt - 2);
            const char* a1 = cA + (size_t)(t + 1) * kstep;
            const char* a2 = last ? nA : cA + (size_t)(t + 2) * kstep; const char* b2 = last ? nB : cB + (size_t)(t + 2) * kstep;
            const char* a3 = a2 + kstep; const char* b3 = b2 + kstep;
            if (last && has_next) S.a_ready(nxt);
            if constexpr (SP2) {
            PG8_LDB(B0, 0, 0); PG8_LDB(B1, 0, 1); PG8_SCHED; PG8_LDA(At, 0, 0); PG8_STAGE(PG8_SA(1, 1), a1 + hstep, voffA);
            PG8_WAIT_V(8); PG8_WAIT_L(0); PG8_BAR; PG8_MMA(0, 0, At, B0); PG8_MMA(0, 1, At, B1); PG8_BAR; PG8_SCHED;
            PG8_LDA(At, 0, 1); PG8_STAGE(PG8_SB(0, 0), b2, voffB); PG8_STAGE(PG8_SB(0, 1), b2 + hstep, voffB); PG8_STAGE(PG8_SA(0, 0), a2, voffA);
            PG8_WAIT_V(8); PG8_WAIT_L(0); PG8_BAR; PG8_MMA(1, 0, At, B0); PG8_MMA(1, 1, At, B1); PG8_BAR; PG8_SCHED;
            PG8_LDB(B0, 1, 0); PG8_LDB(B1, 1, 1); PG8_SCHED; PG8_LDA(At, 1, 0); PG8_STAGE(PG8_SA(0, 1), a2 + hstep, voffA);
            PG8_WAIT_V(8); PG8_WAIT_L(0); PG8_BAR; PG8_MMA(0, 0, At, B0); PG8_MMA(0, 1, At, B1); PG8_BAR; PG8_SCHED;
            PG8_LDA(At, 1, 1); PG8_STAGE(PG8_SB(1, 0), b3, voffB); PG8_STAGE(PG8_SB(1, 1), b3 + hstep, voffB); PG8_STAGE(PG8_SA(1, 0), a3, voffA);
            PG8_WAIT_V(8); PG8_WAIT_L(0); PG8_BAR; PG8_MMA(1, 0, At, B0); PG8_MMA(1, 1, At, B1); PG8_BAR; PG8_SCHED;
            } else {
            PG8_LDB(B0, 0, 0); PG8_SCHED; PG8_LDA(At, 0, 0); PG8_STAGE(PG8_SA(1, 1), a1 + hstep, voffA);
            PG8_WAIT_L(8); PG8_BAR; PG8_WAIT_L(0); PG8_MMA(0, 0, At, B0); PG8_BAR; PG8_SCHED;
            PG8_LDB(B1, 0, 1); PG8_STAGE(PG8_SB(0, 0), b2, voffB);
            PG8_BAR; PG8_WAIT_L(0); PG8_MMA(0, 1, At, B1); PG8_BAR;
            PG8_LDA(At, 0, 1); PG8_STAGE(PG8_SA(0, 0), a2, voffA);
            PG8_BAR; PG8_WAIT_L(0); PG8_MMA(1, 0, At, B0); PG8_BAR; PG8_SCHED;
            PG8_STAGE(PG8_SB(0, 1), b2 + hstep, voffB);
            PG8_WAIT_V(6); PG8_BAR; PG8_MMA(1, 1, At, B1); PG8_BAR;
            PG8_LDB(B0, 1, 0); PG8_SCHED; PG8_LDA(At, 1, 0); PG8_STAGE(PG8_SA(0, 1), a2 + hstep, voffA);
            PG8_WAIT_L(8); PG8_BAR; PG8_WAIT_L(0); PG8_MMA(0, 0, At, B0); PG8_BAR; PG8_SCHED;
            PG8_LDB(B1, 1, 1); PG8_STAGE(PG8_SB(1, 0), b3, voffB);
            PG8_BAR; PG8_WAIT_L(0); PG8_MMA(0, 1, At, B1); PG8_BAR;
            PG8_LDA(At, 1, 1); PG8_STAGE(PG8_SA(1, 0), a3, voffA);
            PG8_BAR; PG8_WAIT_L(0); PG8_MMA(1, 0, At, B0); PG8_BAR; PG8_SCHED;
            PG8_STAGE(PG8_SB(1, 1), b3 + hstep, voffB);
            PG8_WAIT_V(6); PG8_BAR; PG8_MMA(1, 1, At, B1); PG8_BAR;
            }
        }
        if constexpr (ALIGN_EPI) { if (wr == 0) PG8_BAR; }
        if constexpr (!Epi::AFTER_DRAIN) { E(acc, cur, wr, wc, fr, fq); S.done(cur); }
        if (!has_next) break;
#pragma unroll
        for (int a = 0; a < 2; ++a)
#pragma unroll
            for (int b = 0; b < 2; ++b)
#pragma unroll
                for (int m = 0; m < 4; ++m)
#pragma unroll
                    for (int n = 0; n < 2; ++n) acc[a][b][m][n] = (f32x4){0.f, 0.f, 0.f, 0.f};
        cur = nxt; cA = nA; cB = nB; ++ui;
        if constexpr (ALIGN_EPI) { if (wr == 1) PG8_BAR; }
    }
    PG8_WAIT_V(0);
    if constexpr (!ALIGN_EPI) { if (wr == 0) PG8_BAR; }
    PG8_BAR;
    if constexpr (Epi::AFTER_DRAIN) { E.fused(acc, cur, wr, wc, fr, fq, lds, wid, lane); S.done(cur); }
#undef PG8_SA
#undef PG8_SB
#undef PG8_STAGE
#undef PG8_LDA
#undef PG8_LDB
#undef PG8_MMA
#undef PG8_WAIT_V
#undef PG8_WAIT_L
#undef PG8_BAR
#undef PG8_SCHED
}
}

#ifndef PG8_SP2
#define PG8_SP2 true
#endif
#ifndef PG8_ALIGN
#define PG8_ALIGN true
#endif
#include <hip/hip_bf16.h>
#include <cmath>
namespace attn_body {
using bf16=__hip_bfloat16;
using bf16x8=__attribute__((ext_vector_type(8)))short;
using s16x4=__attribute__((ext_vector_type(4)))short;
using f32x16=__attribute__((ext_vector_type(16)))float;
using u32x4=__attribute__((ext_vector_type(4)))unsigned;
constexpr int SEQ=4096,D=64,PQ=1024,PO=1024;
constexpr int KT=4096,VT=8192;
constexpr int NW=8,QBLK=32,QB=QBLK*NW,KVBLK=64,NQB=SEQ/QB;
constexpr int ATTN_UNIT_ROWS=QB;
__device__ __forceinline__ int crow(int r,int hi){return (r&3)+8*(r>>2)+4*hi;}
#define SBAR() __builtin_amdgcn_sched_barrier(0)
__device__ __forceinline__ void cmask(f32x16&p0,f32x16&p1,int jb,int qrel,int hi){
  const float NEG=-INFINITY;
  if(jb>(qrel>>6)){
  #pragma unroll
  for(int r=0;r<16;++r){p0[r]=NEG;p1[r]=NEG;}}
}

constexpr int NSLOT=3, SLOTB=8192;
constexpr int LDS_K=0, LDS_V=NSLOT*SLOTB, LDS_WS=LDS_V+NSLOT*2*SLOTB, LDS_OST=LDS_WS+NW*64*4, LDS_BYTES=LDS_OST+NW*4096;
constexpr float C2=0.125f*1.4426950408889634f;
__device__ __forceinline__ void glds16(const void*gsrc,unsigned lds_dst){unsigned keep;
  asm volatile("s_mov_b32 %0, m0\n\ts_mov_b32 m0, %2\n\ts_nop 0\n\tglobal_load_lds_dwordx4 %1, off\n\ts_mov_b32 m0, %0":"=&s"(keep):"v"(gsrc),"s"(lds_dst):"memory");}
__device__ __forceinline__ void glds16s(const void*sbase,unsigned voff,unsigned lds_dst){unsigned keep;
  asm volatile("s_mov_b32 %0, m0\n\ts_mov_b32 m0, %3\n\ts_nop 0\n\tglobal_load_lds_dwordx4 %1, %2\n\ts_mov_b32 m0, %0":"=&s"(keep):"v"(voff),"s"(sbase),"s"(lds_dst):"memory");}
__device__ __forceinline__ float max3f(float a,float b,float c){float r;asm("v_max3_f32 %0, %1, %2, %3":"=v"(r):"v"(a),"v"(b),"v"(c));return r;}
__device__ __forceinline__ float max2f(float a,float b){float r;asm("v_max_f32_e32 %0, %1, %2":"=v"(r):"v"(a),"v"(b));return r;}
__device__ __forceinline__ float fadd_s(float a,float b){float r;asm("v_add_f32_e32 %0, %1, %2":"=v"(r):"v"(a),"v"(b));return r;}
__device__ __forceinline__ float fsub_s(float a,float b){float r;asm("v_sub_f32_e32 %0, %1, %2":"=v"(r):"v"(a),"v"(b));return r;}
typedef float f32x2_t __attribute__((ext_vector_type(2))); typedef __bf16 bf16x2_t __attribute__((ext_vector_type(2)));
__device__ __forceinline__ unsigned cvtpk_s(float lo,float hi){f32x2_t v={lo,hi};bf16x2_t b=__builtin_convertvector(v,bf16x2_t);return __builtin_bit_cast(unsigned,b);}
#define WAIT_BAR(N) asm volatile("s_waitcnt vmcnt(" #N ") lgkmcnt(0)\n\ts_barrier":::"memory")

__device__ __forceinline__ void qkt(f32x16&p0,f32x16&p1,const char*Kslot,const bf16x8*qr,const f32x16&negm,int r32,int hi){
  const char*kb=Kslot+hi*1024+r32*16;
  #pragma unroll
  for(int d0=0;d0<4;++d0){
    const bf16x8 b0=*reinterpret_cast<const bf16x8*>(kb+d0*2048);
    const bf16x8 b1=*reinterpret_cast<const bf16x8*>(kb+d0*2048+512);
    if(d0==0){p0=__builtin_amdgcn_mfma_f32_32x32x16_bf16(b0,qr[0],negm,0,0,0);p1=__builtin_amdgcn_mfma_f32_32x32x16_bf16(b1,qr[0],negm,0,0,0);}
    else{p0=__builtin_amdgcn_mfma_f32_32x32x16_bf16(b0,qr[d0],p0,0,0,0);p1=__builtin_amdgcn_mfma_f32_32x32x16_bf16(b1,qr[d0],p1,0,0,0);}}
}
typedef __attribute__((address_space(3))) const char* lds_cptr;
typedef short v4i16_t __attribute__((ext_vector_type(4)));
__device__ __forceinline__ void kload8(bf16x8*kf,lds_cptr kp){
  kf[0]=*(const __attribute__((address_space(3))) bf16x8*)(kp);      kf[1]=*(const __attribute__((address_space(3))) bf16x8*)(kp+512);
  kf[2]=*(const __attribute__((address_space(3))) bf16x8*)(kp+2048); kf[3]=*(const __attribute__((address_space(3))) bf16x8*)(kp+2560);
  kf[4]=*(const __attribute__((address_space(3))) bf16x8*)(kp+4096); kf[5]=*(const __attribute__((address_space(3))) bf16x8*)(kp+4608);
  kf[6]=*(const __attribute__((address_space(3))) bf16x8*)(kp+6144); kf[7]=*(const __attribute__((address_space(3))) bf16x8*)(kp+6656);
}
__device__ __forceinline__ void kload2(bf16x8*kf,lds_cptr kp,int j){ kf[2*j]=*(const __attribute__((address_space(3))) bf16x8*)(kp+j*2048); kf[2*j+1]=*(const __attribute__((address_space(3))) bf16x8*)(kp+j*2048+512); }
__device__ __forceinline__ s16x4 vtr(lds_cptr p){ return __builtin_bit_cast(s16x4,__builtin_amdgcn_ds_read_tr16_b64_v4i16((__attribute__((address_space(3))) v4i16_t*)p)); }
__device__ __forceinline__ float rowmax(const f32x16&p0,const f32x16&p1){
  float a=max3f(p0[0],p0[1],p1[0]),b=max3f(p0[2],p0[3],p1[1]);a=max3f(a,p1[2],p1[3]);
  #pragma unroll
  for(int r=4;r<16;r+=4){a=max3f(a,p0[r],p0[r+1]);b=max3f(b,p0[r+2],p0[r+3]);a=max3f(a,p1[r],p1[r+1]);b=max3f(b,p1[r+2],p1[r+3]);}
  const float m=max2f(a,b);
  auto rr=__builtin_amdgcn_permlane32_swap(__float_as_uint(m),__float_as_uint(m),false,false);
  return max2f(__uint_as_float(rr[0]),__uint_as_float(rr[1]));
}
__device__ __forceinline__ void pv(f32x16*o,int vb,bf16x8 pa0,bf16x8 pa1,bf16x8 pa2,bf16x8 pa3){
  #pragma unroll
  for(int d0=0;d0<4;++d0){s16x4 lo[4],hi[4];
    #pragma unroll
    for(int ks=0;ks<4;++ks){
      asm volatile("ds_read_b64_tr_b16 %0,%1 offset:%c2":"=&v"(lo[ks]):"v"(vb),"i"(d0*4096+ks*1024):"memory");
      asm volatile("ds_read_b64_tr_b16 %0,%1 offset:%c2":"=&v"(hi[ks]):"v"(vb),"i"(d0*4096+ks*1024+512):"memory");}
    asm volatile("s_waitcnt lgkmcnt(0)":::"memory");SBAR();
    #define PK(k) (bf16x8){lo[k][0],lo[k][1],lo[k][2],lo[k][3],hi[k][0],hi[k][1],hi[k][2],hi[k][3]}
    o[d0]=__builtin_amdgcn_mfma_f32_32x32x16_bf16(pa0,PK(0),o[d0],0,0,0);
    o[d0]=__builtin_amdgcn_mfma_f32_32x32x16_bf16(pa1,PK(1),o[d0],0,0,0);
    o[d0]=__builtin_amdgcn_mfma_f32_32x32x16_bf16(pa2,PK(2),o[d0],0,0,0);
    o[d0]=__builtin_amdgcn_mfma_f32_32x32x16_bf16(pa3,PK(3),o[d0],0,0,0);
    #undef PK
  }
}

#ifndef ATTN_STORE16
#define ATTN_STORE16(p,v) (*(u32x4*)(p)=(v))
#endif
template<int THRL> __device__ __forceinline__ void attn_unit(int qb,const bf16*Q,const bf16*__restrict__ K,const bf16*__restrict__ V,bf16*O,char*shm){
  const int tid=threadIdx.x,lane=tid&63,r32=lane&31,hi=lane>>5; const int wid=__builtin_amdgcn_readfirstlane(tid>>6);
  const int q0=qb*QB;
  const bf16*Qw=Q+(long)(q0+wid*QBLK)*PQ;
  const bf16*Kh=K,*Vh=V;
  const unsigned lds0=(unsigned)(uintptr_t)shm;
  float*wsf=(float*)(shm+LDS_WS)+wid*64;
  const unsigned koff=(unsigned)(wid*1024+lane*16);
  const unsigned voffv=koff;
  const unsigned kdst=lds0+LDS_K+wid*1024, vdst=lds0+LDS_V+wid*1024;
  #define DMA_K(t,slot) glds16s(Kh+(long)(t)*KT,koff,(unsigned)__builtin_amdgcn_readfirstlane(kdst+(slot)))
  #define DMA_V(t,slot) do{ glds16s(Vh+(long)(t)*VT,voffv,(unsigned)__builtin_amdgcn_readfirstlane(vdst+2*(slot))); glds16s(Vh+4096+(long)(t)*VT,voffv,(unsigned)__builtin_amdgcn_readfirstlane(vdst+8192+2*(slot))); }while(0)
  const int vb0=(int)(lds0+LDS_V)+((lane>>4)&1)*32+(lane&3)*8+(4*hi+((lane&15)>>2))*64;
  const char*Kbase=shm+LDS_K; bf16x8 kf[8];
  const lds_cptr shm3=(lds_cptr)shm; const lds_cptr kp0=shm3+LDS_K+hi*1024+r32*16; const lds_cptr vp0=shm3+LDS_V+((lane>>4)&1)*32+(lane&3)*8+(4*hi+((lane&15)>>2))*64;
  const int NT=(q0+QB)/KVBLK;
  DMA_K(0,0);DMA_V(0,0);DMA_K(1,SLOTB);
  bf16x8 qr[4];
  #pragma unroll
  for(int d0=0;d0<4;++d0)qr[d0]=*reinterpret_cast<const bf16x8*>(&Qw[(long)r32*PQ+d0*16+hi*8]);
  float mhat=0.f,l_reg=0.f;f32x16 o[4];o[0]=f32x16{};o[1]=f32x16{};o[2]=f32x16{};o[3]=f32x16{};
  const int qrel=wid*QBLK+r32;
  #define CMASK(P0,P1,t) do{int jb_=(t)-(NT-4); if(jb_>=0)cmask(P0,P1,jb_,qrel,hi);}while(0)
  bool resc=false;
  #define START(P0,P1) do{ const float rm=rowmax(P0,P1); resc=false; \
    { const float dl=rm; mhat=fadd_s(mhat,dl); \
      _Pragma("unroll") for(int r=0;r<16;++r){P0[r]=fsub_s(P0[r],dl);P1[r]=fsub_s(P1[r],dl);} } \
    _Pragma("unroll") for(int r=0;r<16;++r)P0[r]=__builtin_amdgcn_exp2f(P0[r]); }while(0)
  #define RESC() do{ if(resc){ asm volatile("s_waitcnt lgkmcnt(0)":::"memory"); \
      _Pragma("unroll") for(int d_=0;d_<4;++d_) _Pragma("unroll") for(int r=0;r<16;++r)o[d_][r]*=wsf[crow(r,hi)]; } }while(0)
  f32x16 pA0,pA1,pB0,pB1;
  int sl_prev=0,sl_cur=0,sl_next=SLOTB;
  #define ROT() do{sl_prev=sl_cur;sl_cur=sl_next;sl_next=(sl_next==(NSLOT-1)*SLOTB)?0:sl_next+SLOTB;}while(0)
  DMA_K(2,2*SLOTB);
  WAIT_BAR(4);
  { const f32x16 zero16=f32x16{}; qkt(pA0,pA1,Kbase,qr,zero16,r32,hi); }asm volatile("s_nop 15\n\ts_nop 7":"+v"(pA0),"+v"(pA1));CMASK(pA0,pA1,0);
  START(pA0,pA1);
  _Pragma("unroll") for(int r=0;r<16;++r)pA1[r]=__builtin_amdgcn_exp2f(pA1[r]);
  WAIT_BAR(0);
  DMA_K(3,0);DMA_V(1,SLOTB);
  ROT();
  kload8(kf,kp0+sl_cur);
  WAIT_BAR(3);
  s16x4 vlo[8],vhi[8]; u32x4 pw0,pw1,pw2,pw3;
  #define PKW(P,B) cvtpk_s(P[B],P[B+1])
  #define PAF(k) __builtin_bit_cast(bf16x8,pw##k)
  #define VFR(i) (bf16x8){vlo[i][0],vlo[i][1],vlo[i][2],vlo[i][3],vhi[i][0],vhi[i][1],vhi[i][2],vhi[i][3]}
  #define PIN(x) asm volatile("":"+v"(x))
  #define MX3(a,b,c) __builtin_fmaxf(__builtin_fmaxf((a),(b)),(c))
  #define GAPA(MF,A0,A1,A2,A3,W0,W1,PW) do{ MF; sacc+=A0; sacc+=A1; sacc+=A2; sacc+=A3; PIN(sacc); W0; W1; PIN(PW); SBAR(); }while(0)
  #define EX(v) __builtin_amdgcn_exp2f(v)
  #define GAPM(MF,X,B) do{ MF; X[B]-=mhat; X[B+1]-=mhat; X[B+2]-=mhat; X[B+3]-=mhat; PIN(X); }while(0)
  #define GAPB(MF,X,B) do{ MF; X[B]=EX(X[B]); X[B+1]=EX(X[B+1]); X[B+2]=EX(X[B+2]); X[B+3]=EX(X[B+3]); PIN(X); SBAR(); }while(0)
  #define VRD(i) do{ vlo[i]=vtr(vp_+(((i)>>2)*4096+((i)&3)*1024)); vhi[i]=vtr(vp_+(((i)>>2)*4096+((i)&3)*1024+512)); }while(0)
  #define VRD2(i) do{ vlo[i]=vtr(vp_+((2+((i)>>2))*4096+((i)&3)*1024)); vhi[i]=vtr(vp_+((2+((i)>>2))*4096+((i)&3)*1024+512)); }while(0)
  #define KRD(G,j) do{ if(G){ kload2(kf,kp0+sl_next,j); SBAR(); } }while(0)
  #define STEP(C0,C1,P0,P1,t,GK,GV,GL) do{ SBAR(); \
    const lds_cptr vp_=vp0+2*sl_prev; \
    VRD(0); SBAR(); float sacc=(P0[0]+P0[1]); \
    GAPA(C0=__builtin_amdgcn_mfma_f32_32x32x16_bf16(kf[0],qr[0],f32x16{},0,0,0), P0[2],P0[3],P0[4],P0[5],     pw0[0]=PKW(P0,0), pw0[1]=PKW(P0,2), pw0); \
    VRD(4); SBAR(); GAPA(C1=__builtin_amdgcn_mfma_f32_32x32x16_bf16(kf[1],qr[0],f32x16{},0,0,0), P0[6],P0[7],P0[8],P0[9],     pw0[2]=PKW(P0,4), pw0[3]=PKW(P0,6), pw0); \
    VRD(1); SBAR(); GAPA(C0=__builtin_amdgcn_mfma_f32_32x32x16_bf16(kf[2],qr[1],C0,0,0,0),   P0[10],P0[11],P0[12],P0[13], pw1[0]=PKW(P0,8), pw1[1]=PKW(P0,10), pw1); \
    VRD(5); SBAR(); GAPA(C1=__builtin_amdgcn_mfma_f32_32x32x16_bf16(kf[3],qr[1],C1,0,0,0),   P0[14],P0[15],P1[0],P1[1],   pw1[2]=PKW(P0,12),pw1[3]=PKW(P0,14), pw1); \
    VRD(2); SBAR(); GAPA(C0=__builtin_amdgcn_mfma_f32_32x32x16_bf16(kf[4],qr[2],C0,0,0,0),   P1[2],P1[3],P1[4],P1[5],     pw2[0]=PKW(P1,0), pw2[1]=PKW(P1,2), pw2); \
    VRD(6); SBAR(); GAPA(C1=__builtin_amdgcn_mfma_f32_32x32x16_bf16(kf[5],qr[2],C1,0,0,0),   P1[6],P1[7],P1[8],P1[9],     pw2[2]=PKW(P1,4), pw2[3]=PKW(P1,6), pw2); \
    VRD(3); SBAR(); GAPA(C0=__builtin_amdgcn_mfma_f32_32x32x16_bf16(kf[6],qr[3],C0,0,0,0),   P1[10],P1[11],P1[12],P1[13], pw3[0]=PKW(P1,8), pw3[1]=PKW(P1,10), pw3); \
    VRD(7); SBAR(); GAPA(C1=__builtin_amdgcn_mfma_f32_32x32x16_bf16(kf[7],qr[3],C1,0,0,0),   P1[14],P1[15],0.f,0.f,       pw3[2]=PKW(P1,12),pw3[3]=PKW(P1,14), pw3); \
    l_reg+=sacc; \
    if(GK){DMA_K((t)+3,sl_cur);} if(GV){DMA_V((t)+1,sl_next);} \
    GAPM(o[0]=__builtin_amdgcn_mfma_f32_32x32x16_bf16(PAF(0),VFR(0),o[0],0,0,0), C0,0);  VRD2(0); SBAR(); \
    GAPM(o[1]=__builtin_amdgcn_mfma_f32_32x32x16_bf16(PAF(0),VFR(4),o[1],0,0,0), C0,4);  VRD2(4); SBAR(); \
    GAPM(o[0]=__builtin_amdgcn_mfma_f32_32x32x16_bf16(PAF(1),VFR(1),o[0],0,0,0), C0,8);  VRD2(1); SBAR(); \
    GAPM(o[1]=__builtin_amdgcn_mfma_f32_32x32x16_bf16(PAF(1),VFR(5),o[1],0,0,0), C0,12); VRD2(5); SBAR(); \
    GAPM(o[0]=__builtin_amdgcn_mfma_f32_32x32x16_bf16(PAF(2),VFR(2),o[0],0,0,0), C1,0);  VRD2(2); SBAR(); \
    GAPM(o[1]=__builtin_amdgcn_mfma_f32_32x32x16_bf16(PAF(2),VFR(6),o[1],0,0,0), C1,4);  VRD2(6); SBAR(); \
    GAPM(o[0]=__builtin_amdgcn_mfma_f32_32x32x16_bf16(PAF(3),VFR(3),o[0],0,0,0), C1,8);  VRD2(3); SBAR(); \
    GAPM(o[1]=__builtin_amdgcn_mfma_f32_32x32x16_bf16(PAF(3),VFR(7),o[1],0,0,0), C1,12); VRD2(7); SBAR(); \
    CMASK(C0,C1,t); \
    { float a=MX3(C0[0],C0[1],C1[0]),b=MX3(C0[2],C0[3],C1[1]); a=MX3(a,C1[2],C1[3]); \
      _Pragma("unroll") for(int r=4;r<16;r+=4){a=MX3(a,C0[r],C0[r+1]);b=MX3(b,C0[r+2],C0[r+3]);a=MX3(a,C1[r],C1[r+1]);b=MX3(b,C1[r+2],C1[r+3]);} \
      float rm=__builtin_fmaxf(a,b); { auto rr=__builtin_amdgcn_permlane32_swap(__float_as_uint(rm),__float_as_uint(rm),false,false); rm=__builtin_fmaxf(__uint_as_float(rr[0]),__uint_as_float(rr[1])); } \
      resc=false; \
      if(__builtin_expect(__any(rm>(float)THRL),0)){ const float dl=__builtin_fmaxf(rm,0.f); mhat+=dl; \
        _Pragma("unroll") for(int r=0;r<16;++r){C0[r]-=dl;C1[r]-=dl;} \
        const float f=__builtin_amdgcn_exp2f(-dl); l_reg*=f; if(hi==0)wsf[r32]=f; resc=true; } } \
    SBAR(); \
    GAPB(o[2]=__builtin_amdgcn_mfma_f32_32x32x16_bf16(PAF(0),VFR(0),o[2],0,0,0), C0,0); \
    GAPB(o[3]=__builtin_amdgcn_mfma_f32_32x32x16_bf16(PAF(0),VFR(4),o[3],0,0,0), C0,4); \
    KRD(GL,0); GAPB(o[2]=__builtin_amdgcn_mfma_f32_32x32x16_bf16(PAF(1),VFR(1),o[2],0,0,0), C0,8); \
    KRD(GL,1); GAPB(o[3]=__builtin_amdgcn_mfma_f32_32x32x16_bf16(PAF(1),VFR(5),o[3],0,0,0), C0,12); \
    KRD(GL,2); GAPB(o[2]=__builtin_amdgcn_mfma_f32_32x32x16_bf16(PAF(2),VFR(2),o[2],0,0,0), C1,0); \
    KRD(GL,3); GAPB(o[3]=__builtin_amdgcn_mfma_f32_32x32x16_bf16(PAF(2),VFR(6),o[3],0,0,0), C1,4); \
    GAPB(o[2]=__builtin_amdgcn_mfma_f32_32x32x16_bf16(PAF(3),VFR(3),o[2],0,0,0), C1,8); \
    GAPB(o[3]=__builtin_amdgcn_mfma_f32_32x32x16_bf16(PAF(3),VFR(7),o[3],0,0,0), C1,12); \
    }while(0)
  int t=1;
  #undef CMASK
  #define CMASK(P0,P1,t) do{}while(0)
  for(;t+5<NT;t+=2){
    STEP(pB0,pB1,pA0,pA1,t,true,true,true);     WAIT_BAR(3); RESC(); ROT();
    STEP(pA0,pA1,pB0,pB1,t+1,true,true,true);   WAIT_BAR(3); RESC(); ROT();
  }
  #undef CMASK
  #define CMASK(P0,P1,t) do{int jb_=(t)-(NT-4); if(jb_>=0)cmask(P0,P1,jb_,qrel,hi);}while(0)
  #define ENDW(tt) do{ if((tt)+3<NT){WAIT_BAR(3);} else if((tt)+2<NT){WAIT_BAR(2);} else {WAIT_BAR(0);} }while(0)
  for(;t+1<NT;t+=2){
    STEP(pB0,pB1,pA0,pA1,t,(t+3<NT),(t+1<NT),(t+1<NT));       ENDW(t);   RESC(); ROT();
    STEP(pA0,pA1,pB0,pB1,t+1,(t+4<NT),(t+2<NT),(t+2<NT));     ENDW(t+1); RESC(); ROT();
  }
  STEP(pB0,pB1,pA0,pA1,NT-1,false,false,false); RESC();
  { float sacc=pB0[0]+pB0[1]; _Pragma("unroll") for(int r=2;r<16;++r)sacc+=pB0[r]; _Pragma("unroll") for(int r=0;r<16;++r)sacc+=pB1[r]; l_reg+=sacc;
    pw0=(u32x4){PKW(pB0,0),PKW(pB0,2),PKW(pB0,4),PKW(pB0,6)};pw1=(u32x4){PKW(pB0,8),PKW(pB0,10),PKW(pB0,12),PKW(pB0,14)};pw2=(u32x4){PKW(pB1,0),PKW(pB1,2),PKW(pB1,4),PKW(pB1,6)};pw3=(u32x4){PKW(pB1,8),PKW(pB1,10),PKW(pB1,12),PKW(pB1,14)};
    SBAR(); pv(o,vb0+2*sl_cur,PAF(0),PAF(1),PAF(2),PAF(3)); }
  #undef PKW
  #undef PAF
  #undef VFR
  #undef PIN
  #undef MX3
  #undef GAPA
  #undef GAPB
  #undef GAPM
  #undef EX
  #undef VRD
  #undef VRD2
  #undef KRD
  #undef STEP
  #undef ENDW
  {auto rr=__builtin_amdgcn_permlane32_swap(__float_as_uint(l_reg),__float_as_uint(l_reg),false,false);l_reg=__uint_as_float(rr[0])+__uint_as_float(rr[1]);}
  if(hi==0)wsf[32+r32]=l_reg;asm volatile("s_waitcnt lgkmcnt(0)":::"memory");
  float rli[16];
  #pragma unroll
  for(int r=0;r<16;++r)rli[r]=__builtin_amdgcn_rcpf(wsf[32+crow(r,hi)]);
  bf16*Ow=O+(long)(q0+wid*QBLK)*PO;
  { bf16*stg=(bf16*)(shm+LDS_OST)+wid*2048;
    #pragma unroll
    for(int p=0;p<2;++p){
    #pragma unroll
    for(int r=0;r<16;++r){const int orow=crow(r,hi);
      #pragma unroll
      for(int d0=0;d0<2;++d0)stg[orow*64+d0*32+r32]=__float2bfloat16(o[2*p+d0][r]*rli[r]);}
    asm volatile("s_waitcnt lgkmcnt(0)":::"memory");
    #pragma unroll
    for(int i=0;i<4;++i){const int row=i*8+(lane>>3),ch=lane&7; const u32x4 v=*(const u32x4*)(stg+row*64+ch*8); ATTN_STORE16(Ow+(long)row*PO+p*64+ch*8,v);}
    asm volatile("s_waitcnt lgkmcnt(0)":::"memory"); } }
  asm volatile("s_waitcnt lgkmcnt(0)\n\ts_barrier":::"memory");
  #undef DMA_K
  #undef DMA_V
  #undef CMASK
  #undef START
  #undef RESC
  #undef ROT
}
constexpr int ATTN_LDS_BYTES=LDS_BYTES;
struct AttnTensors { const bf16* Q; const bf16* Kimg; const bf16* Vimg; bf16* O0; bf16* O1; };
struct AttnUnit { int vh; int qb; };
struct StaticOrder {
  int vcu;
  __device__ __forceinline__ explicit StaticOrder(int vcu_):vcu(vcu_){}
  __device__ __forceinline__ bool next(int i,AttnUnit&u)const{ if(i>=4)return false; const int s=vcu&3; u.vh=vcu>>2; u.qb=(i==0)?s:(i==1)?7-s:(i==2)?8+s:15-s; return true; }
  __device__ __forceinline__ void a_ready(const AttnUnit&)const{}
  __device__ __forceinline__ void done(const AttnUnit&)const{}
};
template<int ABL=0> __device__ __forceinline__ void attn_run(const AttnTensors&T,int vh,int qb,char*lds){
  const int comp=vh&1,h=(vh>>1)&3,b=vh>>3;
  attn_unit<8>(qb,T.Q+(long)b*SEQ*PQ+h*128+comp*64,T.Kimg+(long)((b*8+h*2+comp)*(SEQ/64))*KT,T.Vimg+(long)((b*4+h)*(SEQ/64))*VT,(comp?T.O1:T.O0)+(long)b*SEQ*PO+h*128,lds);
}
__device__ __forceinline__ unsigned q_take(unsigned*qheads,int&cq){
  for(int tries=0;tries<8;++tries){
    const unsigned idx=__hip_atomic_fetch_add(qheads+cq,1u,__ATOMIC_RELAXED,__HIP_MEMORY_SCOPE_AGENT);
    if(idx<64u)return (unsigned)cq*64u+idx;
    int found=-1;
    #pragma unroll
    for(int j=1;j<8;++j){const int q=(cq+j)&7; if(found<0&&__hip_atomic_load(qheads+q,__ATOMIC_RELAXED,__HIP_MEMORY_SCOPE_AGENT)<64u)found=q;}
    if(found<0)return 0xffffffffu;
    cq=found;}
  return 0xffffffffu;
}
template<int ABL=0> __device__ __forceinline__ void attn_phase_queue(char*lds,const AttnTensors&T,unsigned*qheads,int xq,volatile __attribute__((address_space(3))) unsigned*mbox){
  const bool t0=(threadIdx.x==0); int cq=xq&7;
  if(t0)mbox[0]=q_take(qheads,cq);
  asm volatile("s_waitcnt vmcnt(0) lgkmcnt(0)\n\ts_barrier":::"memory");
  unsigned ticket=(unsigned)__builtin_amdgcn_readfirstlane(mbox[0]); int par=0;
  while(ticket!=0xffffffffu){
    unsigned nxt=0u; if(t0)nxt=__hip_atomic_fetch_add(qheads+cq,1u,__ATOMIC_RELAXED,__HIP_MEMORY_SCOPE_AGENT);
    attn_run<ABL>(T,4*(int)(ticket>>6)+(int)(ticket&3u),15-(int)((ticket&63u)>>2),lds);
    par^=1; if(t0)mbox[par]=(nxt<64u)?(unsigned)cq*64u+nxt:q_take(qheads,cq);
    asm volatile("s_waitcnt vmcnt(0) lgkmcnt(0)\n\ts_barrier":::"memory");
    ticket=(unsigned)__builtin_amdgcn_readfirstlane(mbox[par]);
  }
}
#undef SBAR
#undef WAIT_BAR
}

constexpr int NWAVES = 8;
#ifndef MK_N_LAUNCHES
#define MK_N_LAUNCHES 1
#endif
constexpr int PER_PHASE = 8;
constexpr int N_LAUNCHES = MK_N_LAUNCHES;

constexpr int BATCH = 4, T = 4096, D = 1024;
constexpr int M = BATCH * T;
constexpr int RW_W = 512, RW_H = 8, RW_N = 64, DA_W = 512;
constexpr int RW_SHIFTED = 1664, RW_COLS = 2176, D_IN = 4224;
constexpr int NMAIN = 4096;
constexpr float RMS_EPS = 1e-6f, GN_EPS = 64e-5f, SUBLN_EPS = 1e-5f;
constexpr float LAMBDA_INIT = 0.2f;
constexpr float LOG2E = 1.4426950408889634f;

constexpr size_t MiB = 1u << 20, KiB = 1u << 10;
constexpr size_t WS_CTL = 0, CTL_ZERO_BYTES = 128 * KiB;
constexpr size_t WS_MOD = 128 * KiB;
constexpr size_t WS_W2T = 256 * KiB;
constexpr size_t WS_BONUS = 512 * KiB;
constexpr size_t WS_X = 1 * MiB;
constexpr size_t WS_WOUT = 1 * MiB + 512 * KiB;
constexpr size_t WS_WIN = 3 * MiB + 512 * KiB;
constexpr size_t WS_XN = 11 * MiB + 768 * KiB;
constexpr size_t WS_REC1 = WS_XN;
constexpr size_t WS_Y = WS_XN;
constexpr size_t WS_URK = WS_XN + 32 * MiB;
constexpr size_t WS_UVG = WS_URK + 32 * MiB;
constexpr size_t WS_UQG = WS_UVG + 32 * MiB;
constexpr size_t WS_KIMG = WS_UQG + 32 * MiB;
constexpr size_t WS_VIMG = WS_KIMG + 16 * MiB;
constexpr size_t WS_REC2 = WS_VIMG + 16 * MiB;
constexpr size_t WS_LO = WS_REC2 + 65 * MiB;
constexpr size_t WS_ORW = WS_LO;
constexpr size_t WS_END = WS_ORW + 16 * MiB;
static_assert(WS_END <= 256 * MiB, "d_ws map");
constexpr int UP = 1024;
constexpr int CW_TMO = 0, CW_CODE = 1;
constexpr int CW_BAR = 4096;
constexpr int CW_SEAM = 16384;
constexpr int CW_QUEUE = 24576;
static_assert((CW_QUEUE + 1024 + 16 * 64) * 4 <= (int)CTL_ZERO_BYTES, "CTL words inside the memset region");

constexpr int RING_OFF = 0, RING_BYTES = 131072;
constexpr int LDSCTL_OFF = RING_BYTES, MISC_OFF = LDSCTL_OFF + 320;
constexpr int LDS_BYTES = 147456;
static_assert(MISC_OFF + 128 <= LDS_BYTES, "LDS map");

#define GAS __attribute__((address_space(1)))
#define LAS __attribute__((address_space(3)))
typedef unsigned short bf16;
typedef unsigned v4u __attribute__((ext_vector_type(4)));
typedef float f32x4 __attribute__((ext_vector_type(4)));
typedef short bf16x8 __attribute__((ext_vector_type(8)));
typedef GAS unsigned gu32;
typedef GAS unsigned long long gu64;
#define RLX_AGENT __ATOMIC_RELAXED, __HIP_MEMORY_SCOPE_AGENT
#define LDS_WAIT() asm volatile("s_waitcnt lgkmcnt(0)" ::: "memory")
#define VM_WAIT() asm volatile("s_waitcnt vmcnt(0)" ::: "memory")
__device__ __forceinline__ unsigned long long rt() { return __builtin_amdgcn_s_memrealtime(); }
__device__ __forceinline__ unsigned f2bf(float f) { unsigned u = __builtin_bit_cast(unsigned, f); return (u + 0x7fffu + ((u >> 16) & 1u)) >> 16; }
__device__ __forceinline__ unsigned pk2(float lo, float hi) { return f2bf(lo) | (f2bf(hi) << 16); }

#define XB_TMO      128
#define XB_XCNT(j)  (256  + 64 * (j))
#define XB_XSUB(j)  (1280 + 64 * (j))
#define XB_XGEN(j)  (2304 + 64 * (j))
#define XB_TOP      3328
#define XB_TOPGEN   3392
#define XCD_BAR_WORDS 3456
#define XB_SPIN_CAP (1u << 18)

__device__ __forceinline__ unsigned xb_ld(unsigned* p)              { return __hip_atomic_load(p, __ATOMIC_RELAXED, __HIP_MEMORY_SCOPE_AGENT); }
__device__ __forceinline__ unsigned xb_add(unsigned* p, unsigned v) { return __hip_atomic_fetch_add(p, v, __ATOMIC_RELAXED, __HIP_MEMORY_SCOPE_AGENT); }
__device__ __forceinline__ unsigned xb_xcc_id() { return (unsigned)__builtin_amdgcn_s_getreg((3 << 11) | 20) & 0xFu; }
#define XB_SPIN(cond, bar) do { unsigned _sp = 0; while (cond) { __builtin_amdgcn_s_sleep(1); \
    if ((++_sp & 255u) == 0u) { if (xb_ld(&(bar)[XB_TMO])) break; if (_sp > XB_SPIN_CAP) { atomicAdd(&(bar)[XB_TMO], 1u); break; } } } } while (0)

struct XcdBarrier {
    unsigned* bar; unsigned x;
    volatile LAS unsigned* st;
};

__device__ __forceinline__ XcdBarrier xcd_barrier_post(unsigned* bar, volatile LAS unsigned* st) {
    XcdBarrier b; b.bar = bar; b.x = xb_xcc_id(); b.st = st;
    if (threadIdx.x == 0) (void)xb_add(&bar[XB_XCNT(b.x)], 1u);
    return b;
}
__device__ __forceinline__ void xcd_barrier_complete(unsigned* bar, unsigned x, unsigned& nloc, unsigned& nx) {
    const unsigned G = gridDim.x * gridDim.y * gridDim.z;
    unsigned sum, cnt, mine, sp = 0u;
    for (;;) {
        sum = 0u; cnt = 0u; mine = 0u;
#pragma unroll
        for (unsigned j = 0; j < 16; ++j) { const unsigned c = xb_ld(&bar[XB_XCNT(j)]); sum += c; cnt += (c > 0u) ? 1u : 0u; mine = (j == x) ? c : mine; }
        if (sum == G) break;
        __builtin_amdgcn_s_sleep(1);
        if ((++sp & 255u) == 0u) { if (xb_ld(&bar[XB_TMO])) break; if (sp > XB_SPIN_CAP) { atomicAdd(&bar[XB_TMO], 1u); break; } }
    }
    nloc = mine > 0u ? mine : 1u; nx = cnt > 0u ? cnt : 1u;
}

__device__ __forceinline__ void xcd_barrier(const XcdBarrier& b) {
    asm volatile("s_waitcnt vmcnt(0)" ::: "memory");
    __syncthreads();
    if (threadIdx.x == 0) {
        unsigned* bar = b.bar;
        __builtin_amdgcn_s_waitcnt(0);
        unsigned nloc = b.st[0], nx = b.st[1];
        if (nloc == 0u) { xcd_barrier_complete(bar, b.x, nloc, nx); b.st[0] = nloc; b.st[1] = nx; }
        const unsigned old = xb_add(&bar[XB_XSUB(b.x)], 1u);
        const unsigned gen = old / nloc;
        if (old + 1u == (gen + 1u) * nloc) {
            __builtin_amdgcn_fence(__ATOMIC_RELEASE, "agent");
            asm volatile("s_waitcnt vmcnt(0)" ::: "memory");
            const unsigned og = xb_add(&bar[XB_TOP], 1u);
            const unsigned tg = og / nx;
            if (og + 1u == (tg + 1u) * nx) xb_add(&bar[XB_TOPGEN], 1u);
            else XB_SPIN(xb_ld(&bar[XB_TOPGEN]) == tg, bar);
            __builtin_amdgcn_fence(__ATOMIC_ACQUIRE, "agent");
            xb_add(&bar[XB_XGEN(b.x)], 1u);
            asm volatile("s_waitcnt vmcnt(0)" ::: "memory");
        } else {
            XB_SPIN(xb_ld(&bar[XB_XGEN(b.x)]) == gen, bar);
            __builtin_amdgcn_fence(__ATOMIC_ACQUIRE, "agent");
            asm volatile("s_waitcnt vmcnt(0)" ::: "memory");
        }
    }
    __syncthreads();
}
struct Frame {
    LAS unsigned char* lds;
    volatile LAS unsigned* MISC;
    gu32* ctl;
    int tid, lane, wave;
    int vcu, G;
    const float* in[23]; float* out; unsigned char* ws;
};
enum { I_X = 0, I_C, I_WADA, I_BADA, I_GPRE, I_GPOST, I_WIN, I_WOUT, I_MU, I_W0, I_WW2, I_A0, I_WA2, I_KK, I_KA, I_RK, I_LNW, I_LNB, I_LQ1, I_LK1, I_LQ2, I_LK2, I_SUBLN };

typedef float f32x2c_t __attribute__((ext_vector_type(2))); typedef __bf16 bf16x2c_t __attribute__((ext_vector_type(2)));
__device__ __forceinline__ unsigned cvtpk(float lo, float hi) { f32x2c_t v = {lo, hi}; bf16x2c_t b = __builtin_convertvector(v, bf16x2c_t); return __builtin_bit_cast(unsigned, b); }
__device__ __forceinline__ float bf2f(unsigned short v) { return __builtin_bit_cast(float, (unsigned)v << 16); }
__device__ __forceinline__ float bflo(unsigned v) { return __builtin_bit_cast(float, v << 16); }
__device__ __forceinline__ float bfhi(unsigned v) { return __builtin_bit_cast(float, v & 0xffff0000u); }
__device__ __forceinline__ float sigmoidf_(float x) { return 1.f / (1.f + __expf(-x)); }
__device__ __forceinline__ float siluf_(float x) { return x / (1.f + __expf(-x)); }
__device__ __forceinline__ float silu_fast(float x) { return x * __builtin_amdgcn_rcpf(1.f + __builtin_amdgcn_exp2f(-1.4426950408889634f * x)); }

__device__ __forceinline__ float wave_sum(float v) {
#pragma unroll
    for (int o = 1; o < 64; o <<= 1) v += __shfl_xor(v, o);
    return v;
}
__device__ __forceinline__ float sum8_dpp(float v) { v += __builtin_bit_cast(float, __builtin_amdgcn_update_dpp(0, __builtin_bit_cast(int, v), 0xB1, 0xf, 0xf, true)); v += __builtin_bit_cast(float, __builtin_amdgcn_update_dpp(0, __builtin_bit_cast(int, v), 0x4E, 0xf, 0xf, true));
    v += __builtin_bit_cast(float, __builtin_amdgcn_update_dpp(0, __builtin_bit_cast(int, v), 0x141, 0xf, 0xf, true)); return v; }
__device__ __forceinline__ float sum16_dpp(float v) { v = sum8_dpp(v); v += __builtin_bit_cast(float, __builtin_amdgcn_update_dpp(0, __builtin_bit_cast(int, v), 0x140, 0xf, 0xf, true)); return v; }
__device__ __forceinline__ int win_col(int n) { return n < 1536 ? n : (n < 2048 ? 1664 + (n - 1536) : (n < 4096 ? 2176 + (n - 2048) : 1536 + (n - 4096))); }
template <bool IMG = false> __device__ __forceinline__ void p0_transpose_item(const float* W, int K, int N, bf16* WT, int k0, int src_col0, int dst_row0, LAS float* scr, int lane) {
#pragma unroll 8
    for (int i = 0; i < 32; ++i) { const int kk = 2 * i + (lane >> 5); scr[kk * 33 + (lane & 31)] = W[(size_t)(k0 + kk) * N + src_col0 + (lane & 31)]; }
    LDS_WAIT(); asm volatile("" ::: "memory");
    const int c = lane & 7;
#pragma unroll
    for (int j = 0; j < 4; ++j) { const int n = (lane >> 3) + 8 * j; const LAS float* s = scr + (8 * c) * 33 + n;
        v4u o; o.x = cvtpk(s[0 * 33], s[1 * 33]); o.y = cvtpk(s[2 * 33], s[3 * 33]); o.z = cvtpk(s[4 * 33], s[5 * 33]); o.w = cvtpk(s[6 * 33], s[7 * 33]);
        if (IMG) { const int nn = dst_row0 + n, kk_ = k0 + 8 * c; *(GAS v4u*)((char*)WT + ((size_t)(((nn >> 4) * 32 + (kk_ >> 5)) * 64 + ((kk_ >> 3) & 3) * 16 + (nn & 15))) * 16) = o; }
        else *(GAS v4u*)(WT + (size_t)(dst_row0 + n) * K + k0 + 8 * c) = o; }
    LDS_WAIT(); asm volatile("" ::: "memory");
}
__device__ __forceinline__ void p0_mod_item(Frame& F, int item) {
    const float* c = F.in[I_C]; const float* wada = F.in[I_WADA]; const float* bada = F.in[I_BADA]; float* mod = (float*)(F.ws + WS_MOD);
    const int col = item * 4;
    f32x4 acc[4] = {{0.f, 0.f, 0.f, 0.f}, {0.f, 0.f, 0.f, 0.f}, {0.f, 0.f, 0.f, 0.f}, {0.f, 0.f, 0.f, 0.f}};
    f32x4 wv[16];
#pragma unroll
    for (int i = 0; i < 16; ++i) wv[i] = *(const f32x4*)(wada + (size_t)(F.lane + 64 * i) * 3072 + col);
#pragma unroll
    for (int i = 0; i < 16; ++i) { const int k = F.lane + 64 * i;
#pragma unroll
        for (int b = 0; b < 4; ++b) acc[b] += siluf_(c[b * D + k]) * wv[i]; }
#pragma unroll
    for (int b = 0; b < 4; ++b)
#pragma unroll
        for (int i = 0; i < 4; ++i) acc[b][i] = wave_sum(acc[b][i]);
    if (F.lane == 0) {
        const f32x4 bv = *(const f32x4*)(bada + col);
#pragma unroll
        for (int b = 0; b < 4; ++b) *(f32x4*)(mod + b * 3072 + col) = acc[b] + bv;
    }
}
__device__ __forceinline__ void p0_prologue(Frame& F) {
    LAS float* scr = (LAS float*)(F.lds + RING_OFF + F.wave * 16384);
    const int gw = F.vcu * NWAVES + F.wave, NGW = F.G * NWAVES;
    constexpr int I_MOD = 3072 / 4, I_IN = (D / 64) * (D_IN / 32), I_OUT = (D / 64) * (D / 32), I_W2 = 512 / 32;
    constexpr int NITEMS = I_MOD + I_IN + I_OUT + 2 * I_W2;
    bf16* WinT = (bf16*)(F.ws + WS_WIN); bf16* WoutT = (bf16*)(F.ws + WS_WOUT);
    for (int it = gw; it < NITEMS; it += NGW) {
        int r = it;
        if (r < I_MOD) { p0_mod_item(F, r); continue; } r -= I_MOD;
        if (r < I_IN) { const int nblk = D_IN / 32, kb = r / nblk, nb = r % nblk; p0_transpose_item(F.in[I_WIN], D, D_IN, WinT, 64 * kb, win_col(32 * nb), 32 * nb, scr, F.lane); continue; } r -= I_IN;
        if (r < I_OUT) { const int nblk = D / 32, kb = r / nblk, nb = r % nblk; p0_transpose_item<true>(F.in[I_WOUT], D, D, WoutT, 64 * kb, 32 * nb, 32 * nb, scr, F.lane); continue; } r -= I_OUT;
        { const int which = r / I_W2, nb = r % I_W2; p0_transpose_item(F.in[which ? I_WA2 : I_WW2], 64, 512, (bf16*)(F.ws + WS_W2T) + (size_t)which * 512 * 64, 0, 32 * nb, 32 * nb, scr, F.lane); }
    }
}
__device__ __forceinline__ void p1_rows(Frame& F) {
    const int gw = F.vcu * NWAVES + F.wave, NGW = F.G * NWAVES;
    const float* x = F.in[I_X]; const float* gpre = F.in[I_GPRE]; const float* mod = (const float*)(F.ws + WS_MOD); bf16* XN = (bf16*)(F.ws + WS_XN);
    for (int m0 = gw; m0 < M; m0 += 8 * NGW) {
        f32x4 v[8][4];
#pragma unroll
        for (int r = 0; r < 8; ++r) { const int m = m0 + r * NGW; if (m < M) { const GAS f32x4* xr = (const GAS f32x4*)(x + (size_t)m * D) + F.lane;
#pragma unroll
            for (int j = 0; j < 4; ++j) v[r][j] = __builtin_nontemporal_load(xr + 64 * j); } }
#pragma unroll
        for (int r = 0; r < 8; ++r) { const int m = m0 + r * NGW; if (m < M) { const int b = m / T; float s = 0.f;
#pragma unroll
            for (int j = 0; j < 4; ++j) s += (v[r][j].x * v[r][j].x + v[r][j].y * v[r][j].y) + (v[r][j].z * v[r][j].z + v[r][j].w * v[r][j].w);
            const float rstd = __builtin_amdgcn_rsqf(wave_sum(s) * (1.f / D) + RMS_EPS);
            GAS unsigned long long* o8 = (GAS unsigned long long*)(XN + (size_t)m * D) + F.lane;
#pragma unroll
            for (int j = 0; j < 4; ++j) { const int col = 4 * F.lane + 256 * j;
                const f32x4 g = *(const f32x4*)(gpre + col), sh = *(const f32x4*)(mod + b * 3072 + col), sc = *(const f32x4*)(mod + b * 3072 + 1024 + col);
                const f32x4 h = v[r][j] * rstd * g * (sc + 1.f) + sh;
                o8[64 * j] = (unsigned long long)cvtpk(h[0], h[1]) | ((unsigned long long)cvtpk(h[2], h[3]) << 32); } } }
    }
}
__device__ __forceinline__ void glds16f(const void* gsrc, unsigned lds_dst) { unsigned keep;
    asm volatile("s_mov_b32 %0, m0\n\ts_mov_b32 m0, %2\n\ts_nop 0\n\tglobal_load_lds_dwordx4 %1, off\n\ts_mov_b32 m0, %0" : "=&s"(keep) : "v"(gsrc), "s"(lds_dst) : "memory"); }
__device__ __forceinline__ void glds4f(const void* gsrc, unsigned lds_dst) { unsigned keep;
    asm volatile("s_mov_b32 %0, m0\n\ts_mov_b32 m0, %2\n\ts_nop 0\n\tglobal_load_lds_dword %1, off\n\ts_mov_b32 m0, %0" : "=&s"(keep) : "v"(gsrc), "s"(lds_dst) : "memory"); }
__device__ __forceinline__ void p2_lora(Frame& F) {
    typedef float f32x4_ __attribute__((ext_vector_type(4)));
    const bf16* XN = (const bf16*)(F.ws + WS_XN); const bf16* Wl = (const bf16*)(F.ws + WS_WIN) + (size_t)NMAIN * D; bf16* LO = (bf16*)(F.ws + WS_LO);
    const int fr = F.lane & 15, fq = F.lane >> 4, w = F.wave;
    const unsigned lds0 = (unsigned)(uintptr_t)(F.lds + RING_OFF);
    for (int unit = F.vcu; unit < M / 64; unit += F.G) {
        const int row0 = unit * 64;
        const bf16* bp = Wl + (size_t)(w * 16 + fr) * D + fq * 8;
        bf16x8 bb[32];
#pragma unroll
        for (int k = 0; k < 32; ++k) bb[k] = *(const bf16x8*)(bp + k * 32);
#pragma unroll
        for (int j = 0; j < 16; ++j) { const int p = w + 8 * j, ks = p >> 2, rt = p & 3;
            glds16f(XN + (size_t)(row0 + rt * 16 + fr) * D + ks * 32 + fq * 8, (unsigned)__builtin_amdgcn_readfirstlane(lds0 + p * 1024)); }
        f32x4_ acc[4] = {{0.f, 0.f, 0.f, 0.f}, {0.f, 0.f, 0.f, 0.f}, {0.f, 0.f, 0.f, 0.f}, {0.f, 0.f, 0.f, 0.f}};
#define LORA_STAGE(s_, cnt_) do { asm volatile("s_waitcnt vmcnt(" #cnt_ ")" ::: "memory"); __builtin_amdgcn_s_barrier(); asm volatile("" ::: "memory"); \
            _Pragma("unroll") for (int k = 0; k < 8; ++k) { const int ks = (s_) * 8 + k; \
                _Pragma("unroll") for (int rt = 0; rt < 4; ++rt) { const bf16x8 a = *(const LAS bf16x8*)(F.lds + RING_OFF + (4 * ks + rt) * 1024 + F.lane * 16); \
                    acc[rt] = __builtin_amdgcn_mfma_f32_16x16x32_bf16(bb[ks], a, acc[rt], 0, 0, 0); } } } while (0)
        LORA_STAGE(0, 12); LORA_STAGE(1, 8); LORA_STAGE(2, 4); LORA_STAGE(3, 0);
#undef LORA_STAGE
#pragma unroll
        for (int rt = 0; rt < 4; ++rt) { const unsigned long long o = (unsigned long long)cvtpk(acc[rt][0], acc[rt][1]) | ((unsigned long long)cvtpk(acc[rt][2], acc[rt][3]) << 32);
            *(GAS unsigned long long*)(LO + (size_t)(row0 + rt * 16 + fr) * 128 + w * 16 + 4 * fq) = o; }
        LDS_WAIT(); __builtin_amdgcn_s_barrier();
    }
}
__device__ __forceinline__ float tshift(float cur, float prev, float mu) { return cur + (prev - cur) * mu; }

constexpr int REC_WA = 0, REC_RA = 2048, REC_AR = 4096, REC_BK = 5120, REC_VT = 9216, REC_MAK = 11264, REC_G = 11776, REC_BYTES = 12032;
constexpr int NCHUNK = T / 16;
constexpr int REC1_N = (int)((32 * MiB) / REC_BYTES);
static_assert((size_t)(BATCH * RW_H * NCHUNK - REC1_N) * REC_BYTES <= 65 * MiB, "record regions");
__device__ __forceinline__ unsigned char* rec_ptr(unsigned char* ws, int b, int h, int chunk) {
    const int idx = (b * RW_H + h) * NCHUNK + chunk;
    return idx < REC1_N ? ws + WS_REC1 + (size_t)idx * REC_BYTES : ws + WS_REC2 + (size_t)(idx - REC1_N) * REC_BYTES;
}
constexpr int PW_KAP = 0, PW_RH = 2304, PW_BH = 4608, PW_KH = 6912, PW_AAB = 9216, PW_AAK = 10496, PW_TM = 11776;
constexpr int PWS = 72;
static_assert(PW_TM + 16 * 20 * 4 <= 13312 && 2 * 16 * 68 * 4 <= PW_AAB, "prep scratch");

constexpr int PWB = 13312;
constexpr int PT_S = 68;
__device__ __forceinline__ float fast_exp(float x) { return __builtin_amdgcn_exp2f(x * LOG2E); }
__device__ __forceinline__ float fast_sigmoid(float x) { return __builtin_amdgcn_rcpf(1.f + fast_exp(-x)); }
__device__ __forceinline__ float fast_tanh(float x) { const float e = fast_exp(-2.f * fabsf(x)); const float t = (1.f - e) * __builtin_amdgcn_rcpf(1.f + e); return x < 0.f ? -t : t; }
__device__ __forceinline__ void p3_prep(Frame& F) {
    typedef float f32x4_ __attribute__((ext_vector_type(4)));
    const bf16* LO = (const bf16*)(F.ws + WS_LO); const bf16* Urk = (const bf16*)(F.ws + WS_URK); const bf16* Uvg = (const bf16*)(F.ws + WS_UVG); float* BON = (float*)(F.ws + WS_BONUS);
    const bf16* W2T = (const bf16*)(F.ws + WS_W2T);
    const float* mu = F.in[I_MU];
    LAS unsigned char* pw = F.lds + RING_OFF + F.wave * PWB;
    const int c = F.tid, lane = F.lane, h = F.wave, fi = lane & 15, fg = lane >> 4;
    const float k_k = F.in[I_KK][c], k_a = F.in[I_KA][c], r_k = F.in[I_RK][c], mu_r = mu[c], mu_k = mu[512 + c], mu_v = mu[1024 + c];
    float w0c[4], a0c[4];
#pragma unroll
    for (int nt = 0; nt < 4; ++nt) { w0c[nt] = F.in[I_W0][h * 64 + nt * 16 + fi]; a0c[nt] = F.in[I_A0][h * 64 + nt * 16 + fi]; }
    for (int tile = F.vcu; tile < M / 16; tile += F.G) {
        const int m0 = tile * 16, b = m0 / T, chunk = (m0 % T) / 16; const bool firstc = (chunk == 0);
        unsigned char* rec = rec_ptr(F.ws, b, h, chunk);
        unsigned short rw_[17], kw_[17], vw_[17];
#pragma unroll
        for (int i = 0; i < 17; ++i) { const size_t m = (size_t)(m0 + i - 1);
            if (i == 0 && firstc) { rw_[0] = 0; kw_[0] = 0; vw_[0] = 0; }
            else { rw_[i] = Urk[m * UP + c]; kw_[i] = Urk[m * UP + 512 + c]; vw_[i] = Uvg[m * UP + c]; } }
        float lw2[16], av[16];
        {
            bf16x8 fw[2], fa[2];
#pragma unroll
            for (int ks = 0; ks < 2; ++ks) {
                const bf16* lp = LO + (size_t)(m0 + fi) * 128 + ks * 32 + fg * 8; const bool nz = !(firstc && fi == 0);
                const v4u cw_ = *(const GAS v4u*)lp, ca_ = *(const GAS v4u*)(lp + 64);
                v4u pw_ = {0u, 0u, 0u, 0u}, pa_ = pw_; if (nz) { pw_ = *(const GAS v4u*)(lp - 128); pa_ = *(const GAS v4u*)(lp - 64); }
                const f32x4_ m0w = *(const f32x4_*)(mu + 1536 + ks * 32 + fg * 8), m1w = *(const f32x4_*)(mu + 1536 + ks * 32 + fg * 8 + 4), m0a = *(const f32x4_*)(mu + 1600 + ks * 32 + fg * 8), m1a = *(const f32x4_*)(mu + 1600 + ks * 32 + fg * 8 + 4);
                v4u ow, oa;
#pragma unroll
                for (int u = 0; u < 4; ++u) { const float mwl = (u < 2 ? m0w : m1w)[(2 * u) & 3], mwh = (u < 2 ? m0w : m1w)[(2 * u + 1) & 3], mal = (u < 2 ? m0a : m1a)[(2 * u) & 3], mah = (u < 2 ? m0a : m1a)[(2 * u + 1) & 3];
                    ow[u] = cvtpk(fast_tanh(tshift(bflo(cw_[u]), bflo(pw_[u]), mwl)), fast_tanh(tshift(bfhi(cw_[u]), bfhi(pw_[u]), mwh)));
                    oa[u] = cvtpk(tshift(bflo(ca_[u]), bflo(pa_[u]), mal), tshift(bfhi(ca_[u]), bfhi(pa_[u]), mah)); }
                fw[ks] = __builtin_bit_cast(bf16x8, ow); fa[ks] = __builtin_bit_cast(bf16x8, oa); }
            f32x4_ cw[4], ca[4];
#pragma unroll
            for (int nt = 0; nt < 4; ++nt) { cw[nt] = (f32x4_){0.f, 0.f, 0.f, 0.f}; ca[nt] = cw[nt]; }
#pragma unroll
            for (int nt = 0; nt < 4; ++nt)
#pragma unroll
                for (int ks = 0; ks < 2; ++ks) { const size_t o = (size_t)(h * 64 + nt * 16 + fi) * 64 + ks * 32 + fg * 8;
                    const bf16x8 bw = *(const bf16x8*)(W2T + o), ba = *(const bf16x8*)(W2T + 512 * 64 + o);
                    cw[nt] = __builtin_amdgcn_mfma_f32_16x16x32_bf16(fw[ks], bw, cw[nt], 0, 0, 0); ca[nt] = __builtin_amdgcn_mfma_f32_16x16x32_bf16(fa[ks], ba, ca[nt], 0, 0, 0); }
            LAS float* t1 = (LAS float*)pw; LAS float* t2 = t1 + 16 * PT_S;
#pragma unroll
            for (int nt = 0; nt < 4; ++nt)
#pragma unroll
                for (int j = 0; j < 4; ++j) { const float x_ = w0c[nt] + cw[nt][j];
                    const float sp = 0.6931471805599453f * __builtin_amdgcn_logf(1.f + fast_exp(-x_));
                    t1[(4 * fg + j) * PT_S + nt * 16 + fi] = -fast_exp(-sp - 0.5f) * LOG2E;
                    t2[(4 * fg + j) * PT_S + nt * 16 + fi] = fast_sigmoid(a0c[nt] + ca[nt][j]); }
            LDS_WAIT(); asm volatile("" ::: "memory");
#pragma unroll
            for (int i = 0; i < 16; ++i) { lw2[i] = t1[i * PT_S + lane]; av[i] = t2[i * PT_S + lane]; }
            LDS_WAIT(); asm volatile("" ::: "memory");
        }
        float kap[16], cl[16];
        {
        float rr[16], kt[16], kk[16], bb[16];
        LAS float* r1 = (LAS float*)pw; LAS float* r2 = r1 + 16 * PT_S; LAS float* s1 = (LAS float*)(pw + PW_TM);
        {
        float vv[16];
#pragma unroll
        for (int i = 0; i < 16; ++i) {
            const float r = tshift(bf2f(rw_[i + 1]), bf2f(rw_[i]), mu_r), k = tshift(bf2f(kw_[i + 1]), bf2f(kw_[i]), mu_k);
            vv[i] = tshift(bf2f(vw_[i + 1]), bf2f(vw_[i]), mu_v);
            const float kkr = k * k_k; kk[i] = kkr; kt[i] = k * (1.f + (av[i] - 1.f) * k_a); rr[i] = r;
            r1[i * PT_S + lane] = kkr * kkr; r2[i * PT_S + lane] = r * kt[i] * r_k; }
#pragma unroll
        for (int g = 0; g < 4; ++g) { const unsigned long long o = (unsigned long long)cvtpk(vv[4 * g], vv[4 * g + 1]) | ((unsigned long long)cvtpk(vv[4 * g + 2], vv[4 * g + 3]) << 32);
            *(GAS unsigned long long*)(rec + REC_VT + (lane >> 4) * 512 + (g * 16 + (lane & 15)) * 8) = o; }
        }
        LDS_WAIT(); asm volatile("" ::: "memory");
        { const int i = lane >> 2, q = lane & 3; float sa = 0.f, sb = 0.f;
#pragma unroll
          for (int u = 0; u < 4; ++u) { const f32x4_ x = *(const LAS f32x4_*)(r1 + i * PT_S + 16 * q + 4 * u), y = *(const LAS f32x4_*)(r2 + i * PT_S + 16 * q + 4 * u); sa += (x[0] + x[1]) + (x[2] + x[3]); sb += (y[0] + y[1]) + (y[2] + y[3]); }
          sa += __shfl_xor(sa, 1); sa += __shfl_xor(sa, 2); sb += __shfl_xor(sb, 1); sb += __shfl_xor(sb, 2);
          if (q == 0) { s1[i] = sa; BON[(m0 + i) * 8 + h] = sb; } }
        LDS_WAIT(); asm volatile("" ::: "memory");
        float run = 0.f;
#pragma unroll
        for (int i = 0; i < 16; ++i) { kk[i] = kk[i] * __builtin_amdgcn_rcpf(fmaxf(__builtin_amdgcn_sqrtf(s1[i]), 1e-12f)); bb[i] = av[i] * kk[i]; run += lw2[i]; cl[i] = run; }
        LDS_WAIT(); asm volatile("" ::: "memory");
        LAS unsigned short* okap = (LAS unsigned short*)(pw + PW_KAP); LAS unsigned short* orh = (LAS unsigned short*)(pw + PW_RH);
        LAS unsigned short* obh = (LAS unsigned short*)(pw + PW_BH); LAS unsigned short* okh = (LAS unsigned short*)(pw + PW_KH);
        const float cl15 = cl[15];
#pragma unroll
        for (int g = 0; g < 4; ++g) { float kd[4], nbd[4];
#pragma unroll
            for (int u = 0; u < 4; ++u) { const int i = 4 * g + u;
                const float e = __builtin_amdgcn_exp2f(cl[i]), em1 = (i == 0) ? 1.f : __builtin_amdgcn_exp2f(cl[i - 1]), inv = __builtin_amdgcn_exp2f(-cl[i]), eL = __builtin_amdgcn_exp2f(cl15 - cl[i]);
                kap[i] = kk[i] * em1; const float rh = rr[i] * e, kh = kt[i] * inv, bh = bb[i] * inv; kd[u] = kt[i] * eL; nbd[u] = -bb[i] * eL;
                okap[i * PWS + lane] = (unsigned short)(cvtpk(kap[i], 0.f) & 0xffffu); orh[i * PWS + lane] = (unsigned short)(cvtpk(rh, 0.f) & 0xffffu); obh[i * PWS + lane] = (unsigned short)(cvtpk(bh, 0.f) & 0xffffu); okh[i * PWS + lane] = (unsigned short)(cvtpk(kh, 0.f) & 0xffffu); }
            v4u o; o.x = cvtpk(nbd[0], nbd[1]); o.y = cvtpk(nbd[2], nbd[3]); o.z = cvtpk(kd[0], kd[1]); o.w = cvtpk(kd[2], kd[3]);
            *(GAS v4u*)(rec + REC_BK + (lane >> 4) * 1024 + (g * 16 + (lane & 15)) * 16) = o; }
        }
        *(GAS float*)(rec + REC_G + ((((lane >> 2) & 3) * 4 + (lane >> 4)) * 4 + (lane & 3)) * 4) = __builtin_amdgcn_exp2f(cl[15]);
        LDS_WAIT(); asm volatile("" ::: "memory");
        f32x4_ sab = {0.f, 0.f, 0.f, 0.f}, sak = sab, srb = sab, srk = sab;
#pragma unroll
        for (int ks = 0; ks < 2; ++ks) { const int off = (fi * PWS + ks * 32 + fg * 8) * 2;
            const bf16x8 fk = *(const LAS bf16x8*)(pw + PW_KAP + off), fr_ = *(const LAS bf16x8*)(pw + PW_RH + off), fb = *(const LAS bf16x8*)(pw + PW_BH + off), fh = *(const LAS bf16x8*)(pw + PW_KH + off);
            sab = __builtin_amdgcn_mfma_f32_16x16x32_bf16(fk, fb, sab, 0, 0, 0); sak = __builtin_amdgcn_mfma_f32_16x16x32_bf16(fk, fh, sak, 0, 0, 0);
            srb = __builtin_amdgcn_mfma_f32_16x16x32_bf16(fr_, fb, srb, 0, 0, 0); srk = __builtin_amdgcn_mfma_f32_16x16x32_bf16(fr_, fh, srk, 0, 0, 0); }
        LAS float* Aab = (LAS float*)(pw + PW_AAB); LAS float* Aak = (LAS float*)(pw + PW_AAK); LAS float* Tm = (LAS float*)(pw + PW_TM);
        LAS unsigned short* arimg = (LAS unsigned short*)(pw + PW_BH);
        asm volatile("" ::: "memory");
#pragma unroll
        for (int j = 0; j < 4; ++j) { const int i = 4 * fg + j;
            Aab[i * 20 + fi] = (fi < i) ? sab[j] : 0.f; Aak[i * 20 + fi] = (fi < i) ? sak[j] : 0.f;
            const float nrb = (fi <= i) ? -srb[j] : 0.f, rk = (fi <= i) ? srk[j] : 0.f; const unsigned pk = cvtpk(nrb, rk);
            arimg[((fi >> 2) * 16 + i) * 8 + (fi & 3)] = (unsigned short)(pk & 0xffffu); arimg[((fi >> 2) * 16 + i) * 8 + 4 + (fi & 3)] = (unsigned short)(pk >> 16); }
        LDS_WAIT(); asm volatile("" ::: "memory");
        *(GAS v4u*)(rec + REC_AR + lane * 16) = *(const LAS v4u*)(pw + PW_BH + lane * 16);
        float tc[16];
#pragma unroll
        for (int i = 0; i < 16; ++i) { float acc = (i == fi) ? 1.f : 0.f;
#pragma unroll
            for (int j4 = 0; j4 < i; j4 += 4) { const f32x4_ ar_ = *(const LAS f32x4_*)(Aab + i * 20 + j4);
#pragma unroll
                for (int u = 0; u < 4; ++u) if (j4 + u < i) acc -= ar_[u] * tc[j4 + u]; }
            tc[i] = acc; }
        if (fg == 0) {
#pragma unroll
            for (int i = 0; i < 16; ++i) Tm[i * 20 + fi] = tc[i]; }
        LDS_WAIT(); asm volatile("" ::: "memory");
        { LAS unsigned short* okap = (LAS unsigned short*)(pw + PW_KAP);
#pragma unroll
        for (int i = 0; i < 16; ++i) { float acc = 0.f;
#pragma unroll
            for (int j4 = 0; j4 <= i; j4 += 4) { const f32x4_ tr_ = *(const LAS f32x4_*)(Tm + i * 20 + j4);
#pragma unroll
                for (int u = 0; u < 4; ++u) if (j4 + u <= i) acc += tr_[u] * kap[j4 + u]; }
            okap[i * PWS + lane] = (unsigned short)(cvtpk(acc, 0.f) & 0xffffu); } }
        { const int i = lane >> 2, q = lane & 3; f32x4_ acc = {0.f, 0.f, 0.f, 0.f};
#pragma unroll
          for (int j4 = 0; j4 < 16; j4 += 4) { const f32x4_ tr_ = *(const LAS f32x4_*)(Tm + i * 20 + j4);
#pragma unroll
              for (int u = 0; u < 4; ++u) acc += tr_[u] * *(const LAS f32x4_*)(Aak + (j4 + u) * 20 + 4 * q); }
          *(GAS unsigned long long*)(rec + REC_MAK + (q * 16 + i) * 8) = (unsigned long long)cvtpk(acc[0], acc[1]) | ((unsigned long long)cvtpk(acc[2], acc[3]) << 32); }
        LDS_WAIT(); asm volatile("" ::: "memory");
#pragma unroll
        for (int ks = 0; ks < 2; ++ks) { const int off = (fi * PWS + ks * 32 + 4 * fg) * 2;
            const unsigned long long w0_ = *(const LAS unsigned long long*)(pw + PW_KAP + off), w1_ = *(const LAS unsigned long long*)(pw + PW_KAP + off + 32);
            const unsigned long long r0_ = *(const LAS unsigned long long*)(pw + PW_RH + off), r1_ = *(const LAS unsigned long long*)(pw + PW_RH + off + 32);
            v4u o; o.x = (unsigned)w0_; o.y = (unsigned)(w0_ >> 32); o.z = (unsigned)w1_; o.w = (unsigned)(w1_ >> 32);
            *(GAS v4u*)(rec + REC_WA + ks * 1024 + lane * 16) = o;
            o.x = (unsigned)r0_; o.y = (unsigned)(r0_ >> 32); o.z = (unsigned)r1_; o.w = (unsigned)(r1_ >> 32);
            *(GAS v4u*)(rec + REC_RA + ks * 1024 + lane * 16) = o; }
        LDS_WAIT(); asm volatile("" ::: "memory");
    }
}
constexpr int SCAN_NS = 8;
__device__ __forceinline__ void p4_scan(Frame& F) {
    typedef float f32x4_ __attribute__((ext_vector_type(4)));
    const int si = (int)blockIdx.x;
    if (si >= BATCH * RW_H) return;
    const int b = si / RW_H, h = si % RW_H, lane = F.lane, w = F.wave;
    const unsigned lds0 = (unsigned)(uintptr_t)(F.lds + RING_OFF);
    if (w >= 4) {
        const int lw = w - 4;
#define SCAN_ISSUE(n) do { const int n_ = (n) < NCHUNK ? (n) : NCHUNK - 1; const unsigned char* rp = rec_ptr(F.ws, b, h, n_); const unsigned sb = lds0 + (unsigned)(((n) % SCAN_NS) * REC_BYTES); \
            glds16f(rp + lw * 1024 + lane * 16, (unsigned)__builtin_amdgcn_readfirstlane(sb + lw * 1024)); glds16f(rp + (lw + 4) * 1024 + lane * 16, (unsigned)__builtin_amdgcn_readfirstlane(sb + (lw + 4) * 1024)); \
            if (lw < 3) { glds16f(rp + (lw + 8) * 1024 + lane * 16, (unsigned)__builtin_amdgcn_readfirstlane(sb + (lw + 8) * 1024)); glds4f(rp + 11264 + lw * 256 + lane * 4, (unsigned)__builtin_amdgcn_readfirstlane(sb + 11264 + lw * 256)); } } while (0)
        for (int n = 0; n < SCAN_NS - 1; ++n) SCAN_ISSUE(n);
        for (int n = 0; n < NCHUNK; ++n) {
            if (lw < 3) asm volatile("s_waitcnt vmcnt(24)" ::: "memory"); else asm volatile("s_waitcnt vmcnt(12)" ::: "memory");
            __builtin_amdgcn_s_barrier(); asm volatile("" ::: "memory");
            SCAN_ISSUE(n + SCAN_NS - 1);
        }
        asm volatile("s_waitcnt vmcnt(0)" ::: "memory");
        __builtin_amdgcn_s_barrier();
#undef SCAN_ISSUE
        return;
    }
    bf16* Orw = (bf16*)(F.ws + WS_ORW);
    const int fc = lane & 15, fg = lane >> 4;
    f32x4_ H[4];
#pragma unroll
    for (int mt = 0; mt < 4; ++mt) H[mt] = (f32x4_){0.f, 0.f, 0.f, 0.f};
    bf16x8 hb0 = {0, 0, 0, 0, 0, 0, 0, 0}, hb1 = hb0;
    bf16* orow = Orw + ((size_t)b * T + 4 * fg) * 512 + h * 64 + 16 * w + fc;
    for (int n = 0; n < NCHUNK; ++n) {
        LDS_WAIT(); __builtin_amdgcn_s_barrier(); asm volatile("" ::: "memory");
        const LAS unsigned char* sb = F.lds + RING_OFF + (n % SCAN_NS) * REC_BYTES;
        typedef unsigned u32x2_ __attribute__((ext_vector_type(2)));
        const bf16x8 wa0 = *(const LAS bf16x8*)(sb + REC_WA + lane * 16), wa1 = *(const LAS bf16x8*)(sb + REC_WA + 1024 + lane * 16);
        const u32x2_ mk = *(const LAS u32x2_*)(sb + REC_MAK + lane * 8);
        const bf16x8 ra0 = *(const LAS bf16x8*)(sb + REC_RA + lane * 16), ra1 = *(const LAS bf16x8*)(sb + REC_RA + 1024 + lane * 16), ar = *(const LAS bf16x8*)(sb + REC_AR + lane * 16);
        bf16x8 bk[4]; f32x4_ gm[4];
#pragma unroll
        for (int mt = 0; mt < 4; ++mt) { bk[mt] = *(const LAS bf16x8*)(sb + REC_BK + mt * 1024 + lane * 16); gm[mt] = *(const LAS f32x4_*)(sb + REC_G + fg * 64 + mt * 16); }
        const u32x2_ vt = *(const LAS u32x2_*)(sb + REC_VT + w * 512 + lane * 8);
        const bf16x8 vz = __builtin_bit_cast(bf16x8, (v4u){0u, 0u, vt.x, vt.y}), mak = __builtin_bit_cast(bf16x8, (v4u){0u, 0u, mk.x, mk.y});
        f32x4_ U = {0.f, 0.f, 0.f, 0.f}, O = {0.f, 0.f, 0.f, 0.f};
        U = __builtin_amdgcn_mfma_f32_16x16x32_bf16(wa0, hb0, U, 0, 0, 0);
        U = __builtin_amdgcn_mfma_f32_16x16x32_bf16(wa1, hb1, U, 0, 0, 0);
        U = __builtin_amdgcn_mfma_f32_16x16x32_bf16(mak, vz, U, 0, 0, 0);
        O = __builtin_amdgcn_mfma_f32_16x16x32_bf16(ra0, hb0, O, 0, 0, 0);
        O = __builtin_amdgcn_mfma_f32_16x16x32_bf16(ra1, hb1, O, 0, 0, 0);
#pragma unroll
        for (int mt = 0; mt < 4; ++mt) H[mt] = H[mt] * gm[mt];
        const bf16x8 uv = __builtin_bit_cast(bf16x8, (v4u){cvtpk(U[0], U[1]), cvtpk(U[2], U[3]), vt.x, vt.y});
#pragma unroll
        for (int mt = 0; mt < 4; ++mt) H[mt] = __builtin_amdgcn_mfma_f32_16x16x32_bf16(bk[mt], uv, H[mt], 0, 0, 0);
        O = __builtin_amdgcn_mfma_f32_16x16x32_bf16(ar, uv, O, 0, 0, 0);
        hb0 = __builtin_bit_cast(bf16x8, (v4u){cvtpk(H[0][0], H[0][1]), cvtpk(H[0][2], H[0][3]), cvtpk(H[1][0], H[1][1]), cvtpk(H[1][2], H[1][3])});
        hb1 = __builtin_bit_cast(bf16x8, (v4u){cvtpk(H[2][0], H[2][1]), cvtpk(H[2][2], H[2][3]), cvtpk(H[3][0], H[3][1]), cvtpk(H[3][2], H[3][3])});
        bf16* op = orow + (size_t)n * 16 * 512;
#pragma unroll
        for (int j = 0; j < 4; ++j) op[(size_t)j * 512] = (bf16)(cvtpk(O[j], 0.f) & 0xffffu);
    }
    LDS_WAIT(); __builtin_amdgcn_s_barrier();
}
__device__ __forceinline__ void p6_assemble(Frame& F) {
    const int gw = F.vcu * NWAVES + F.wave, NGW = F.G * NWAVES;
    const bf16* Orw = (const bf16*)(F.ws + WS_ORW); const bf16* Uvg = (const bf16*)(F.ws + WS_UVG); const bf16* Uqg = (const bf16*)(F.ws + WS_UQG); const bf16* O0 = (const bf16*)(F.ws + WS_URK); const bf16* O1 = O0 + 512;
    const float* BON = (const float*)(F.ws + WS_BONUS); bf16* Y = (bf16*)(F.ws + WS_Y);
    const float lam = __expf(wave_sum(F.in[I_LQ1][F.lane] * F.in[I_LK1][F.lane])) - __expf(wave_sum(F.in[I_LQ2][F.lane] * F.in[I_LK2][F.lane])) + LAMBDA_INIT;
    const int c0 = 8 * F.lane;
    float lw[8], lb[8], muv[8], sw[8];
#pragma unroll
    for (int i = 0; i < 8; ++i) { lw[i] = F.in[I_LNW][c0 + i]; lb[i] = F.in[I_LNB][c0 + i]; muv[i] = F.in[I_MU][1024 + c0 + i]; sw[i] = F.in[I_SUBLN][(c0 + i) & 127] * (1.f - LAMBDA_INIT); }
    for (int m = gw; m < M; m += NGW) {
        const bool first = (m % T == 0);
        const v4u ow = *(const GAS v4u*)(Orw + (size_t)m * 512 + c0), vw = *(const GAS v4u*)(Uvg + (size_t)m * UP + c0), gw_ = *(const GAS v4u*)(Uvg + (size_t)m * UP + 512 + c0);
        v4u pw = {0u, 0u, 0u, 0u}; if (!first) pw = *(const GAS v4u*)(Uvg + (size_t)(m - 1) * UP + c0);
        float o[8], v[8], g[8];
#pragma unroll
        for (int i = 0; i < 4; ++i) { o[2 * i] = bflo(ow[i]); o[2 * i + 1] = bfhi(ow[i]); g[2 * i] = bflo(gw_[i]); g[2 * i + 1] = bfhi(gw_[i]);
            v[2 * i] = tshift(bflo(vw[i]), bflo(pw[i]), muv[2 * i]); v[2 * i + 1] = tshift(bfhi(vw[i]), bfhi(pw[i]), muv[2 * i + 1]); }
        float s = 0.f;
#pragma unroll
        for (int i = 0; i < 8; ++i) s += o[i];
        s += __shfl_xor(s, 1); s += __shfl_xor(s, 2); s += __shfl_xor(s, 4);
        const float mean = s * (1.f / 64.f); float q = 0.f;
#pragma unroll
        for (int i = 0; i < 8; ++i) { o[i] -= mean; q += o[i] * o[i]; }
        q += __shfl_xor(q, 1); q += __shfl_xor(q, 2); q += __shfl_xor(q, 4);
        const float rstd = 1.f / sqrtf(q * (1.f / 64.f) + GN_EPS), bon = BON[m * 8 + (F.lane >> 3)];
        float y[8];
#pragma unroll
        for (int i = 0; i < 8; ++i) y[i] = (o[i] * rstd * lw[i] + lb[i] + bon * v[i]) * siluf_(g[i]);
        v4u yo; yo.x = pk2(y[0], y[1]); yo.y = pk2(y[2], y[3]); yo.z = pk2(y[4], y[5]); yo.w = pk2(y[6], y[7]);
        *(GAS v4u*)(Y + (size_t)m * D + c0) = yo;
        const v4u a0 = *(const GAS v4u*)(O0 + (size_t)m * 1024 + c0), a1 = *(const GAS v4u*)(O1 + (size_t)m * 1024 + c0), dgw = *(const GAS v4u*)(Uqg + (size_t)m * 1024 + 512 + c0);
        float d[8]; float ms = 0.f;
#pragma unroll
        for (int i = 0; i < 4; ++i) { d[2 * i] = bflo(a0[i]) - lam * bflo(a1[i]); d[2 * i + 1] = bfhi(a0[i]) - lam * bfhi(a1[i]); g[2 * i] = bflo(dgw[i]); g[2 * i + 1] = bfhi(dgw[i]); }
#pragma unroll
        for (int i = 0; i < 8; ++i) ms += d[i] * d[i];
        ms += __shfl_xor(ms, 1); ms += __shfl_xor(ms, 2); ms += __shfl_xor(ms, 4); ms += __shfl_xor(ms, 8);
        const float rs = 1.f / sqrtf(ms * (1.f / 128.f) + SUBLN_EPS);
#pragma unroll
        for (int i = 0; i < 8; ++i) y[i] = d[i] * rs * sw[i] * siluf_(g[i]);
        yo.x = pk2(y[0], y[1]); yo.y = pk2(y[2], y[3]); yo.z = pk2(y[4], y[5]); yo.w = pk2(y[6], y[7]);
        *(GAS v4u*)(Y + (size_t)m * D + 512 + c0) = yo;
    }
}
__device__ __forceinline__ void p67_fused(Frame& F) {
    typedef float f32x4_ __attribute__((ext_vector_type(4)));
    const bf16* Orw = (const bf16*)(F.ws + WS_ORW); const bf16* Uvg = (const bf16*)(F.ws + WS_UVG); const bf16* Uqg = (const bf16*)(F.ws + WS_UQG); const bf16* O0 = (const bf16*)(F.ws + WS_URK); const bf16* O1 = O0 + 512;
    const float* BON = (const float*)(F.ws + WS_BONUS); const unsigned char* Wimg = (const unsigned char*)(F.ws + WS_WOUT);
    const float* x = F.in[I_X]; const float* gpost = F.in[I_GPOST]; const float* mod = (const float*)(F.ws + WS_MOD);
    const int lane = F.lane, w = F.wave, fr = lane & 15, fq = lane >> 4;
    const float lam = __expf(wave_sum(F.in[I_LQ1][lane] * F.in[I_LK1][lane])) - __expf(wave_sum(F.in[I_LQ2][lane] * F.in[I_LK2][lane])) + LAMBDA_INIT;
    LAS unsigned char* A = F.lds + RING_OFF;
    {
        const int unit = F.vcu; const int r0 = unit * 64, bb = r0 / T;
        {
            const int c0 = 8 * lane;
            float lw[8], lb[8], muv[8], sw[8];
#pragma unroll
            for (int i = 0; i < 8; ++i) { lw[i] = F.in[I_LNW][c0 + i]; lb[i] = F.in[I_LNB][c0 + i]; muv[i] = F.in[I_MU][1024 + c0 + i]; sw[i] = F.in[I_SUBLN][(c0 + i) & 127] * (1.f - LAMBDA_INIT); }
            LAS unsigned char* arow = A + ((lane >> 2) * 4 + (w >> 1)) * 1024 + ((lane & 3) * 16 + 8 * (w & 1)) * 16;
#pragma unroll 2
            for (int j = 0; j < 8; ++j) { const int m = r0 + 8 * w + j; const bool first = (m % T == 0);
                const v4u ow = *(const GAS v4u*)(Orw + (size_t)m * 512 + c0), vw = *(const GAS v4u*)(Uvg + (size_t)m * UP + c0), gw_ = *(const GAS v4u*)(Uvg + (size_t)m * UP + 512 + c0);
                v4u pw = {0u, 0u, 0u, 0u}; if (!first) pw = *(const GAS v4u*)(Uvg + (size_t)(m - 1) * UP + c0);
                const v4u a0 = *(const GAS v4u*)(O0 + (size_t)m * 1024 + c0), a1 = *(const GAS v4u*)(O1 + (size_t)m * 1024 + c0), dgw = *(const GAS v4u*)(Uqg + (size_t)m * 1024 + 512 + c0);
                const float bon = BON[m * 8 + (lane >> 3)];
                float o[8], v[8], g[8];
#pragma unroll
                for (int i = 0; i < 4; ++i) { o[2 * i] = bflo(ow[i]); o[2 * i + 1] = bfhi(ow[i]); g[2 * i] = bflo(gw_[i]); g[2 * i + 1] = bfhi(gw_[i]);
                    v[2 * i] = tshift(bflo(vw[i]), bflo(pw[i]), muv[2 * i]); v[2 * i + 1] = tshift(bfhi(vw[i]), bfhi(pw[i]), muv[2 * i + 1]); }
                float s = 0.f;
#pragma unroll
                for (int i = 0; i < 8; ++i) s += o[i];
                s = sum8_dpp(s);
                const float mean = s * (1.f / 64.f); float q = 0.f;
#pragma unroll
                for (int i = 0; i < 8; ++i) { o[i] -= mean; q += o[i] * o[i]; }
                q = sum8_dpp(q);
                const float rstd = __builtin_amdgcn_rsqf(q * (1.f / 64.f) + GN_EPS);
                float y[8];
#pragma unroll
                for (int i = 0; i < 8; ++i) y[i] = (o[i] * rstd * lw[i] + lb[i] + bon * v[i]) * silu_fast(g[i]);
                *(LAS v4u*)(arow + j * 16) = (v4u){cvtpk(y[0], y[1]), cvtpk(y[2], y[3]), cvtpk(y[4], y[5]), cvtpk(y[6], y[7])};
                float d[8]; float ms = 0.f;
#pragma unroll
                for (int i = 0; i < 4; ++i) { d[2 * i] = bflo(a0[i]) - lam * bflo(a1[i]); d[2 * i + 1] = bfhi(a0[i]) - lam * bfhi(a1[i]); g[2 * i] = bflo(dgw[i]); g[2 * i + 1] = bfhi(dgw[i]); }
#pragma unroll
                for (int i = 0; i < 8; ++i) ms += d[i] * d[i];
                ms = sum16_dpp(ms);
                const float rs = __builtin_amdgcn_rsqf(ms * (1.f / 128.f) + SUBLN_EPS);
#pragma unroll
                for (int i = 0; i < 8; ++i) y[i] = d[i] * rs * sw[i] * silu_fast(g[i]);
                *(LAS v4u*)(arow + 65536 + j * 16) = (v4u){cvtpk(y[0], y[1]), cvtpk(y[2], y[3]), cvtpk(y[4], y[5]), cvtpk(y[6], y[7])}; }
        }
        __syncthreads();
        f32x4_ acc[4][8];
#pragma unroll
        for (int rt = 0; rt < 4; ++rt)
#pragma unroll
            for (int nt = 0; nt < 8; ++nt) acc[rt][nt] = (f32x4_){0.f, 0.f, 0.f, 0.f};
        const unsigned char* bp = Wimg + ((size_t)(8 * w) * 32 * 64 + lane) * 16;
        bf16x8 b0_[8], b1_[8];
#pragma unroll
        for (int nt = 0; nt < 8; ++nt) b0_[nt] = *(const bf16x8*)(bp + nt * 32768);
#define P67_STEP(BC, BN, ks_) do { \
            if ((ks_) + 1 < 32) { _Pragma("unroll") for (int nt = 0; nt < 8; ++nt) BN[nt] = *(const bf16x8*)(bp + nt * 32768 + ((ks_) + 1) * 1024); } \
            bf16x8 af[4]; _Pragma("unroll") for (int rt = 0; rt < 4; ++rt) af[rt] = *(const LAS bf16x8*)(A + ((ks_) * 4 + rt) * 1024 + lane * 16); \
            _Pragma("unroll") for (int nt = 0; nt < 8; ++nt) _Pragma("unroll") for (int rt = 0; rt < 4; ++rt) acc[rt][nt] = __builtin_amdgcn_mfma_f32_16x16x32_bf16(BC[nt], af[rt], acc[rt][nt], 0, 0, 0); } while (0)
        for (int ks = 0; ks < 32; ks += 2) { P67_STEP(b0_, b1_, ks); P67_STEP(b1_, b0_, ks + 1); }
#undef P67_STEP
        float ss[4];
#pragma unroll
        for (int rt = 0; rt < 4; ++rt) { float s_ = 0.f;
#pragma unroll
            for (int nt = 0; nt < 8; ++nt) { const f32x4_ a_ = acc[rt][nt]; s_ += (a_[0] * a_[0] + a_[1] * a_[1]) + (a_[2] * a_[2] + a_[3] * a_[3]); }
            s_ += __shfl_xor(s_, 16); s_ += __shfl_xor(s_, 32); ss[rt] = s_; }
        __syncthreads();
        LAS float* P = (LAS float*)A;
        if (fq == 0) {
#pragma unroll
            for (int rt = 0; rt < 4; ++rt) P[(rt * 16 + fr) * 8 + w] = ss[rt]; }
        __syncthreads();
        const float* grow = mod + (size_t)bb * 3072 + 2048;
        float rstd[4];
#pragma unroll
        for (int rt = 0; rt < 4; ++rt) { const int row = rt * 16 + fr; const f32x4_ p0_ = *(const LAS f32x4_*)(P + row * 8), p1_ = *(const LAS f32x4_*)(P + row * 8 + 4);
            rstd[rt] = 1.f / sqrtf(((p0_[0] + p0_[1]) + (p0_[2] + p0_[3]) + (p1_[0] + p1_[1]) + (p1_[2] + p1_[3])) * (1.f / D) + RMS_EPS); }
        LAS unsigned char* tb = A + 4096 + w * 8448;
        const int rr = lane >> 5, c4 = lane & 31, colr = 128 * w + 4 * c4;
        const f32x4_ cfr = *(const f32x4_*)(grow + colr) * *(const f32x4_*)(gpost + colr);
#pragma unroll
        for (int rt = 0; rt < 4; ++rt) {
            f32x4_ xr[8];
#pragma unroll
            for (int k = 0; k < 8; ++k) xr[k] = __builtin_nontemporal_load((const f32x4_*)(x + (size_t)(r0 + rt * 16 + 2 * k + rr) * D + colr));
#pragma unroll
            for (int nt = 0; nt < 8; ++nt) *(LAS f32x4_*)(tb + fr * 528 + (16 * nt + 4 * fq) * 4) = acc[rt][nt] * rstd[rt];
            LDS_WAIT(); asm volatile("" ::: "memory");
#pragma unroll
            for (int k = 0; k < 8; ++k) { const f32x4_ t_ = *(const LAS f32x4_*)(tb + (2 * k + rr) * 528 + c4 * 16);
                *(f32x4_*)(F.out + (size_t)(r0 + rt * 16 + 2 * k + rr) * D + colr) = xr[k] + t_ * cfr; }
            LDS_WAIT(); asm volatile("" ::: "memory");
        }
        __syncthreads();
    }
}
__device__ __forceinline__ void nan_rows_f32(Frame& F, float* out) {
    const int gw = F.vcu * NWAVES + F.wave, NGW = F.G * NWAVES; const float q = __builtin_nanf("");
    for (int m = gw; m < M; m += NGW) { GAS f32x4* o = (GAS f32x4*)(out + (size_t)m * D) + F.lane;
#pragma unroll
        for (int j = 0; j < 4; ++j) o[64 * j] = (f32x4){q, q, q, q}; }
}
__device__ __forceinline__ void wrong_grid_word(Frame& F) {
    if (blockIdx.x == 0 && F.tid == 0) { unsigned expect = 0u; __hip_atomic_compare_exchange_strong((unsigned*)(F.ctl + CW_CODE), &expect, 0x7f0u, __ATOMIC_RELAXED, __ATOMIC_RELAXED, __HIP_MEMORY_SCOPE_AGENT);
        __hip_atomic_store(F.ctl + CW_TMO, 1u, RLX_AGENT); }
}

struct Args { const float* in[23]; float* out; unsigned char* ws; int ph_lo, ph_hi, li, pad; };
__global__ void __launch_bounds__(NWAVES * 64, 2) skel_fwd(Args args) {
    extern __shared__ __attribute__((aligned(16))) unsigned char lds[];
    Frame F;
    F.lds = (LAS unsigned char*)lds;
    F.MISC = (volatile LAS unsigned*)(F.lds + MISC_OFF);
    F.tid = threadIdx.x; F.lane = F.tid & 63; F.wave = __builtin_amdgcn_readfirstlane(F.tid >> 6);
    F.G = gridDim.x; { const int bx = blockIdx.x; F.vcu = (F.G % 8 == 0) ? (bx % 8) * (F.G / 8) + bx / 8 : bx; }
#define GRID_BAR(seam) do { if (N_LAUNCHES == PER_PHASE) { if (F.tid == 0) __hip_atomic_store(F.ctl + CW_TMO, 0xBADBA0u | (unsigned)(seam), RLX_AGENT); } \
    else { xcd_barrier(bar); } } while (0)
    unsigned char* ws = args.ws; F.ws = ws;
    F.ctl = (gu32*)(ws + WS_CTL);
#pragma unroll
    for (int i = 0; i < 23; ++i) F.in[i] = args.in[i];
    F.out = args.out;
    for (int u = F.tid; u < (LDS_BYTES - LDSCTL_OFF) / 4; u += NWAVES * 64) ((LAS unsigned*)(F.lds + LDSCTL_OFF))[u] = 0u;
    __syncthreads();
    XcdBarrier bar; bar.bar = (unsigned*)(F.ctl + CW_BAR); bar.x = 0; bar.st = nullptr;
    if (N_LAUNCHES != PER_PHASE) bar = xcd_barrier_post((unsigned*)(F.ctl + CW_BAR), F.MISC + 8);

    const int lo = args.ph_lo, hi = args.ph_hi;
#define IN(k) (lo <= (k) && (k) < hi)
#define BOTH(k) (IN(k) && IN((k) + 1))

#ifndef PROBE_PHASE
#define PROBE_PHASE -1
#endif
#ifndef PROBE_REPS
#define PROBE_REPS 2
#endif
#define REPS(k) ((k) == PROBE_PHASE ? PROBE_REPS : 1)
    if (IN(0)) { for (int rep = 0; rep < REPS(0); ++rep) p0_prologue(F); if (BOTH(0)) GRID_BAR(0); }
    if (IN(1)) { for (int rep = 0; rep < REPS(1); ++rep) p1_rows(F); if (BOTH(1)) GRID_BAR(1); }
    if (PROBE_PHASE == 9) { for (int rep = 0; rep < 16; ++rep) GRID_BAR(9); }
    if (IN(2)) {
        pg8::Gemm g{(const pg8::bf16_t*)(ws + WS_XN), (const pg8::bf16_t*)(ws + WS_WIN), M, NMAIN, D}; pg8::StaticOrder S; S.init(M, NMAIN, F.G, (int)blockIdx.x);
        pg8::EpiU E{(pg8::bf16_t*)(ws + WS_URK), (pg8::bf16_t*)(ws + WS_UVG), (pg8::bf16_t*)(ws + WS_UQG), (pg8::bf16_t*)(ws + WS_KIMG), (pg8::bf16_t*)(ws + WS_VIMG), attn_body::C2, T};
        for (int rep = 0; rep < REPS(2); ++rep) pg8::gemm_phase<pg8::EpiU, pg8::StaticOrder, PG8_ALIGN, PG8_SP2>(F.lds + RING_OFF, g, S, E);
        for (int rep = 0; rep < REPS(8); ++rep) p2_lora(F);
        if (BOTH(2)) GRID_BAR(2);
    }
    if (IN(3)) { for (int rep = 0; rep < REPS(3); ++rep) p3_prep(F); if (BOTH(3)) GRID_BAR(3); }
    if (IN(4)) {
        for (int rep = 0; rep < REPS(4); ++rep) p4_scan(F);
        const attn_body::AttnTensors AT{(const attn_body::bf16*)(ws + WS_UQG), (const attn_body::bf16*)(ws + WS_KIMG), (const attn_body::bf16*)(ws + WS_VIMG), (attn_body::bf16*)(ws + WS_URK), (attn_body::bf16*)(ws + WS_URK) + 512};
        if (F.G == 256) attn_body::attn_phase_queue((char*)lds + RING_OFF, AT, (unsigned*)(F.ctl + CW_QUEUE), (int)(xb_xcc_id() & 7u), F.MISC + 16);
        if (PROBE_PHASE == 5) { GRID_BAR(5); attn_body::attn_phase_queue((char*)lds + RING_OFF, AT, (unsigned*)(F.ctl + CW_QUEUE + 512 + 64 * ((int)blockIdx.x & 7)), (int)blockIdx.x & 7, F.MISC + 16); }
        if (BOTH(4)) GRID_BAR(4);
    }
    if (IN(6)) { }
    if (IN(7)) { if (F.G == 256) p67_fused(F); else { nan_rows_f32(F, F.out); wrong_grid_word(F); } }
#undef IN
#undef BOTH
}

extern "C" void kernel_launch(void* const* d_in, const int* in_sizes, int n_in, void* d_out, int out_size, void* d_ws, size_t ws_size, hipStream_t stream) {
    static int grid = 0;
    if (grid == 0) {
        if (n_in != 23 || in_sizes[0] != M * D || out_size != M * D || ws_size < WS_END) { fprintf(stderr, "kernel_launch: built for 23 inputs, x and out of %d floats, >= %zu bytes of workspace; got n_in %d, in0 %d, out %d, ws %zu; nothing launched\n", M * D, (size_t)WS_END, n_in, n_in > 0 ? in_sizes[0] : -1, out_size, ws_size); grid = -1; return; }
        int dev = 0, cus = 0, per_cu = 0;
        if (hipGetDevice(&dev) != hipSuccess || hipDeviceGetAttribute(&cus, hipDeviceAttributeMultiprocessorCount, dev) != hipSuccess) { fprintf(stderr, "kernel_launch: hipGetDevice / hipDeviceGetAttribute failed; nothing launched\n"); grid = -1; return; }
        if (hipFuncSetAttribute((const void*)skel_fwd, hipFuncAttributeMaxDynamicSharedMemorySize, LDS_BYTES) != hipSuccess) { fprintf(stderr, "kernel_launch: hipFuncSetAttribute failed\n"); grid = -1; return; }
        if (hipOccupancyMaxActiveBlocksPerMultiprocessor(&per_cu, (const void*)skel_fwd, NWAVES * 64, LDS_BYTES) != hipSuccess || per_cu < 1)
            fprintf(stderr, "kernel_launch: note: the occupancy query reports %d workgroups per CU\n", per_cu);
        (void)hipGetLastError();
        grid = cus;
        if (grid != 256) fprintf(stderr, "kernel_launch: launching %d workgroups; the fused phases need exactly 256\n", grid);
    }
    if (grid < 0) return;
    if (hipMemsetAsync((char*)d_ws + WS_CTL, 0, CTL_ZERO_BYTES, stream) != hipSuccess) { fprintf(stderr, "kernel_launch: hipMemsetAsync of the control words failed; nothing launched\n"); return; }
    Args a{};
    for (int i = 0; i < 23; ++i) a.in[i] = (const float*)d_in[i];
    a.out = (float*)d_out; a.ws = (unsigned char*)d_ws;
    for (int li = 0; li < N_LAUNCHES; ++li) {
        a.ph_lo = (N_LAUNCHES == PER_PHASE) ? li : 0; a.ph_hi = (N_LAUNCHES == PER_PHASE) ? li + 1 : PER_PHASE; a.li = li;
        hipLaunchKernelGGL(skel_fwd, dim3(grid), dim3(NWAVES * 64), LDS_BYTES, stream, a);
        const hipError_t le = hipPeekAtLastError();
        if (le != hipSuccess) { fprintf(stderr, "kernel_launch: launch %d failed: %s\n", li, hipGetErrorName(le)); break; }
    }
}
```

```cpp
#include <hip/hip_runtime.h>
#include <cstdio>
#include <cstdint>
namespace pg8 {
#define PG8_LAS __attribute__((address_space(3)))
typedef unsigned short bf16_t;
typedef short bf16x8 __attribute__((ext_vector_type(8)));
typedef float f32x4 __attribute__((ext_vector_type(4)));
typedef unsigned u32x4 __attribute__((ext_vector_type(4)));
constexpr int BM = 256, BK = 64, HALF = 128, HTB = HALF * BK * 2  , STAGE_BYTES = 8 * HTB, NXCD = 8, WGM = 8;

__host__ __device__ __forceinline__ int lds_byte(int r, int c) { const int st = (r >> 4) * 2 + (c >> 5), rr = r & 15, cc = c & 31, ob = rr * 64 + cc * 2; return st * 1024 + (ob ^ (((ob >> 9) & 1) << 5)); }
__host__ __device__ __forceinline__ void stage_rc(int b, int& R, int& C) { const int st = b / 1024, sb = b % 1024, swz = sb ^ (((sb >> 9) & 1) << 5); R = (st >> 1) * 16 + swz / 64; C = (st & 1) * 32 + (swz % 64) / 2; }
__host__ __device__ __forceinline__ int perm32(int rho) { const int n = rho >> 4, i = rho & 15; return 8 * (i >> 2) + 4 * n + (i & 3); }

struct Unit { int pm, pn; };
struct Gemm { const bf16_t* A; const bf16_t* Bt; int M, N, K; };

struct StaticOrder {
    int nM, nN, nwg, G, c;
    __host__ __device__ void init(int M, int N, int G_, int c_) { nM = M / BM; nN = N / BM; nwg = nM * nN; G = G_; c = c_; }
    __host__ __device__ bool next(int i, Unit& u) const {
        const long L = (long)i * G + c; if (L >= nwg) return false;
        int wgid = (int)L; { const int q = nwg / NXCD, r = nwg % NXCD, xcd = wgid % NXCD, off = wgid / NXCD; wgid = (xcd < r ? xcd * (q + 1) : r * (q + 1) + (xcd - r) * q) + off; }
        const int nig = WGM * nN, gid = wgid / nig, fm = gid * WGM, gsz = (nM - fm) < WGM ? (nM - fm) : WGM;
        u.pm = fm + ((wgid % nig) % gsz); u.pn = (wgid % nig) / gsz; return true;
    }
    __device__ __forceinline__ void a_ready(const Unit&) const {}
    __device__ __forceinline__ void done(const Unit&) const {}
};

__device__ __forceinline__ unsigned cvt_pk_bf16(float lo, float hi) { unsigned r; asm volatile("v_cvt_pk_bf16_f32 %0, %1, %2" : "=v"(r) : "v"(lo), "v"(hi)); return r; }
typedef float f32x2 __attribute__((ext_vector_type(2)));
struct EpiU {
    static constexpr bool PERM = true, AFTER_DRAIN = false;
    bf16_t* Urk; bf16_t* Uvg; bf16_t* Uqg; bf16_t* Kimg; bf16_t* Vimg; float qscale; int seq;
    __device__ __forceinline__ void operator()(const f32x4 (&acc)[2][2][4][2], const Unit& u, int wr, int wc, int fr, int fq) const {
        const int row0 = u.pm * BM + wr * 64 + fr;
        const float sc = (u.pn == 8 || u.pn == 9) ? qscale : 1.f;
        const bool img = (u.pn >= 10 && u.pn <= 13);
        bf16_t* base = (u.pn < 4) ? (Urk + u.pn * BM) : (u.pn < 8 ? (Uvg + (u.pn - 4) * BM) : (u.pn < 10 ? (Uqg + (u.pn - 8) * BM) : (Uqg + 512 + (u.pn - 14) * BM)));
        const int col0 = wc * 32 + 8 * fq;
#pragma unroll
        for (int ai = 0; ai < 2; ++ai)
#pragma unroll
            for (int m = 0; m < 4; ++m) { const int r = row0 + ai * HALF + m * 16; bf16_t* rowp = base + (size_t)r * 1024 + col0;
                const int bb = r / seq, t = r % seq;
#pragma unroll
                for (int bj = 0; bj < 2; ++bj) { f32x4 v0 = acc[ai][bj][m][0] * sc, v1 = acc[ai][bj][m][1] * sc;
                    u32x4 w; w.x = cvt_pk_bf16(v0[0], v0[1]); w.y = cvt_pk_bf16(v0[2], v0[3]); w.z = cvt_pk_bf16(v1[0], v1[1]); w.w = cvt_pk_bf16(v1[2], v1[3]);
                    if (!img) *(u32x4*)(rowp + bj * HALF) = w;
                    else if (u.pn < 12) { const int hh = 4 * (u.pn - 10) + 2 * bj + (wc >> 1), dch = 4 * (wc & 1) + fq;
                        *(u32x4*)((char*)Kimg + ((size_t)((bb * 8 + hh) * (seq / 64) + (t >> 6)) * 8192 + dch * 1024 + (t & 63) * 16)) = w; }
                    else { const int h = 2 * (u.pn - 12) + bj;
                        *(u32x4*)((char*)Vimg + ((size_t)((bb * 4 + h) * (seq / 64) + (t >> 6)) * 16384 + (wc * 4 + ((t & 63) >> 4)) * 1024 + ((t & 15) * 4 + fq) * 16)) = w; } } }
    }
};

struct PanelStats {
    unsigned* xbuf;
    unsigned* cnt;
    unsigned* tmo;
    int ntn; float eps;
    bool rms;
    unsigned code;
    __device__ __forceinline__ bool run(const f32x4 (&v)[2][2][4][2], const Unit& u, int wr, int wc, int fr, int fq, PG8_LAS unsigned char* lds, int wid, int lane) const {
        typedef float f32x2v __attribute__((ext_vector_type(2)));
        PG8_LAS f32x2v* P = (PG8_LAS f32x2v*)lds;
        PG8_LAS f32x2v* S = (PG8_LAS f32x2v*)(lds + 8192);
        PG8_LAS unsigned* flag = (PG8_LAS unsigned*)(lds + 8192 + 2048);
#pragma unroll
        for (int ai = 0; ai < 2; ++ai)
#pragma unroll
            for (int m = 0; m < 4; ++m) {
                float s = 0.f;
#pragma unroll
                for (int bj = 0; bj < 2; ++bj)
#pragma unroll
                    for (int n = 0; n < 2; ++n) { const f32x4 x = v[ai][bj][m][n]; s += (x[0] + x[1]) + (x[2] + x[3]); }
                s += __shfl_xor(s, 16); s += __shfl_xor(s, 32);
                const float mw = s * (1.0f / 64.0f); float q = 0.f;
#pragma unroll
                for (int bj = 0; bj < 2; ++bj)
#pragma unroll
                    for (int n = 0; n < 2; ++n) { const f32x4 d = v[ai][bj][m][n] - mw; q += (d[0] * d[0] + d[1] * d[1]) + (d[2] * d[2] + d[3] * d[3]); }
                q += __shfl_xor(q, 16); q += __shfl_xor(q, 32);
                if (fq == 0) P[(ai * HALF + wr * 64 + m * 16 + fr) * 4 + wc] = (f32x2v){mw, q};
            }
        asm volatile("s_waitcnt lgkmcnt(0)" ::: "memory"); __builtin_amdgcn_s_barrier(); asm volatile("" ::: "memory");
#if defined(BROKEN_EXCHANGE_NO_WAIT)
#warning BROKEN CONTROL BUILD: the row-statistics exchange does not wait; results are wrong by design
        if (blockIdx.x >= 64) { const long long t0_ = clock64(); while (clock64() - t0_ < 60000) __builtin_amdgcn_s_sleep(8); }
#endif
        const int row = wid * 32 + (lane & 31);
        if (lane < 32) {
            const f32x2v a = P[row * 4 + 0], b = P[row * 4 + 1], c = P[row * 4 + 2], d = P[row * 4 + 3];
            const float mt = (a.x + b.x + c.x + d.x) * 0.25f;
            const float da = a.x - mt, db = b.x - mt, dc = c.x - mt, dd = d.x - mt;
            const float m2 = (a.y + b.y) + (c.y + d.y) + 64.0f * ((da * da + db * db) + (dc * dc + dd * dd));
            unsigned long long* slot = (unsigned long long*)xbuf + ((size_t)(u.pm * BM + row) * 4 + u.pn);
            __hip_atomic_store(slot, ((unsigned long long)__float_as_uint(m2) << 32) | __float_as_uint(mt), __ATOMIC_RELAXED, __HIP_MEMORY_SCOPE_AGENT);
        }
        asm volatile("s_waitcnt vmcnt(0)" ::: "memory");
        if (lane == 0) __hip_atomic_fetch_add(cnt + 64 * u.pm, 1u, __ATOMIC_RELAXED, __HIP_MEMORY_SCOPE_AGENT);
        if (wid == 0) {
            bool dead = false; const unsigned long long t0 = __builtin_amdgcn_s_memrealtime(); const unsigned want = 8u * (unsigned)ntn;
            for (;;) {
#if defined(BROKEN_EXCHANGE_NO_WAIT)
                break;
#endif
                if ((unsigned)__builtin_amdgcn_readfirstlane(__hip_atomic_load(cnt + 64 * u.pm, __ATOMIC_RELAXED, __HIP_MEMORY_SCOPE_AGENT)) >= want) break;
                if (__builtin_amdgcn_s_memrealtime() - t0 > 2000000ull) {
                    if (lane == 0) { unsigned expect = 0u; __hip_atomic_compare_exchange_strong(tmo + 1, &expect, code | (unsigned)(u.pm & 0xff), __ATOMIC_RELAXED, __ATOMIC_RELAXED, __HIP_MEMORY_SCOPE_AGENT);
                                     __hip_atomic_store(tmo, 1u, __ATOMIC_RELAXED, __HIP_MEMORY_SCOPE_AGENT); }
                    dead = true; break; }
                __builtin_amdgcn_s_sleep(2);
            }
            __builtin_amdgcn_fence(__ATOMIC_ACQUIRE, "agent");
            if (lane == 0) flag[0] = dead ? 1u : 0u;
        }
        asm volatile("s_waitcnt vmcnt(0) lgkmcnt(0)" ::: "memory"); __builtin_amdgcn_s_barrier(); asm volatile("" ::: "memory");
        const bool bad = flag[0] != 0u;
        if (lane < 32) {
            const unsigned long long* slot = (const unsigned long long*)xbuf + (size_t)(u.pm * BM + row) * 4; float mt[4], m2[4]; float ms = 0.f;
#pragma unroll
            for (int t = 0; t < 4; ++t) { if (t < ntn) { const unsigned long long w = __hip_atomic_load(slot + t, __ATOMIC_RELAXED, __HIP_MEMORY_SCOPE_AGENT); mt[t] = __uint_as_float((unsigned)w); m2[t] = __uint_as_float((unsigned)(w >> 32)); } else { mt[t] = 0.f; m2[t] = 0.f; } ms += mt[t]; }
            const float mean = ms / (float)ntn; float q = 0.f;
#pragma unroll
            for (int t = 0; t < 4; ++t) if (t < ntn) { const float dm = mt[t] - mean; q += m2[t] + 256.0f * dm * dm; }
            S[row] = (f32x2v){mean, 1.0f / sqrtf(q / (256.0f * (float)ntn) + (rms ? mean * mean : 0.f) + eps)};
        }
        asm volatile("s_waitcnt lgkmcnt(0)" ::: "memory"); __builtin_amdgcn_s_barrier(); asm volatile("" ::: "memory");
        return bad;
    }
};
struct EpiRmsRes {
    static constexpr bool PERM = false, AFTER_DRAIN = true;
    const float* base; float* out; int ldc; const float* gate; int gate_pitch; int rows_per_batch; const float* gpost; PanelStats st; unsigned poison;
    __device__ __forceinline__ void fused(f32x4 (&acc)[2][2][4][2], const Unit& u, int wr, int wc, int fr, int fq, PG8_LAS unsigned char* lds, int wid, int lane) const {
        typedef float f32x2v __attribute__((ext_vector_type(2)));
        const PG8_LAS f32x2v* S = (const PG8_LAS f32x2v*)(lds + 8192);
        const int col0 = u.pn * BM + wc * 32 + 4 * fq;
        const float* grow = gate + (size_t)((u.pm * BM) / rows_per_batch) * gate_pitch;
        f32x4 cf[2][2];
#pragma unroll
        for (int bj = 0; bj < 2; ++bj)
#pragma unroll
            for (int n = 0; n < 2; ++n) cf[bj][n] = *(const f32x4*)(grow + col0 + bj * HALF + n * 16) * *(const f32x4*)(gpost + col0 + bj * HALF + n * 16);
        f32x4 pre[2][2][2];
#pragma unroll
        for (int m = 0; m < 2; ++m) { const size_t off = (size_t)(u.pm * BM + wr * 64 + m * 16 + fr) * ldc + col0;
#pragma unroll
            for (int bj = 0; bj < 2; ++bj)
#pragma unroll
                for (int n = 0; n < 2; ++n) pre[m][bj][n] = *(const f32x4*)(base + off + bj * HALF + n * 16); }
        const bool bad = st.run(acc, u, wr, wc, fr, fq, lds, wid, lane) || poison != 0u;
        const float qnan = __builtin_nanf("");
#pragma unroll
        for (int ai = 0; ai < 2; ++ai)
#pragma unroll
            for (int m = 0; m < 4; ++m) { const int r = ai * HALF + wr * 64 + m * 16 + fr; const f32x2v sr = S[r]; const size_t off = (size_t)(u.pm * BM + r) * ldc + col0;
#pragma unroll
                for (int bj = 0; bj < 2; ++bj)
#pragma unroll
                    for (int n = 0; n < 2; ++n) { const f32x4 bs = (ai == 0 && m < 2) ? pre[m & 1][bj][n] : *(const f32x4*)(base + off + bj * HALF + n * 16); f32x4 o = bs + acc[ai][bj][m][n] * sr.y * cf[bj][n];
                        if (bad) o = (f32x4){qnan, qnan, qnan, qnan}; *(f32x4*)(out + off + bj * HALF + n * 16) = o; }
                if (m & 1) asm volatile("" ::: "memory"); }
    }
};

template <class Epi, class Sched, bool ALIGN_EPI = false, bool SP2 = false>
__device__ __forceinline__ void gemm_phase(PG8_LAS unsigned char* lds, const Gemm g, const Sched& S, const Epi& E) {
    const int tid = threadIdx.x, wid = __builtin_amdgcn_readfirstlane(tid >> 6), lane = tid & 63, wr = wid >> 2, wc = wid & 3, fr = lane & 15, fq = lane >> 4;
    const int K = g.K, nt = K / BK;
    unsigned voffA[2], voffB[2];
#pragma unroll
    for (int i = 0; i < 2; ++i) { int R, C; stage_rc(tid * 16 + i * 8192, R, C); const int Rb = Epi::PERM ? ((R & ~31) + perm32(R & 31)) : R;
        voffA[i] = (unsigned)(R * K + C) * 2u; voffB[i] = (unsigned)(Rb * K + C) * 2u; }
    const size_t kstep = (size_t)(BK * 2);
    const size_t hstep = (size_t)HALF * K * 2;
    const size_t tstep = 2 * hstep;
    const unsigned ldsw = (unsigned)wid * 1024u;
    const int aoff = lds_byte(wr * 64 + fr, fq * 8), boff = lds_byte(wc * 32 + fr, fq * 8);
#define PG8_SA(b, h) (((b) * 2 + (h)) * HTB)
#define PG8_SB(b, h) ((4 + (b) * 2 + (h)) * HTB)
#define PG8_STAGE(bufoff, gbase, voff) do { _Pragma("unroll") for (int _i = 0; _i < 2; ++_i) \
        __builtin_amdgcn_global_load_lds((const unsigned*)((const char*)(gbase) + (voff)[_i]), (PG8_LAS unsigned*)(lds + (bufoff) + ldsw + _i * 8192), 16, 0, 0); } while (0)
#define PG8_LDA(dst, b, h) do { _Pragma("unroll") for (int m = 0; m < 4; ++m) _Pragma("unroll") for (int k = 0; k < 2; ++k) dst[m][k] = *(const PG8_LAS bf16x8*)(lds + PG8_SA(b, h) + aoff + m * 2048 + k * 1024); } while (0)
#define PG8_LDB(dst, b, h) do { _Pragma("unroll") for (int n = 0; n < 2; ++n) _Pragma("unroll") for (int k = 0; k < 2; ++k) dst[n][k] = *(const PG8_LAS bf16x8*)(lds + PG8_SB(b, h) + boff + n * 2048 + k * 1024); } while (0)
#define PG8_MMA(ai, bj, At, Bt) do { __builtin_amdgcn_s_setprio(1); _Pragma("unroll") for (int m = 0; m < 4; ++m) _Pragma("unroll") for (int n = 0; n < 2; ++n) _Pragma("unroll") for (int k = 0; k < 2; ++k) \
        acc[ai][bj][m][n] = __builtin_amdgcn_mfma_f32_16x16x32_bf16(Bt[n][k], At[m][k], acc[ai][bj][m][n], 0, 0, 0); __builtin_amdgcn_s_setprio(0); } while (0)
#define PG8_WAIT_V(n) asm volatile("s_waitcnt vmcnt(" #n ")" ::: "memory")
#define PG8_WAIT_L(n) asm volatile("s_waitcnt lgkmcnt(" #n ")" ::: "memory")
#define PG8_BAR __builtin_amdgcn_s_barrier()
#define PG8_SCHED __builtin_amdgcn_sched_barrier(0)
    Unit cur, nxt; int ui = 0;
    if (!S.next(0, cur)) return;
    f32x4 acc[2][2][4][2];
#pragma unroll
    for (int a = 0; a < 2; ++a)
#pragma unroll
        for (int b = 0; b < 2; ++b)
#pragma unroll
            for (int m = 0; m < 4; ++m)
#pragma unroll
                for (int n = 0; n < 2; ++n) acc[a][b][m][n] = (f32x4){0.f, 0.f, 0.f, 0.f};
    bf16x8 At[4][2], B0[2][2], B1[2][2];
    const char* cA = (const char*)g.A + (size_t)cur.pm * tstep; const char* cB = (const char*)g.Bt + (size_t)cur.pn * tstep;
    S.a_ready(cur);
    if constexpr (SP2) {
        PG8_STAGE(PG8_SB(0, 0), cB, voffB); PG8_STAGE(PG8_SB(0, 1), cB + hstep, voffB); PG8_STAGE(PG8_SA(0, 0), cA, voffA); PG8_STAGE(PG8_SA(0, 1), cA + hstep, voffA);
        if (wr == 1) PG8_BAR;
        PG8_WAIT_V(2); PG8_BAR;
        PG8_STAGE(PG8_SB(1, 0), cB + kstep, voffB); PG8_STAGE(PG8_SA(1, 0), cA + kstep, voffA); PG8_STAGE(PG8_SB(1, 1), cB + hstep + kstep, voffB);
        PG8_WAIT_V(6); PG8_BAR;
    } else {
        PG8_STAGE(PG8_SB(0, 0), cB, voffB); PG8_STAGE(PG8_SA(0, 0), cA, voffA); PG8_STAGE(PG8_SB(0, 1), cB + hstep, voffB); PG8_STAGE(PG8_SA(0, 1), cA + hstep, voffA);
        if (wr == 1) PG8_BAR;
        PG8_WAIT_V(4); PG8_BAR;
        PG8_STAGE(PG8_SB(1, 0), cB + kstep, voffB); PG8_STAGE(PG8_SA(1, 0), cA + kstep, voffA); PG8_STAGE(PG8_SB(1, 1), cB + hstep + kstep, voffB);
        PG8_WAIT_V(6); PG8_BAR;
    }
    for (;;) {
        const bool has_next = S.next(ui + 1, nxt);
        const char* nA = has_next ? (const char*)g.A + (size_t)nxt.pm * tstep : cA; const char* nB = has_next ? (const char*)g.Bt + (size_t)nxt.pn * tstep : cB;
        for (int t = 0; t < nt; t += 2) {
            const bool last = (t == nt - 2);
            const char* a1 = cA + (size_t)(t + 1) * kstep;
            const char* a2 = last ? nA : cA + (size_t)(t + 2) * kstep; const char* b2 = last ? nB : cB + (size_t)(t + 2) * kstep;
            const char* a3 = a2 + kstep; const char* b3 = b2 + kstep;
            if (last && has_next) S.a_ready(nxt);
            if constexpr (SP2) {
            PG8_LDB(B0, 0, 0); PG8_LDB(B1, 0, 1); PG8_SCHED; PG8_LDA(At, 0, 0); PG8_STAGE(PG8_SA(1, 1), a1 + hstep, voffA);
            PG8_WAIT_V(8); PG8_WAIT_L(0); PG8_BAR; PG8_MMA(0, 0, At, B0); PG8_MMA(0, 1, At, B1); PG8_BAR; PG8_SCHED;
            PG8_LDA(At, 0, 1); PG8_STAGE(PG8_SB(0, 0), b2, voffB); PG8_STAGE(PG8_SB(0, 1), b2 + hstep, voffB); PG8_STAGE(PG8_SA(0, 0), a2, voffA);
            PG8_WAIT_V(8); PG8_WAIT_L(0); PG8_BAR; PG8_MMA(1, 0, At, B0); PG8_MMA(1, 1, At, B1); PG8_BAR; PG8_SCHED;
            PG8_LDB(B0, 1, 0); PG8_LDB(B1, 1, 1); PG8_SCHED; PG8_LDA(At, 1, 0); PG8_STAGE(PG8_SA(0, 1), a2 + hstep, voffA);
            PG8_WAIT_V(8); PG8_WAIT_L(0); PG8_BAR; PG8_MMA(0, 0, At, B0); PG8_MMA(0, 1, At, B1); PG8_BAR; PG8_SCHED;
            PG8_LDA(At, 1, 1); PG8_STAGE(PG8_SB(1, 0), b3, voffB); PG8_STAGE(PG8_SB(1, 1), b3 + hstep, voffB); PG8_STAGE(PG8_SA(1, 0), a3, voffA);
            PG8_WAIT_V(8); PG8_WAIT_L(0); PG8_BAR; PG8_MMA(1, 0, At, B0); PG8_MMA(1, 1, At, B1); PG8_BAR; PG8_SCHED;
            } else {
            PG8_LDB(B0, 0, 0); PG8_SCHED; PG8_LDA(At, 0, 0); PG8_STAGE(PG8_SA(1, 1), a1 + hstep, voffA);
            PG8_WAIT_L(8); PG8_BAR; PG8_WAIT_L(0); PG8_MMA(0, 0, At, B0); PG8_BAR; PG8_SCHED;
            PG8_LDB(B1, 0, 1); PG8_STAGE(PG8_SB(0, 0), b2, voffB);
            PG8_BAR; PG8_WAIT_L(0); PG8_MMA(0, 1, At, B1); PG8_BAR;
            PG8_LDA(At, 0, 1); PG8_STAGE(PG8_SA(0, 0), a2, voffA);
            PG8_BAR; PG8_WAIT_L(0); PG8_MMA(1, 0, At, B0); PG8_BAR; PG8_SCHED;
            PG8_STAGE(PG8_SB(0, 1), b2 + hstep, voffB);
            PG8_WAIT_V(6); PG8_BAR; PG8_MMA(1, 1, At, B1); PG8_BAR;
            PG8_LDB(B0, 1, 0); PG8_SCHED; PG8_LDA(At, 1, 0); PG8_STAGE(PG8_SA(0, 1), a2 + hstep, voffA);
            PG8_WAIT_L(8); PG8_BAR; PG8_WAIT_L(0); PG8_MMA(0, 0, At, B0); PG8_BAR; PG8_SCHED;
            PG8_LDB(B1, 1, 1); PG8_STAGE(PG8_SB(1, 0), b3, voffB);
            PG8_BAR; PG8_WAIT_L(0); PG8_MMA(0, 1, At, B1); PG8_BAR;
            PG8_LDA(At, 1, 1); PG8_STAGE(PG8_SA(1, 0), a3, voffA);
            PG8_BAR; PG8_WAIT_L(0); PG8_MMA(1, 0, At, B0); PG8_BAR; PG8_SCHED;
            PG8_STAGE(PG8_SB(1, 1), b3 + hstep, voffB);
            PG8_WAIT_V(6); PG8_BAR; PG8_MMA(1, 1, At, B1); PG8_BAR;
            }
        }
        if constexpr (ALIGN_EPI) { if (wr == 0) PG8_BAR; }
        if constexpr (!Epi::AFTER_DRAIN) { E(acc, cur, wr, wc, fr, fq); S.done(cur); }
        if (!has_next) break;
#pragma unroll
        for (int a = 0; a < 2; ++a)
#pragma unroll
            for (int b = 0; b < 2; ++b)
#pragma unroll
                for (int m = 0; m < 4; ++m)
#pragma unroll
                    for (int n = 0; n < 2; ++n) acc[a][b][m][n] = (f32x4){0.f, 0.f, 0.f, 0.f};
        cur = nxt; cA = nA; cB = nB; ++ui;
        if constexpr (ALIGN_EPI) { if (wr == 1) PG8_BAR; }
    }
    PG8_WAIT_V(0);
    if constexpr (!ALIGN_EPI) { if (wr == 0) PG8_BAR; }
    PG8_BAR;
    if constexpr (Epi::AFTER_DRAIN) { E.fused(acc, cur, wr, wc, fr, fq, lds, wid, lane); S.done(cur); }
#undef PG8_SA
#undef PG8_SB
#undef PG8_STAGE
#undef PG8_LDA
#undef PG8_LDB
#undef PG8_MMA
#undef PG8_WAIT_V
#undef PG8_WAIT_L
#undef PG8_BAR
#undef PG8_SCHED
}
}

#ifndef PG8_SP2
#define PG8_SP2 true
#endif
#ifndef PG8_ALIGN
#define PG8_ALIGN true
#endif
#include <hip/hip_bf16.h>
#include <cmath>
namespace attn_body {
using bf16=__hip_bfloat16;
using bf16x8=__attribute__((ext_vector_type(8)))short;
using s16x4=__attribute__((ext_vector_type(4)))short;
using f32x16=__attribute__((ext_vector_type(16)))float;
using u32x4=__attribute__((ext_vector_type(4)))unsigned;
constexpr int SEQ=4096,D=64,PQ=1024,PO=1024;
constexpr int KT=4096,VT=8192;
constexpr int NW=8,QBLK=32,QB=QBLK*NW,KVBLK=64,NQB=SEQ/QB;
constexpr int ATTN_UNIT_ROWS=QB;
__device__ __forceinline__ int crow(int r,int hi){return (r&3)+8*(r>>2)+4*hi;}
#define SBAR() __builtin_amdgcn_sched_barrier(0)
__device__ __forceinline__ void cmask(f32x16&p0,f32x16&p1,int jb,int qrel,int hi){
  const float NEG=-INFINITY;
  if(jb>(qrel>>6)){
  #pragma unroll
  for(int r=0;r<16;++r){p0[r]=NEG;p1[r]=NEG;}}
}

constexpr int NSLOT=3, SLOTB=8192;
constexpr int LDS_K=0, LDS_V=NSLOT*SLOTB, LDS_WS=LDS_V+NSLOT*2*SLOTB, LDS_OST=LDS_WS+NW*64*4, LDS_BYTES=LDS_OST+NW*4096;
constexpr float C2=0.125f*1.4426950408889634f;
__device__ __forceinline__ void glds16(const void*gsrc,unsigned lds_dst){unsigned keep;
  asm volatile("s_mov_b32 %0, m0\n\ts_mov_b32 m0, %2\n\ts_nop 0\n\tglobal_load_lds_dwordx4 %1, off\n\ts_mov_b32 m0, %0":"=&s"(keep):"v"(gsrc),"s"(lds_dst):"memory");}
__device__ __forceinline__ void glds16s(const void*sbase,unsigned voff,unsigned lds_dst){unsigned keep;
  asm volatile("s_mov_b32 %0, m0\n\ts_mov_b32 m0, %3\n\ts_nop 0\n\tglobal_load_lds_dwordx4 %1, %2\n\ts_mov_b32 m0, %0":"=&s"(keep):"v"(voff),"s"(sbase),"s"(lds_dst):"memory");}
__device__ __forceinline__ float max3f(float a,float b,float c){float r;asm("v_max3_f32 %0, %1, %2, %3":"=v"(r):"v"(a),"v"(b),"v"(c));return r;}
__device__ __forceinline__ float max2f(float a,float b){float r;asm("v_max_f32_e32 %0, %1, %2":"=v"(r):"v"(a),"v"(b));return r;}
__device__ __forceinline__ float fadd_s(float a,float b){float r;asm("v_add_f32_e32 %0, %1, %2":"=v"(r):"v"(a),"v"(b));return r;}
__device__ __forceinline__ float fsub_s(float a,float b){float r;asm("v_sub_f32_e32 %0, %1, %2":"=v"(r):"v"(a),"v"(b));return r;}
typedef float f32x2_t __attribute__((ext_vector_type(2))); typedef __bf16 bf16x2_t __attribute__((ext_vector_type(2)));
__device__ __forceinline__ unsigned cvtpk_s(float lo,float hi){f32x2_t v={lo,hi};bf16x2_t b=__builtin_convertvector(v,bf16x2_t);return __builtin_bit_cast(unsigned,b);}
#define WAIT_BAR(N) asm volatile("s_waitcnt vmcnt(" #N ") lgkmcnt(0)\n\ts_barrier":::"memory")

__device__ __forceinline__ void qkt(f32x16&p0,f32x16&p1,const char*Kslot,const bf16x8*qr,const f32x16&negm,int r32,int hi){
  const char*kb=Kslot+hi*1024+r32*16;
  #pragma unroll
  for(int d0=0;d0<4;++d0){
    const bf16x8 b0=*reinterpret_cast<const bf16x8*>(kb+d0*2048);
    const bf16x8 b1=*reinterpret_cast<const bf16x8*>(kb+d0*2048+512);
    if(d0==0){p0=__builtin_amdgcn_mfma_f32_32x32x16_bf16(b0,qr[0],negm,0,0,0);p1=__builtin_amdgcn_mfma_f32_32x32x16_bf16(b1,qr[0],negm,0,0,0);}
    else{p0=__builtin_amdgcn_mfma_f32_32x32x16_bf16(b0,qr[d0],p0,0,0,0);p1=__builtin_amdgcn_mfma_f32_32x32x16_bf16(b1,qr[d0],p1,0,0,0);}}
}
typedef __attribute__((address_space(3))) const char* lds_cptr;
typedef short v4i16_t __attribute__((ext_vector_type(4)));
__device__ __forceinline__ void kload8(bf16x8*kf,lds_cptr kp){
  kf[0]=*(const __attribute__((address_space(3))) bf16x8*)(kp);      kf[1]=*(const __attribute__((address_space(3))) bf16x8*)(kp+512);
  kf[2]=*(const __attribute__((address_space(3))) bf16x8*)(kp+2048); kf[3]=*(const __attribute__((address_space(3))) bf16x8*)(kp+2560);
  kf[4]=*(const __attribute__((address_space(3))) bf16x8*)(kp+4096); kf[5]=*(const __attribute__((address_space(3))) bf16x8*)(kp+4608);
  kf[6]=*(const __attribute__((address_space(3))) bf16x8*)(kp+6144); kf[7]=*(const __attribute__((address_space(3))) bf16x8*)(kp+6656);
}
__device__ __forceinline__ void kload2(bf16x8*kf,lds_cptr kp,int j){ kf[2*j]=*(const __attribute__((address_space(3))) bf16x8*)(kp+j*2048); kf[2*j+1]=*(const __attribute__((address_space(3))) bf16x8*)(kp+j*2048+512); }
__device__ __forceinline__ s16x4 vtr(lds_cptr p){ return __builtin_bit_cast(s16x4,__builtin_amdgcn_ds_read_tr16_b64_v4i16((__attribute__((address_space(3))) v4i16_t*)p)); }
__device__ __forceinline__ float rowmax(const f32x16&p0,const f32x16&p1){
  float a=max3f(p0[0],p0[1],p1[0]),b=max3f(p0[2],p0[3],p1[1]);a=max3f(a,p1[2],p1[3]);
  #pragma unroll
  for(int r=4;r<16;r+=4){a=max3f(a,p0[r],p0[r+1]);b=max3f(b,p0[r+2],p0[r+3]);a=max3f(a,p1[r],p1[r+1]);b=max3f(b,p1[r+2],p1[r+3]);}
  const float m=max2f(a,b);
  auto rr=__builtin_amdgcn_permlane32_swap(__float_as_uint(m),__float_as_uint(m),false,false);
  return max2f(__uint_as_float(rr[0]),__uint_as_float(rr[1]));
}
__device__ __forceinline__ void pv(f32x16*o,int vb,bf16x8 pa0,bf16x8 pa1,bf16x8 pa2,bf16x8 pa3){
  #pragma unroll
  for(int d0=0;d0<4;++d0){s16x4 lo[4],hi[4];
    #pragma unroll
    for(int ks=0;ks<4;++ks){
      asm volatile("ds_read_b64_tr_b16 %0,%1 offset:%c2":"=&v"(lo[ks]):"v"(vb),"i"(d0*4096+ks*1024):"memory");
      asm volatile("ds_read_b64_tr_b16 %0,%1 offset:%c2":"=&v"(hi[ks]):"v"(vb),"i"(d0*4096+ks*1024+512):"memory");}
    asm volatile("s_waitcnt lgkmcnt(0)":::"memory");SBAR();
    #define PK(k) (bf16x8){lo[k][0],lo[k][1],lo[k][2],lo[k][3],hi[k][0],hi[k][1],hi[k][2],hi[k][3]}
    o[d0]=__builtin_amdgcn_mfma_f32_32x32x16_bf16(pa0,PK(0),o[d0],0,0,0);
    o[d0]=__builtin_amdgcn_mfma_f32_32x32x16_bf16(pa1,PK(1),o[d0],0,0,0);
    o[d0]=__builtin_amdgcn_mfma_f32_32x32x16_bf16(pa2,PK(2),o[d0],0,0,0);
    o[d0]=__builtin_amdgcn_mfma_f32_32x32x16_bf16(pa3,PK(3),o[d0],0,0,0);
    #undef PK
  }
}

#ifndef ATTN_STORE16
#define ATTN_STORE16(p,v) (*(u32x4*)(p)=(v))
#endif
template<int THRL> __device__ __forceinline__ void attn_unit(int qb,const bf16*Q,const bf16*__restrict__ K,const bf16*__restrict__ V,bf16*O,char*shm){
  const int tid=threadIdx.x,lane=tid&63,r32=lane&31,hi=lane>>5; const int wid=__builtin_amdgcn_readfirstlane(tid>>6);
  const int q0=qb*QB;
  const bf16*Qw=Q+(long)(q0+wid*QBLK)*PQ;
  const bf16*Kh=K,*Vh=V;
  const unsigned lds0=(unsigned)(uintptr_t)shm;
  float*wsf=(float*)(shm+LDS_WS)+wid*64;
  const unsigned koff=(unsigned)(wid*1024+lane*16);
  const unsigned voffv=koff;
  const unsigned kdst=lds0+LDS_K+wid*1024, vdst=lds0+LDS_V+wid*1024;
  #define DMA_K(t,slot) glds16s(Kh+(long)(t)*KT,koff,(unsigned)__builtin_amdgcn_readfirstlane(kdst+(slot)))
  #define DMA_V(t,slot) do{ glds16s(Vh+(long)(t)*VT,voffv,(unsigned)__builtin_amdgcn_readfirstlane(vdst+2*(slot))); glds16s(Vh+4096+(long)(t)*VT,voffv,(unsigned)__builtin_amdgcn_readfirstlane(vdst+8192+2*(slot))); }while(0)
  const int vb0=(int)(lds0+LDS_V)+((lane>>4)&1)*32+(lane&3)*8+(4*hi+((lane&15)>>2))*64;
  const char*Kbase=shm+LDS_K; bf16x8 kf[8];
  const lds_cptr shm3=(lds_cptr)shm; const lds_cptr kp0=shm3+LDS_K+hi*1024+r32*16; const lds_cptr vp0=shm3+LDS_V+((lane>>4)&1)*32+(lane&3)*8+(4*hi+((lane&15)>>2))*64;
  const int NT=(q0+QB)/KVBLK;
  DMA_K(0,0);DMA_V(0,0);DMA_K(1,SLOTB);
  bf16x8 qr[4];
  #pragma unroll
  for(int d0=0;d0<4;++d0)qr[d0]=*reinterpret_cast<const bf16x8*>(&Qw[(long)r32*PQ+d0*16+hi*8]);
  float mhat=0.f,l_reg=0.f;f32x16 o[4];o[0]=f32x16{};o[1]=f32x16{};o[2]=f32x16{};o[3]=f32x16{};
  const int qrel=wid*QBLK+r32;
  #define CMASK(P0,P1,t) do{int jb_=(t)-(NT-4); if(jb_>=0)cmask(P0,P1,jb_,qrel,hi);}while(0)
  bool resc=false;
  #define START(P0,P1) do{ const float rm=rowmax(P0,P1); resc=false; \
    { const float dl=rm; mhat=fadd_s(mhat,dl); \
      _Pragma("unroll") for(int r=0;r<16;++r){P0[r]=fsub_s(P0[r],dl);P1[r]=fsub_s(P1[r],dl);} } \
    _Pragma("unroll") for(int r=0;r<16;++r)P0[r]=__builtin_amdgcn_exp2f(P0[r]); }while(0)
  #define RESC() do{ if(resc){ asm volatile("s_waitcnt lgkmcnt(0)":::"memory"); \
      _Pragma("unroll") for(int d_=0;d_<4;++d_) _Pragma("unroll") for(int r=0;r<16;++r)o[d_][r]*=wsf[crow(r,hi)]; } }while(0)
  f32x16 pA0,pA1,pB0,pB1;
  int sl_prev=0,sl_cur=0,sl_next=SLOTB;
  #define ROT() do{sl_prev=sl_cur;sl_cur=sl_next;sl_next=(sl_next==(NSLOT-1)*SLOTB)?0:sl_next+SLOTB;}while(0)
  DMA_K(2,2*SLOTB);
  WAIT_BAR(4);
  { const f32x16 zero16=f32x16{}; qkt(pA0,pA1,Kbase,qr,zero16,r32,hi); }asm volatile("s_nop 15\n\ts_nop 7":"+v"(pA0),"+v"(pA1));CMASK(pA0,pA1,0);
  START(pA0,pA1);
  _Pragma("unroll") for(int r=0;r<16;++r)pA1[r]=__builtin_amdgcn_exp2f(pA1[r]);
  WAIT_BAR(0);
  DMA_K(3,0);DMA_V(1,SLOTB);
  ROT();
  kload8(kf,kp0+sl_cur);
  WAIT_BAR(3);
  s16x4 vlo[8],vhi[8]; u32x4 pw0,pw1,pw2,pw3;
  #define PKW(P,B) cvtpk_s(P[B],P[B+1])
  #define PAF(k) __builtin_bit_cast(bf16x8,pw##k)
  #define VFR(i) (bf16x8){vlo[i][0],vlo[i][1],vlo[i][2],vlo[i][3],vhi[i][0],vhi[i][1],vhi[i][2],vhi[i][3]}
  #define PIN(x) asm volatile("":"+v"(x))
  #define MX3(a,b,c) __builtin_fmaxf(__builtin_fmaxf((a),(b)),(c))
  #define GAPA(MF,A0,A1,A2,A3,W0,W1,PW) do{ MF; sacc+=A0; sacc+=A1; sacc+=A2; sacc+=A3; PIN(sacc); W0; W1; PIN(PW); SBAR(); }while(0)
  #define EX(v) __builtin_amdgcn_exp2f(v)
  #define GAPM(MF,X,B) do{ MF; X[B]-=mhat; X[B+1]-=mhat; X[B+2]-=mhat; X[B+3]-=mhat; PIN(X); }while(0)
  #define GAPB(MF,X,B) do{ MF; X[B]=EX(X[B]); X[B+1]=EX(X[B+1]); X[B+2]=EX(X[B+2]); X[B+3]=EX(X[B+3]); PIN(X); SBAR(); }while(0)
  #define VRD(i) do{ vlo[i]=vtr(vp_+(((i)>>2)*4096+((i)&3)*1024)); vhi[i]=vtr(vp_+(((i)>>2)*4096+((i)&3)*1024+512)); }while(0)
  #define VRD2(i) do{ vlo[i]=vtr(vp_+((2+((i)>>2))*4096+((i)&3)*1024)); vhi[i]=vtr(vp_+((2+((i)>>2))*4096+((i)&3)*1024+512)); }while(0)
  #define KRD(G,j) do{ if(G){ kload2(kf,kp0+sl_next,j); SBAR(); } }while(0)
  #define STEP(C0,C1,P0,P1,t,GK,GV,GL) do{ SBAR(); \
    const lds_cptr vp_=vp0+2*sl_prev; \
    VRD(0); SBAR(); float sacc=(P0[0]+P0[1]); \
    GAPA(C0=__builtin_amdgcn_mfma_f32_32x32x16_bf16(kf[0],qr[0],f32x16{},0,0,0), P0[2],P0[3],P0[4],P0[5],     pw0[0]=PKW(P0,0), pw0[1]=PKW(P0,2), pw0); \
    VRD(4); SBAR(); GAPA(C1=__builtin_amdgcn_mfma_f32_32x32x16_bf16(kf[1],qr[0],f32x16{},0,0,0), P0[6],P0[7],P0[8],P0[9],     pw0[2]=PKW(P0,4), pw0[3]=PKW(P0,6), pw0); \
    VRD(1); SBAR(); GAPA(C0=__builtin_amdgcn_mfma_f32_32x32x16_bf16(kf[2],qr[1],C0,0,0,0),   P0[10],P0[11],P0[12],P0[13], pw1[0]=PKW(P0,8), pw1[1]=PKW(P0,10), pw1); \
    VRD(5); SBAR(); GAPA(C1=__builtin_amdgcn_mfma_f32_32x32x16_bf16(kf[3],qr[1],C1,0,0,0),   P0[14],P0[15],P1[0],P1[1],   pw1[2]=PKW(P0,12),pw1[3]=PKW(P0,14), pw1); \
    VRD(2); SBAR(); GAPA(C0=__builtin_amdgcn_mfma_f32_32x32x16_bf16(kf[4],qr[2],C0,0,0,0),   P1[2],P1[3],P1[4],P1[5],     pw2[0]=PKW(P1,0), pw2[1]=PKW(P1,2), pw2); \
    VRD(6); SBAR(); GAPA(C1=__builtin_amdgcn_mfma_f32_32x32x16_bf16(kf[5],qr[2],C1,0,0,0),   P1[6],P1[7],P1[8],P1[9],     pw2[2]=PKW(P1,4), pw2[3]=PKW(P1,6), pw2); \
    VRD(3); SBAR(); GAPA(C0=__builtin_amdgcn_mfma_f32_32x32x16_bf16(kf[6],qr[3],C0,0,0,0),   P1[10],P1[11],P1[12],P1[13], pw3[0]=PKW(P1,8), pw3[1]=PKW(P1,10), pw3); \
    VRD(7); SBAR(); GAPA(C1=__builtin_amdgcn_mfma_f32_32x32x16_bf16(kf[7],qr[3],C1,0,0,0),   P1[14],P1[15],0.f,0.f,       pw3[2]=PKW(P1,12),pw3[3]=PKW(P1,14), pw3); \
    l_reg+=sacc; \
    if(GK){DMA_K((t)+3,sl_cur);} if(GV){DMA_V((t)+1,sl_next);} \
    GAPM(o[0]=__builtin_amdgcn_mfma_f32_32x32x16_bf16(PAF(0),VFR(0),o[0],0,0,0), C0,0);  VRD2(0); SBAR(); \
    GAPM(o[1]=__builtin_amdgcn_mfma_f32_32x32x16_bf16(PAF(0),VFR(4),o[1],0,0,0), C0,4);  VRD2(4); SBAR(); \
    GAPM(o[0]=__builtin_amdgcn_mfma_f32_32x32x16_bf16(PAF(1),VFR(1),o[0],0,0,0), C0,8);  VRD2(1); SBAR(); \
    GAPM(o[1]=__builtin_amdgcn_mfma_f32_32x32x16_bf16(PAF(1),VFR(5),o[1],0,0,0), C0,12); VRD2(5); SBAR(); \
    GAPM(o[0]=__builtin_amdgcn_mfma_f32_32x32x16_bf16(PAF(2),VFR(2),o[0],0,0,0), C1,0);  VRD2(2); SBAR(); \
    GAPM(o[1]=__builtin_amdgcn_mfma_f32_32x32x16_bf16(PAF(2),VFR(6),o[1],0,0,0), C1,4);  VRD2(6); SBAR(); \
    GAPM(o[0]=__builtin_amdgcn_mfma_f32_32x32x16_bf16(PAF(3),VFR(3),o[0],0,0,0), C1,8);  VRD2(3); SBAR(); \
    GAPM(o[1]=__builtin_amdgcn_mfma_f32_32x32x16_bf16(PAF(3),VFR(7),o[1],0,0,0), C1,12); VRD2(7); SBAR(); \
    CMASK(C0,C1,t); \
    { float a=MX3(C0[0],C0[1],C1[0]),b=MX3(C0[2],C0[3],C1[1]); a=MX3(a,C1[2],C1[3]); \
      _Pragma("unroll") for(int r=4;r<16;r+=4){a=MX3(a,C0[r],C0[r+1]);b=MX3(b,C0[r+2],C0[r+3]);a=MX3(a,C1[r],C1[r+1]);b=MX3(b,C1[r+2],C1[r+3]);} \
      float rm=__builtin_fmaxf(a,b); { auto rr=__builtin_amdgcn_permlane32_swap(__float_as_uint(rm),__float_as_uint(rm),false,false); rm=__builtin_fmaxf(__uint_as_float(rr[0]),__uint_as_float(rr[1])); } \
      resc=false; \
      if(__builtin_expect(__any(rm>(float)THRL),0)){ const float dl=__builtin_fmaxf(rm,0.f); mhat+=dl; \
        _Pragma("unroll") for(int r=0;r<16;++r){C0[r]-=dl;C1[r]-=dl;} \
        const float f=__builtin_amdgcn_exp2f(-dl); l_reg*=f; if(hi==0)wsf[r32]=f; resc=true; } } \
    SBAR(); \
    GAPB(o[2]=__builtin_amdgcn_mfma_f32_32x32x16_bf16(PAF(0),VFR(0),o[2],0,0,0), C0,0); \
    GAPB(o[3]=__builtin_amdgcn_mfma_f32_32x32x16_bf16(PAF(0),VFR(4),o[3],0,0,0), C0,4); \
    KRD(GL,0); GAPB(o[2]=__builtin_amdgcn_mfma_f32_32x32x16_bf16(PAF(1),VFR(1),o[2],0,0,0), C0,8); \
    KRD(GL,1); GAPB(o[3]=__builtin_amdgcn_mfma_f32_32x32x16_bf16(PAF(1),VFR(5),o[3],0,0,0), C0,12); \
    KRD(GL,2); GAPB(o[2]=__builtin_amdgcn_mfma_f32_32x32x16_bf16(PAF(2),VFR(2),o[2],0,0,0), C1,0); \
    KRD(GL,3); GAPB(o[3]=__builtin_amdgcn_mfma_f32_32x32x16_bf16(PAF(2),VFR(6),o[3],0,0,0), C1,4); \
    GAPB(o[2]=__builtin_amdgcn_mfma_f32_32x32x16_bf16(PAF(3),VFR(3),o[2],0,0,0), C1,8); \
    GAPB(o[3]=__builtin_amdgcn_mfma_f32_32x32x16_bf16(PAF(3),VFR(7),o[3],0,0,0), C1,12); \
    }while(0)
  int t=1;
  #undef CMASK
  #define CMASK(P0,P1,t) do{}while(0)
  for(;t+5<NT;t+=2){
    STEP(pB0,pB1,pA0,pA1,t,true,true,true);     WAIT_BAR(3); RESC(); ROT();
    STEP(pA0,pA1,pB0,pB1,t+1,true,true,true);   WAIT_BAR(3); RESC(); ROT();
  }
  #undef CMASK
  #define CMASK(P0,P1,t) do{int jb_=(t)-(NT-4); if(jb_>=0)cmask(P0,P1,jb_,qrel,hi);}while(0)
  #define ENDW(tt) do{ if((tt)+3<NT){WAIT_BAR(3);} else if((tt)+2<NT){WAIT_BAR(2);} else {WAIT_BAR(0);} }while(0)
  for(;t+1<NT;t+=2){
    STEP(pB0,pB1,pA0,pA1,t,(t+3<NT),(t+1<NT),(t+1<NT));       ENDW(t);   RESC(); ROT();
    STEP(pA0,pA1,pB0,pB1,t+1,(t+4<NT),(t+2<NT),(t+2<NT));     ENDW(t+1); RESC(); ROT();
  }
  STEP(pB0,pB1,pA0,pA1,NT-1,false,false,false); RESC();
  { float sacc=pB0[0]+pB0[1]; _Pragma("unroll") for(int r=2;r<16;++r)sacc+=pB0[r]; _Pragma("unroll") for(int r=0;r<16;++r)sacc+=pB1[r]; l_reg+=sacc;
    pw0=(u32x4){PKW(pB0,0),PKW(pB0,2),PKW(pB0,4),PKW(pB0,6)};pw1=(u32x4){PKW(pB0,8),PKW(pB0,10),PKW(pB0,12),PKW(pB0,14)};pw2=(u32x4){PKW(pB1,0),PKW(pB1,2),PKW(pB1,4),PKW(pB1,6)};pw3=(u32x4){PKW(pB1,8),PKW(pB1,10),PKW(pB1,12),PKW(pB1,14)};
    SBAR(); pv(o,vb0+2*sl_cur,PAF(0),PAF(1),PAF(2),PAF(3)); }
  #undef PKW
  #undef PAF
  #undef VFR
  #undef PIN
  #undef MX3
  #undef GAPA
  #undef GAPB
  #undef GAPM
  #undef EX
  #undef VRD
  #undef VRD2
  #undef KRD
  #undef STEP
  #undef ENDW
  {auto rr=__builtin_amdgcn_permlane32_swap(__float_as_uint(l_reg),__float_as_uint(l_reg),false,false);l_reg=__uint_as_float(rr[0])+__uint_as_float(rr[1]);}
  if(hi==0)wsf[32+r32]=l_reg;asm volatile("s_waitcnt lgkmcnt(0)":::"memory");
  float rli[16];
  #pragma unroll
  for(int r=0;r<16;++r)rli[r]=__builtin_amdgcn_rcpf(wsf[32+crow(r,hi)]);
  bf16*Ow=O+(long)(q0+wid*QBLK)*PO;
  { bf16*stg=(bf16*)(shm+LDS_OST)+wid*2048;
    #pragma unroll
    for(int p=0;p<2;++p){
    #pragma unroll
    for(int r=0;r<16;++r){const int orow=crow(r,hi);
      #pragma unroll
      for(int d0=0;d0<2;++d0)stg[orow*64+d0*32+r32]=__float2bfloat16(o[2*p+d0][r]*rli[r]);}
    asm volatile("s_waitcnt lgkmcnt(0)":::"memory");
    #pragma unroll
    for(int i=0;i<4;++i){const int row=i*8+(lane>>3),ch=lane&7; const u32x4 v=*(const u32x4*)(stg+row*64+ch*8); ATTN_STORE16(Ow+(long)row*PO+p*64+ch*8,v);}
    asm volatile("s_waitcnt lgkmcnt(0)":::"memory"); } }
  asm volatile("s_waitcnt lgkmcnt(0)\n\ts_barrier":::"memory");
  #undef DMA_K
  #undef DMA_V
  #undef CMASK
  #undef START
  #undef RESC
  #undef ROT
}
constexpr int ATTN_LDS_BYTES=LDS_BYTES;
struct AttnTensors { const bf16* Q; const bf16* Kimg; const bf16* Vimg; bf16* O0; bf16* O1; };
struct AttnUnit { int vh; int qb; };
struct StaticOrder {
  int vcu;
  __device__ __forceinline__ explicit StaticOrder(int vcu_):vcu(vcu_){}
  __device__ __forceinline__ bool next(int i,AttnUnit&u)const{ if(i>=4)return false; const int s=vcu&3; u.vh=vcu>>2; u.qb=(i==0)?s:(i==1)?7-s:(i==2)?8+s:15-s; return true; }
  __device__ __forceinline__ void a_ready(const AttnUnit&)const{}
  __device__ __forceinline__ void done(const AttnUnit&)const{}
};
template<int ABL=0> __device__ __forceinline__ void attn_run(const AttnTensors&T,int vh,int qb,char*lds){
  const int comp=vh&1,h=(vh>>1)&3,b=vh>>3;
  attn_unit<8>(qb,T.Q+(long)b*SEQ*PQ+h*128+comp*64,T.Kimg+(long)((b*8+h*2+comp)*(SEQ/64))*KT,T.Vimg+(long)((b*4+h)*(SEQ/64))*VT,(comp?T.O1:T.O0)+(long)b*SEQ*PO+h*128,lds);
}
__device__ __forceinline__ unsigned q_take(unsigned*qheads,int&cq){
  for(int tries=0;tries<8;++tries){
    const unsigned idx=__hip_atomic_fetch_add(qheads+cq,1u,__ATOMIC_RELAXED,__HIP_MEMORY_SCOPE_AGENT);
    if(idx<64u)return (unsigned)cq*64u+idx;
    int found=-1;
    #pragma unroll
    for(int j=1;j<8;++j){const int q=(cq+j)&7; if(found<0&&__hip_atomic_load(qheads+q,__ATOMIC_RELAXED,__HIP_MEMORY_SCOPE_AGENT)<64u)found=q;}
    if(found<0)return 0xffffffffu;
    cq=found;}
  return 0xffffffffu;
}
template<int ABL=0> __device__ __forceinline__ void attn_phase_queue(char*lds,const AttnTensors&T,unsigned*qheads,int xq,volatile __attribute__((address_space(3))) unsigned*mbox){
  const bool t0=(threadIdx.x==0); int cq=xq&7;
  if(t0)mbox[0]=q_take(qheads,cq);
  asm volatile("s_waitcnt vmcnt(0) lgkmcnt(0)\n\ts_barrier":::"memory");
  unsigned ticket=(unsigned)__builtin_amdgcn_readfirstlane(mbox[0]); int par=0;
  while(ticket!=0xffffffffu){
    unsigned nxt=0u; if(t0)nxt=__hip_atomic_fetch_add(qheads+cq,1u,__ATOMIC_RELAXED,__HIP_MEMORY_SCOPE_AGENT);
    attn_run<ABL>(T,4*(int)(ticket>>6)+(int)(ticket&3u),15-(int)((ticket&63u)>>2),lds);
    par^=1; if(t0)mbox[par]=(nxt<64u)?(unsigned)cq*64u+nxt:q_take(qheads,cq);
    asm volatile("s_waitcnt vmcnt(0) lgkmcnt(0)\n\ts_barrier":::"memory");
    ticket=(unsigned)__builtin_amdgcn_readfirstlane(mbox[par]);
  }
}
#undef SBAR
#undef WAIT_BAR
}

constexpr int NWAVES = 8;
#ifndef MK_N_LAUNCHES
#define MK_N_LAUNCHES 1
#endif
constexpr int PER_PHASE = 8;
constexpr int N_LAUNCHES = MK_N_LAUNCHES;

constexpr int BATCH = 4, T = 4096, D = 1024;
constexpr int M = BATCH * T;
constexpr int RW_W = 512, RW_H = 8, RW_N = 64, DA_W = 512;
constexpr int RW_SHIFTED = 1664, RW_COLS = 2176, D_IN = 4224;
constexpr int NMAIN = 4096;
constexpr float RMS_EPS = 1e-6f, GN_EPS = 64e-5f, SUBLN_EPS = 1e-5f;
constexpr float LAMBDA_INIT = 0.2f;
constexpr float LOG2E = 1.4426950408889634f;

constexpr size_t MiB = 1u << 20, KiB = 1u << 10;
constexpr size_t WS_CTL = 0, CTL_ZERO_BYTES = 128 * KiB;
constexpr size_t WS_MOD = 128 * KiB;
constexpr size_t WS_W2T = 256 * KiB;
constexpr size_t WS_BONUS = 512 * KiB;
constexpr size_t WS_X = 1 * MiB;
constexpr size_t WS_WOUT = 1 * MiB + 512 * KiB;
constexpr size_t WS_WIN = 3 * MiB + 512 * KiB;
constexpr size_t WS_XN = 11 * MiB + 768 * KiB;
constexpr size_t WS_REC1 = WS_XN;
constexpr size_t WS_Y = WS_XN;
constexpr size_t WS_URK = WS_XN + 32 * MiB;
constexpr size_t WS_UVG = WS_URK + 32 * MiB;
constexpr size_t WS_UQG = WS_UVG + 32 * MiB;
constexpr size_t WS_KIMG = WS_UQG + 32 * MiB;
constexpr size_t WS_VIMG = WS_KIMG + 16 * MiB;
constexpr size_t WS_REC2 = WS_VIMG + 16 * MiB;
constexpr size_t WS_LO = WS_REC2 + 65 * MiB;
constexpr size_t WS_ORW = WS_LO;
constexpr size_t WS_END = WS_ORW + 16 * MiB;
static_assert(WS_END <= 256 * MiB, "d_ws map");
constexpr int UP = 1024;
constexpr int CW_TMO = 0, CW_CODE = 1;
constexpr int CW_BAR = 4096;
constexpr int CW_SEAM = 16384;
constexpr int CW_QUEUE = 24576;
static_assert((CW_QUEUE + 1024 + 16 * 64) * 4 <= (int)CTL_ZERO_BYTES, "CTL words inside the memset region");

constexpr int RING_OFF = 0, RING_BYTES = 131072;
constexpr int LDSCTL_OFF = RING_BYTES, MISC_OFF = LDSCTL_OFF + 320;
constexpr int LDS_BYTES = 147456;
static_assert(MISC_OFF + 128 <= LDS_BYTES, "LDS map");

#define GAS __attribute__((address_space(1)))
#define LAS __attribute__((address_space(3)))
typedef unsigned short bf16;
typedef unsigned v4u __attribute__((ext_vector_type(4)));
typedef float f32x4 __attribute__((ext_vector_type(4)));
typedef short bf16x8 __attribute__((ext_vector_type(8)));
typedef GAS unsigned gu32;
typedef GAS unsigned long long gu64;
#define RLX_AGENT __ATOMIC_RELAXED, __HIP_MEMORY_SCOPE_AGENT
#define LDS_WAIT() asm volatile("s_waitcnt lgkmcnt(0)" ::: "memory")
#define VM_WAIT() asm volatile("s_waitcnt vmcnt(0)" ::: "memory")
__device__ __forceinline__ unsigned long long rt() { return __builtin_amdgcn_s_memrealtime(); }
__device__ __forceinline__ unsigned f2bf(float f) { unsigned u = __builtin_bit_cast(unsigned, f); return (u + 0x7fffu + ((u >> 16) & 1u)) >> 16; }
__device__ __forceinline__ unsigned pk2(float lo, float hi) { return f2bf(lo) | (f2bf(hi) << 16); }

#define XB_TMO      128
#define XB_XCNT(j)  (256  + 64 * (j))
#define XB_XSUB(j)  (1280 + 64 * (j))
#define XB_XGEN(j)  (2304 + 64 * (j))
#define XB_TOP      3328
#define XB_TOPGEN   3392
#define XCD_BAR_WORDS 3456
#define XB_SPIN_CAP (1u << 18)

__device__ __forceinline__ unsigned xb_ld(unsigned* p)              { return __hip_atomic_load(p, __ATOMIC_RELAXED, __HIP_MEMORY_SCOPE_AGENT); }
__device__ __forceinline__ unsigned xb_add(unsigned* p, unsigned v) { return __hip_atomic_fetch_add(p, v, __ATOMIC_RELAXED, __HIP_MEMORY_SCOPE_AGENT); }
__device__ __forceinline__ unsigned xb_xcc_id() { return (unsigned)__builtin_amdgcn_s_getreg((3 << 11) | 20) & 0xFu; }
#define XB_SPIN(cond, bar) do { unsigned _sp = 0; while (cond) { __builtin_amdgcn_s_sleep(1); \
    if ((++_sp & 255u) == 0u) { if (xb_ld(&(bar)[XB_TMO])) break; if (_sp > XB_SPIN_CAP) { atomicAdd(&(bar)[XB_TMO], 1u); break; } } } } while (0)

struct XcdBarrier {
    unsigned* bar; unsigned x;
    volatile LAS unsigned* st;
};

__device__ __forceinline__ XcdBarrier xcd_barrier_post(unsigned* bar, volatile LAS unsigned* st) {
    XcdBarrier b; b.bar = bar; b.x = xb_xcc_id(); b.st = st;
    if (threadIdx.x == 0) (void)xb_add(&bar[XB_XCNT(b.x)], 1u);
    return b;
}
__device__ __forceinline__ void xcd_barrier_complete(unsigned* bar, unsigned x, unsigned& nloc, unsigned& nx) {
    const unsigned G = gridDim.x * gridDim.y * gridDim.z;
    unsigned sum, cnt, mine, sp = 0u;
    for (;;) {
        sum = 0u; cnt = 0u; mine = 0u;
#pragma unroll
        for (unsigned j = 0; j < 16; ++j) { const unsigned c = xb_ld(&bar[XB_XCNT(j)]); sum += c; cnt += (c > 0u) ? 1u : 0u; mine = (j == x) ? c : mine; }
        if (sum == G) break;
        __builtin_amdgcn_s_sleep(1);
        if ((++sp & 255u) == 0u) { if (xb_ld(&bar[XB_TMO])) break; if (sp > XB_SPIN_CAP) { atomicAdd(&bar[XB_TMO], 1u); break; } }
    }
    nloc = mine > 0u ? mine : 1u; nx = cnt > 0u ? cnt : 1u;
}

__device__ __forceinline__ void xcd_barrier(const XcdBarrier& b) {
    asm volatile("s_waitcnt vmcnt(0)" ::: "memory");
    __syncthreads();
    if (threadIdx.x == 0) {
        unsigned* bar = b.bar;
        __builtin_amdgcn_s_waitcnt(0);
        unsigned nloc = b.st[0], nx = b.st[1];
        if (nloc == 0u) { xcd_barrier_complete(bar, b.x, nloc, nx); b.st[0] = nloc; b.st[1] = nx; }
        const unsigned old = xb_add(&bar[XB_XSUB(b.x)], 1u);
        const unsigned gen = old / nloc;
        if (old + 1u == (gen + 1u) * nloc) {
            __builtin_amdgcn_fence(__ATOMIC_RELEASE, "agent");
            asm volatile("s_waitcnt vmcnt(0)" ::: "memory");
            const unsigned og = xb_add(&bar[XB_TOP], 1u);
            const unsigned tg = og / nx;
            if (og + 1u == (tg + 1u) * nx) xb_add(&bar[XB_TOPGEN], 1u);
            else XB_SPIN(xb_ld(&bar[XB_TOPGEN]) == tg, bar);
            __builtin_amdgcn_fence(__ATOMIC_ACQUIRE, "agent");
            xb_add(&bar[XB_XGEN(b.x)], 1u);
            asm volatile("s_waitcnt vmcnt(0)" ::: "memory");
        } else {
            XB_SPIN(xb_ld(&bar[XB_XGEN(b.x)]) == gen, bar);
            __builtin_amdgcn_fence(__ATOMIC_ACQUIRE, "agent");
            asm volatile("s_waitcnt vmcnt(0)" ::: "memory");
        }
    }
    __syncthreads();
}
struct Frame {
    LAS unsigned char* lds;
    volatile LAS unsigned* MISC;
    gu32* ctl;
    int tid, lane, wave;
    int vcu, G;
    const float* in[23]; float* out; unsigned char* ws;
};
enum { I_X = 0, I_C, I_WADA, I_BADA, I_GPRE, I_GPOST, I_WIN, I_WOUT, I_MU, I_W0, I_WW2, I_A0, I_WA2, I_KK, I_KA, I_RK, I_LNW, I_LNB, I_LQ1, I_LK1, I_LQ2, I_LK2, I_SUBLN };

typedef float f32x2c_t __attribute__((ext_vector_type(2))); typedef __bf16 bf16x2c_t __attribute__((ext_vector_type(2)));
__device__ __forceinline__ unsigned cvtpk(float lo, float hi) { f32x2c_t v = {lo, hi}; bf16x2c_t b = __builtin_convertvector(v, bf16x2c_t); return __builtin_bit_cast(unsigned, b); }
__device__ __forceinline__ float bf2f(unsigned short v) { return __builtin_bit_cast(float, (unsigned)v << 16); }
__device__ __forceinline__ float bflo(unsigned v) { return __builtin_bit_cast(float, v << 16); }
__device__ __forceinline__ float bfhi(unsigned v) { return __builtin_bit_cast(float, v & 0xffff0000u); }
__device__ __forceinline__ float sigmoidf_(float x) { return 1.f / (1.f + __expf(-x)); }
__device__ __forceinline__ float siluf_(float x) { return x / (1.f + __expf(-x)); }
__device__ __forceinline__ float silu_fast(float x) { return x * __builtin_amdgcn_rcpf(1.f + __builtin_amdgcn_exp2f(-1.4426950408889634f * x)); }

__device__ __forceinline__ float wave_sum(float v) {
#pragma unroll
    for (int o = 1; o < 64; o <<= 1) v += __shfl_xor(v, o);
    return v;
}
__device__ __forceinline__ float sum8_dpp(float v) { v += __builtin_bit_cast(float, __builtin_amdgcn_update_dpp(0, __builtin_bit_cast(int, v), 0xB1, 0xf, 0xf, true)); v += __builtin_bit_cast(float, __builtin_amdgcn_update_dpp(0, __builtin_bit_cast(int, v), 0x4E, 0xf, 0xf, true));
    v += __builtin_bit_cast(float, __builtin_amdgcn_update_dpp(0, __builtin_bit_cast(int, v), 0x141, 0xf, 0xf, true)); return v; }
__device__ __forceinline__ float sum16_dpp(float v) { v = sum8_dpp(v); v += __builtin_bit_cast(float, __builtin_amdgcn_update_dpp(0, __builtin_bit_cast(int, v), 0x140, 0xf, 0xf, true)); return v; }
__device__ __forceinline__ int win_col(int n) { return n < 1536 ? n : (n < 2048 ? 1664 + (n - 1536) : (n < 4096 ? 2176 + (n - 2048) : 1536 + (n - 4096))); }
template <bool IMG = false> __device__ __forceinline__ void p0_transpose_item(const float* W, int K, int N, bf16* WT, int k0, int src_col0, int dst_row0, LAS float* scr, int lane) {
#pragma unroll 8
    for (int i = 0; i < 32; ++i) { const int kk = 2 * i + (lane >> 5); scr[kk * 33 + (lane & 31)] = W[(size_t)(k0 + kk) * N + src_col0 + (lane & 31)]; }
    LDS_WAIT(); asm volatile("" ::: "memory");
    const int c = lane & 7;
#pragma unroll
    for (int j = 0; j < 4; ++j) { const int n = (lane >> 3) + 8 * j; const LAS float* s = scr + (8 * c) * 33 + n;
        v4u o; o.x = pk2(s[0 * 33], s[1 * 33]); o.y = pk2(s[2 * 33], s[3 * 33]); o.z = pk2(s[4 * 33], s[5 * 33]); o.w = pk2(s[6 * 33], s[7 * 33]);
        if (IMG) { const int nn = dst_row0 + n, kk_ = k0 + 8 * c; *(GAS v4u*)((char*)WT + ((size_t)(((nn >> 4) * 32 + (kk_ >> 5)) * 64 + ((kk_ >> 3) & 3) * 16 + (nn & 15))) * 16) = o; }
        else *(GAS v4u*)(WT + (size_t)(dst_row0 + n) * K + k0 + 8 * c) = o; }
    LDS_WAIT(); asm volatile("" ::: "memory");
}
__device__ __forceinline__ void p0_mod_item(Frame& F, int item) {
    const float* c = F.in[I_C]; const float* wada = F.in[I_WADA]; const float* bada = F.in[I_BADA]; float* mod = (float*)(F.ws + WS_MOD);
    const int col = item * 4;
    f32x4 acc[4] = {{0.f, 0.f, 0.f, 0.f}, {0.f, 0.f, 0.f, 0.f}, {0.f, 0.f, 0.f, 0.f}, {0.f, 0.f, 0.f, 0.f}};
    f32x4 wv[16];
#pragma unroll
    for (int i = 0; i < 16; ++i) wv[i] = *(const f32x4*)(wada + (size_t)(F.lane + 64 * i) * 3072 + col);
#pragma unroll
    for (int i = 0; i < 16; ++i) { const int k = F.lane + 64 * i;
#pragma unroll
        for (int b = 0; b < 4; ++b) acc[b] += siluf_(c[b * D + k]) * wv[i]; }
#pragma unroll
    for (int b = 0; b < 4; ++b)
#pragma unroll
        for (int i = 0; i < 4; ++i) acc[b][i] = wave_sum(acc[b][i]);
    if (F.lane == 0) {
        const f32x4 bv = *(const f32x4*)(bada + col);
#pragma unroll
        for (int b = 0; b < 4; ++b) *(f32x4*)(mod + b * 3072 + col) = acc[b] + bv;
    }
}
__device__ __forceinline__ void p0_prologue(Frame& F) {
    LAS float* scr = (LAS float*)(F.lds + RING_OFF + F.wave * 16384);
    const int gw = F.vcu * NWAVES + F.wave, NGW = F.G * NWAVES;
    constexpr int I_MOD = 3072 / 4, I_IN = (D / 64) * (D_IN / 32), I_OUT = (D / 64) * (D / 32), I_W2 = 512 / 32;
    constexpr int NITEMS = I_MOD + I_IN + I_OUT + 2 * I_W2;
    bf16* WinT = (bf16*)(F.ws + WS_WIN); bf16* WoutT = (bf16*)(F.ws + WS_WOUT);
    for (int it = gw; it < NITEMS; it += NGW) {
        int r = it;
        if (r < I_MOD) { p0_mod_item(F, r); continue; } r -= I_MOD;
        if (r < I_IN) { const int nblk = D_IN / 32, kb = r / nblk, nb = r % nblk; p0_transpose_item(F.in[I_WIN], D, D_IN, WinT, 64 * kb, win_col(32 * nb), 32 * nb, scr, F.lane); continue; } r -= I_IN;
        if (r < I_OUT) { const int nblk = D / 32, kb = r / nblk, nb = r % nblk; p0_transpose_item<true>(F.in[I_WOUT], D, D, WoutT, 64 * kb, 32 * nb, 32 * nb, scr, F.lane); continue; } r -= I_OUT;
        { const int which = r / I_W2, nb = r % I_W2; p0_transpose_item(F.in[which ? I_WA2 : I_WW2], 64, 512, (bf16*)(F.ws + WS_W2T) + (size_t)which * 512 * 64, 0, 32 * nb, 32 * nb, scr, F.lane); }
    }
}
__device__ __forceinline__ void p1_rows(Frame& F) {
    const int gw = F.vcu * NWAVES + F.wave, NGW = F.G * NWAVES;
    const float* x = F.in[I_X]; const float* gpre = F.in[I_GPRE]; const float* mod = (const float*)(F.ws + WS_MOD); bf16* XN = (bf16*)(F.ws + WS_XN);
    for (int m0 = gw; m0 < M; m0 += 8 * NGW) {
        f32x4 v[8][4];
#pragma unroll
        for (int r = 0; r < 8; ++r) { const int m = m0 + r * NGW; if (m < M) { const GAS f32x4* xr = (const GAS f32x4*)(x + (size_t)m * D) + F.lane;
#pragma unroll
            for (int j = 0; j < 4; ++j) v[r][j] = __builtin_nontemporal_load(xr + 64 * j); } }
#pragma unroll
        for (int r = 0; r < 8; ++r) { const int m = m0 + r * NGW; if (m < M) { const int b = m / T; float s = 0.f;
#pragma unroll
            for (int j = 0; j < 4; ++j) s += (v[r][j].x * v[r][j].x + v[r][j].y * v[r][j].y) + (v[r][j].z * v[r][j].z + v[r][j].w * v[r][j].w);
            const float rstd = 1.f / sqrtf(wave_sum(s) * (1.f / D) + RMS_EPS);
            GAS unsigned long long* o8 = (GAS unsigned long long*)(XN + (size_t)m * D) + F.lane;
#pragma unroll
            for (int j = 0; j < 4; ++j) { const int col = 4 * F.lane + 256 * j;
                const f32x4 g = *(const f32x4*)(gpre + col), sh = *(const f32x4*)(mod + b * 3072 + col), sc = *(const f32x4*)(mod + b * 3072 + 1024 + col);
                const f32x4 h = v[r][j] * rstd * g * (sc + 1.f) + sh;
                o8[64 * j] = (unsigned long long)pk2(h.x, h.y) | ((unsigned long long)pk2(h.z, h.w) << 32); } } }
    }
}
__device__ __forceinline__ void glds16f(const void* gsrc, unsigned lds_dst) { unsigned keep;
    asm volatile("s_mov_b32 %0, m0\n\ts_mov_b32 m0, %2\n\ts_nop 0\n\tglobal_load_lds_dwordx4 %1, off\n\ts_mov_b32 m0, %0" : "=&s"(keep) : "v"(gsrc), "s"(lds_dst) : "memory"); }
__device__ __forceinline__ void glds4f(const void* gsrc, unsigned lds_dst) { unsigned keep;
    asm volatile("s_mov_b32 %0, m0\n\ts_mov_b32 m0, %2\n\ts_nop 0\n\tglobal_load_lds_dword %1, off\n\ts_mov_b32 m0, %0" : "=&s"(keep) : "v"(gsrc), "s"(lds_dst) : "memory"); }
__device__ __forceinline__ void p2_lora(Frame& F) {
    typedef float f32x4_ __attribute__((ext_vector_type(4)));
    const bf16* XN = (const bf16*)(F.ws + WS_XN); const bf16* Wl = (const bf16*)(F.ws + WS_WIN) + (size_t)NMAIN * D; bf16* LO = (bf16*)(F.ws + WS_LO);
    const int fr = F.lane & 15, fq = F.lane >> 4, w = F.wave;
    const unsigned lds0 = (unsigned)(uintptr_t)(F.lds + RING_OFF);
    for (int unit = F.vcu; unit < M / 64; unit += F.G) {
        const int row0 = unit * 64;
        const bf16* bp = Wl + (size_t)(w * 16 + fr) * D + fq * 8;
        bf16x8 bb[32];
#pragma unroll
        for (int k = 0; k < 32; ++k) bb[k] = *(const bf16x8*)(bp + k * 32);
#pragma unroll
        for (int j = 0; j < 16; ++j) { const int p = w + 8 * j, ks = p >> 2, rt = p & 3;
            glds16f(XN + (size_t)(row0 + rt * 16 + fr) * D + ks * 32 + fq * 8, (unsigned)__builtin_amdgcn_readfirstlane(lds0 + p * 1024)); }
        f32x4_ acc[4] = {{0.f, 0.f, 0.f, 0.f}, {0.f, 0.f, 0.f, 0.f}, {0.f, 0.f, 0.f, 0.f}, {0.f, 0.f, 0.f, 0.f}};
#define LORA_STAGE(s_, cnt_) do { asm volatile("s_waitcnt vmcnt(" #cnt_ ")" ::: "memory"); __builtin_amdgcn_s_barrier(); asm volatile("" ::: "memory"); \
            _Pragma("unroll") for (int k = 0; k < 8; ++k) { const int ks = (s_) * 8 + k; \
                _Pragma("unroll") for (int rt = 0; rt < 4; ++rt) { const bf16x8 a = *(const LAS bf16x8*)(F.lds + RING_OFF + (4 * ks + rt) * 1024 + F.lane * 16); \
                    acc[rt] = __builtin_amdgcn_mfma_f32_16x16x32_bf16(bb[ks], a, acc[rt], 0, 0, 0); } } } while (0)
        LORA_STAGE(0, 12); LORA_STAGE(1, 8); LORA_STAGE(2, 4); LORA_STAGE(3, 0);
#undef LORA_STAGE
#pragma unroll
        for (int rt = 0; rt < 4; ++rt) { const unsigned long long o = (unsigned long long)cvtpk(acc[rt][0], acc[rt][1]) | ((unsigned long long)cvtpk(acc[rt][2], acc[rt][3]) << 32);
            *(GAS unsigned long long*)(LO + (size_t)(row0 + rt * 16 + fr) * 128 + w * 16 + 4 * fq) = o; }
        LDS_WAIT(); __builtin_amdgcn_s_barrier();
    }
}
__device__ __forceinline__ float tshift(float cur, float prev, float mu) { return cur + (prev - cur) * mu; }

constexpr int REC_WA = 0, REC_RA = 2048, REC_AR = 4096, REC_BK = 5120, REC_VT = 9216, REC_MAK = 11264, REC_G = 11776, REC_BYTES = 12032;
constexpr int NCHUNK = T / 16;
constexpr int REC1_N = (int)((32 * MiB) / REC_BYTES);
static_assert((size_t)(BATCH * RW_H * NCHUNK - REC1_N) * REC_BYTES <= 65 * MiB, "record regions");
__device__ __forceinline__ unsigned char* rec_ptr(unsigned char* ws, int b, int h, int chunk) {
    const int idx = (b * RW_H + h) * NCHUNK + chunk;
    return idx < REC1_N ? ws + WS_REC1 + (size_t)idx * REC_BYTES : ws + WS_REC2 + (size_t)(idx - REC1_N) * REC_BYTES;
}
constexpr int PW_KAP = 0, PW_RH = 2304, PW_BH = 4608, PW_KH = 6912, PW_AAB = 9216, PW_AAK = 10496, PW_TM = 11776;
constexpr int PWS = 72;
static_assert(PW_TM + 16 * 20 * 4 <= 13312 && 2 * 16 * 68 * 4 <= PW_AAB, "prep scratch");

constexpr int PWB = 13312;
constexpr int PT_S = 68;
__device__ __forceinline__ float fast_exp(float x) { return __builtin_amdgcn_exp2f(x * LOG2E); }
__device__ __forceinline__ float fast_sigmoid(float x) { return __builtin_amdgcn_rcpf(1.f + fast_exp(-x)); }
__device__ __forceinline__ float fast_tanh(float x) { const float e = fast_exp(-2.f * fabsf(x)); const float t = (1.f - e) * __builtin_amdgcn_rcpf(1.f + e); return x < 0.f ? -t : t; }
__device__ __forceinline__ void p3_prep(Frame& F) {
    typedef float f32x4_ __attribute__((ext_vector_type(4)));
    const bf16* LO = (const bf16*)(F.ws + WS_LO); const bf16* Urk = (const bf16*)(F.ws + WS_URK); const bf16* Uvg = (const bf16*)(F.ws + WS_UVG); float* BON = (float*)(F.ws + WS_BONUS);
    const bf16* W2T = (const bf16*)(F.ws + WS_W2T);
    const float* mu = F.in[I_MU];
    LAS unsigned char* pw = F.lds + RING_OFF + F.wave * PWB;
    const int c = F.tid, lane = F.lane, h = F.wave, fi = lane & 15, fg = lane >> 4;
    const float k_k = F.in[I_KK][c], k_a = F.in[I_KA][c], r_k = F.in[I_RK][c], mu_r = mu[c], mu_k = mu[512 + c], mu_v = mu[1024 + c];
    float w0c[4], a0c[4];
#pragma unroll
    for (int nt = 0; nt < 4; ++nt) { w0c[nt] = F.in[I_W0][h * 64 + nt * 16 + fi]; a0c[nt] = F.in[I_A0][h * 64 + nt * 16 + fi]; }
    for (int tile = F.vcu; tile < M / 16; tile += F.G) {
        const int m0 = tile * 16, b = m0 / T, chunk = (m0 % T) / 16; const bool firstc = (chunk == 0);
        unsigned char* rec = rec_ptr(F.ws, b, h, chunk);
        unsigned short rw_[17], kw_[17], vw_[17];
#pragma unroll
        for (int i = 0; i < 17; ++i) { const size_t m = (size_t)(m0 + i - 1);
            if (i == 0 && firstc) { rw_[0] = 0; kw_[0] = 0; vw_[0] = 0; }
            else { rw_[i] = Urk[m * UP + c]; kw_[i] = Urk[m * UP + 512 + c]; vw_[i] = Uvg[m * UP + c]; } }
        float lw2[16], av[16];
        {
            bf16x8 fw[2], fa[2];
#pragma unroll
            for (int ks = 0; ks < 2; ++ks) {
                const bf16* lp = LO + (size_t)(m0 + fi) * 128 + ks * 32 + fg * 8; const bool nz = !(firstc && fi == 0);
                const v4u cw_ = *(const GAS v4u*)lp, ca_ = *(const GAS v4u*)(lp + 64);
                v4u pw_ = {0u, 0u, 0u, 0u}, pa_ = pw_; if (nz) { pw_ = *(const GAS v4u*)(lp - 128); pa_ = *(const GAS v4u*)(lp - 64); }
                const f32x4_ m0w = *(const f32x4_*)(mu + 1536 + ks * 32 + fg * 8), m1w = *(const f32x4_*)(mu + 1536 + ks * 32 + fg * 8 + 4), m0a = *(const f32x4_*)(mu + 1600 + ks * 32 + fg * 8), m1a = *(const f32x4_*)(mu + 1600 + ks * 32 + fg * 8 + 4);
                v4u ow, oa;
#pragma unroll
                for (int u = 0; u < 4; ++u) { const float mwl = (u < 2 ? m0w : m1w)[(2 * u) & 3], mwh = (u < 2 ? m0w : m1w)[(2 * u + 1) & 3], mal = (u < 2 ? m0a : m1a)[(2 * u) & 3], mah = (u < 2 ? m0a : m1a)[(2 * u + 1) & 3];
                    ow[u] = cvtpk(fast_tanh(tshift(bflo(cw_[u]), bflo(pw_[u]), mwl)), fast_tanh(tshift(bfhi(cw_[u]), bfhi(pw_[u]), mwh)));
                    oa[u] = cvtpk(tshift(bflo(ca_[u]), bflo(pa_[u]), mal), tshift(bfhi(ca_[u]), bfhi(pa_[u]), mah)); }
                fw[ks] = __builtin_bit_cast(bf16x8, ow); fa[ks] = __builtin_bit_cast(bf16x8, oa); }
            f32x4_ cw[4], ca[4];
#pragma unroll
            for (int nt = 0; nt < 4; ++nt) { cw[nt] = (f32x4_){0.f, 0.f, 0.f, 0.f}; ca[nt] = cw[nt]; }
#pragma unroll
            for (int nt = 0; nt < 4; ++nt)
#pragma unroll
                for (int ks = 0; ks < 2; ++ks) { const size_t o = (size_t)(h * 64 + nt * 16 + fi) * 64 + ks * 32 + fg * 8;
                    const bf16x8 bw = *(const bf16x8*)(W2T + o), ba = *(const bf16x8*)(W2T + 512 * 64 + o);
                    cw[nt] = __builtin_amdgcn_mfma_f32_16x16x32_bf16(fw[ks], bw, cw[nt], 0, 0, 0); ca[nt] = __builtin_amdgcn_mfma_f32_16x16x32_bf16(fa[ks], ba, ca[nt], 0, 0, 0); }
            LAS float* t1 = (LAS float*)pw; LAS float* t2 = t1 + 16 * PT_S;
#pragma unroll
            for (int nt = 0; nt < 4; ++nt)
#pragma unroll
                for (int j = 0; j < 4; ++j) { const float x_ = w0c[nt] + cw[nt][j];
                    const float sp = 0.6931471805599453f * __builtin_amdgcn_logf(1.f + fast_exp(-x_));
                    t1[(4 * fg + j) * PT_S + nt * 16 + fi] = -fast_exp(-sp - 0.5f) * LOG2E;
                    t2[(4 * fg + j) * PT_S + nt * 16 + fi] = fast_sigmoid(a0c[nt] + ca[nt][j]); }
            LDS_WAIT(); asm volatile("" ::: "memory");
#pragma unroll
            for (int i = 0; i < 16; ++i) { lw2[i] = t1[i * PT_S + lane]; av[i] = t2[i * PT_S + lane]; }
            LDS_WAIT(); asm volatile("" ::: "memory");
        }
        float kap[16], cl[16];
        {
        float rr[16], kt[16], kk[16], bb[16];
        LAS float* r1 = (LAS float*)pw; LAS float* r2 = r1 + 16 * PT_S; LAS float* s1 = (LAS float*)(pw + PW_TM);
        {
        float vv[16];
#pragma unroll
        for (int i = 0; i < 16; ++i) {
            const float r = tshift(bf2f(rw_[i + 1]), bf2f(rw_[i]), mu_r), k = tshift(bf2f(kw_[i + 1]), bf2f(kw_[i]), mu_k);
            vv[i] = tshift(bf2f(vw_[i + 1]), bf2f(vw_[i]), mu_v);
            const float kkr = k * k_k; kk[i] = kkr; kt[i] = k * (1.f + (av[i] - 1.f) * k_a); rr[i] = r;
            r1[i * PT_S + lane] = kkr * kkr; r2[i * PT_S + lane] = r * kt[i] * r_k; }
#pragma unroll
        for (int g = 0; g < 4; ++g) { const unsigned long long o = (unsigned long long)cvtpk(vv[4 * g], vv[4 * g + 1]) | ((unsigned long long)cvtpk(vv[4 * g + 2], vv[4 * g + 3]) << 32);
            *(GAS unsigned long long*)(rec + REC_VT + (lane >> 4) * 512 + (g * 16 + (lane & 15)) * 8) = o; }
        }
        LDS_WAIT(); asm volatile("" ::: "memory");
        { const int i = lane >> 2, q = lane & 3; float sa = 0.f, sb = 0.f;
#pragma unroll
          for (int u = 0; u < 4; ++u) { const f32x4_ x = *(const LAS f32x4_*)(r1 + i * PT_S + 16 * q + 4 * u), y = *(const LAS f32x4_*)(r2 + i * PT_S + 16 * q + 4 * u); sa += (x[0] + x[1]) + (x[2] + x[3]); sb += (y[0] + y[1]) + (y[2] + y[3]); }
          sa += __shfl_xor(sa, 1); sa += __shfl_xor(sa, 2); sb += __shfl_xor(sb, 1); sb += __shfl_xor(sb, 2);
          if (q == 0) { s1[i] = sa; BON[(m0 + i) * 8 + h] = sb; } }
        LDS_WAIT(); asm volatile("" ::: "memory");
        float run = 0.f;
#pragma unroll
        for (int i = 0; i < 16; ++i) { kk[i] = kk[i] * __builtin_amdgcn_rcpf(fmaxf(__builtin_amdgcn_sqrtf(s1[i]), 1e-12f)); bb[i] = av[i] * kk[i]; run += lw2[i]; cl[i] = run; }
        LDS_WAIT(); asm volatile("" ::: "memory");
        LAS unsigned short* okap = (LAS unsigned short*)(pw + PW_KAP); LAS unsigned short* orh = (LAS unsigned short*)(pw + PW_RH);
        LAS unsigned short* obh = (LAS unsigned short*)(pw + PW_BH); LAS unsigned short* okh = (LAS unsigned short*)(pw + PW_KH);
        const float cl15 = cl[15];
#pragma unroll
        for (int g = 0; g < 4; ++g) { float kd[4], nbd[4];
#pragma unroll
            for (int u = 0; u < 4; ++u) { const int i = 4 * g + u;
                const float e = __builtin_amdgcn_exp2f(cl[i]), em1 = (i == 0) ? 1.f : __builtin_amdgcn_exp2f(cl[i - 1]), inv = __builtin_amdgcn_exp2f(-cl[i]), eL = __builtin_amdgcn_exp2f(cl15 - cl[i]);
                kap[i] = kk[i] * em1; const float rh = rr[i] * e, kh = kt[i] * inv, bh = bb[i] * inv; kd[u] = kt[i] * eL; nbd[u] = -bb[i] * eL;
                okap[i * PWS + lane] = (unsigned short)(cvtpk(kap[i], 0.f) & 0xffffu); orh[i * PWS + lane] = (unsigned short)(cvtpk(rh, 0.f) & 0xffffu); obh[i * PWS + lane] = (unsigned short)(cvtpk(bh, 0.f) & 0xffffu); okh[i * PWS + lane] = (unsigned short)(cvtpk(kh, 0.f) & 0xffffu); }
            v4u o; o.x = cvtpk(nbd[0], nbd[1]); o.y = cvtpk(nbd[2], nbd[3]); o.z = cvtpk(kd[0], kd[1]); o.w = cvtpk(kd[2], kd[3]);
            *(GAS v4u*)(rec + REC_BK + (lane >> 4) * 1024 + (g * 16 + (lane & 15)) * 16) = o; }
        }
        *(GAS float*)(rec + REC_G + ((((lane >> 2) & 3) * 4 + (lane >> 4)) * 4 + (lane & 3)) * 4) = __builtin_amdgcn_exp2f(cl[15]);
        LDS_WAIT(); asm volatile("" ::: "memory");
        f32x4_ sab = {0.f, 0.f, 0.f, 0.f}, sak = sab, srb = sab, srk = sab;
#pragma unroll
        for (int ks = 0; ks < 2; ++ks) { const int off = (fi * PWS + ks * 32 + fg * 8) * 2;
            const bf16x8 fk = *(const LAS bf16x8*)(pw + PW_KAP + off), fr_ = *(const LAS bf16x8*)(pw + PW_RH + off), fb = *(const LAS bf16x8*)(pw + PW_BH + off), fh = *(const LAS bf16x8*)(pw + PW_KH + off);
            sab = __builtin_amdgcn_mfma_f32_16x16x32_bf16(fk, fb, sab, 0, 0, 0); sak = __builtin_amdgcn_mfma_f32_16x16x32_bf16(fk, fh, sak, 0, 0, 0);
            srb = __builtin_amdgcn_mfma_f32_16x16x32_bf16(fr_, fb, srb, 0, 0, 0); srk = __builtin_amdgcn_mfma_f32_16x16x32_bf16(fr_, fh, srk, 0, 0, 0); }
        LAS float* Aab = (LAS float*)(pw + PW_AAB); LAS float* Aak = (LAS float*)(pw + PW_AAK); LAS float* Tm = (LAS float*)(pw + PW_TM);
        LAS unsigned short* arimg = (LAS unsigned short*)(pw + PW_BH);
        asm volatile("" ::: "memory");
#pragma unroll
        for (int j = 0; j < 4; ++j) { const int i = 4 * fg + j;
            Aab[i * 20 + fi] = (fi < i) ? sab[j] : 0.f; Aak[i * 20 + fi] = (fi < i) ? sak[j] : 0.f;
            const float nrb = (fi <= i) ? -srb[j] : 0.f, rk = (fi <= i) ? srk[j] : 0.f; const unsigned pk = cvtpk(nrb, rk);
            arimg[((fi >> 2) * 16 + i) * 8 + (fi & 3)] = (unsigned short)(pk & 0xffffu); arimg[((fi >> 2) * 16 + i) * 8 + 4 + (fi & 3)] = (unsigned short)(pk >> 16); }
        LDS_WAIT(); asm volatile("" ::: "memory");
        *(GAS v4u*)(rec + REC_AR + lane * 16) = *(const LAS v4u*)(pw + PW_BH + lane * 16);
        float tc[16];
#pragma unroll
        for (int i = 0; i < 16; ++i) { float acc = (i == fi) ? 1.f : 0.f;
#pragma unroll
            for (int j4 = 0; j4 < i; j4 += 4) { const f32x4_ ar_ = *(const LAS f32x4_*)(Aab + i * 20 + j4);
#pragma unroll
                for (int u = 0; u < 4; ++u) if (j4 + u < i) acc -= ar_[u] * tc[j4 + u]; }
            tc[i] = acc; }
        if (fg == 0) {
#pragma unroll
            for (int i = 0; i < 16; ++i) Tm[i * 20 + fi] = tc[i]; }
        LDS_WAIT(); asm volatile("" ::: "memory");
        { LAS unsigned short* okap = (LAS unsigned short*)(pw + PW_KAP);
#pragma unroll
        for (int i = 0; i < 16; ++i) { float acc = 0.f;
#pragma unroll
            for (int j4 = 0; j4 <= i; j4 += 4) { const f32x4_ tr_ = *(const LAS f32x4_*)(Tm + i * 20 + j4);
#pragma unroll
                for (int u = 0; u < 4; ++u) if (j4 + u <= i) acc += tr_[u] * kap[j4 + u]; }
            okap[i * PWS + lane] = (unsigned short)(cvtpk(acc, 0.f) & 0xffffu); } }
        { const int i = lane >> 2, q = lane & 3; f32x4_ acc = {0.f, 0.f, 0.f, 0.f};
#pragma unroll
          for (int j4 = 0; j4 < 16; j4 += 4) { const f32x4_ tr_ = *(const LAS f32x4_*)(Tm + i * 20 + j4);
#pragma unroll
              for (int u = 0; u < 4; ++u) acc += tr_[u] * *(const LAS f32x4_*)(Aak + (j4 + u) * 20 + 4 * q); }
          *(GAS unsigned long long*)(rec + REC_MAK + (q * 16 + i) * 8) = (unsigned long long)cvtpk(acc[0], acc[1]) | ((unsigned long long)cvtpk(acc[2], acc[3]) << 32); }
        LDS_WAIT(); asm volatile("" ::: "memory");
#pragma unroll
        for (int ks = 0; ks < 2; ++ks) { const int off = (fi * PWS + ks * 32 + 4 * fg) * 2;
            const unsigned long long w0_ = *(const LAS unsigned long long*)(pw + PW_KAP + off), w1_ = *(const LAS unsigned long long*)(pw + PW_KAP + off + 32);
            const unsigned long long r0_ = *(const LAS unsigned long long*)(pw + PW_RH + off), r1_ = *(const LAS unsigned long long*)(pw + PW_RH + off + 32);
            v4u o; o.x = (unsigned)w0_; o.y = (unsigned)(w0_ >> 32); o.z = (unsigned)w1_; o.w = (unsigned)(w1_ >> 32);
            *(GAS v4u*)(rec + REC_WA + ks * 1024 + lane * 16) = o;
            o.x = (unsigned)r0_; o.y = (unsigned)(r0_ >> 32); o.z = (unsigned)r1_; o.w = (unsigned)(r1_ >> 32);
            *(GAS v4u*)(rec + REC_RA + ks * 1024 + lane * 16) = o; }
        LDS_WAIT(); asm volatile("" ::: "memory");
    }
}
constexpr int SCAN_NS = 8;
__device__ __forceinline__ void p4_scan(Frame& F) {
    typedef float f32x4_ __attribute__((ext_vector_type(4)));
    const int si = (int)blockIdx.x;
    if (si >= BATCH * RW_H) return;
    const int b = si / RW_H, h = si % RW_H, lane = F.lane, w = F.wave;
    const unsigned lds0 = (unsigned)(uintptr_t)(F.lds + RING_OFF);
    if (w >= 4) {
        const int lw = w - 4;
#define SCAN_ISSUE(n) do { const int n_ = (n) < NCHUNK ? (n) : NCHUNK - 1; const unsigned char* rp = rec_ptr(F.ws, b, h, n_); const unsigned sb = lds0 + (unsigned)(((n) % SCAN_NS) * REC_BYTES); \
            glds16f(rp + lw * 1024 + lane * 16, (unsigned)__builtin_amdgcn_readfirstlane(sb + lw * 1024)); glds16f(rp + (lw + 4) * 1024 + lane * 16, (unsigned)__builtin_amdgcn_readfirstlane(sb + (lw + 4) * 1024)); \
            if (lw < 3) { glds16f(rp + (lw + 8) * 1024 + lane * 16, (unsigned)__builtin_amdgcn_readfirstlane(sb + (lw + 8) * 1024)); glds4f(rp + 11264 + lw * 256 + lane * 4, (unsigned)__builtin_amdgcn_readfirstlane(sb + 11264 + lw * 256)); } } while (0)
        for (int n = 0; n < SCAN_NS - 1; ++n) SCAN_ISSUE(n);
        for (int n = 0; n < NCHUNK; ++n) {
            if (lw < 3) asm volatile("s_waitcnt vmcnt(24)" ::: "memory"); else asm volatile("s_waitcnt vmcnt(12)" ::: "memory");
            __builtin_amdgcn_s_barrier(); asm volatile("" ::: "memory");
            SCAN_ISSUE(n + SCAN_NS - 1);
        }
        asm volatile("s_waitcnt vmcnt(0)" ::: "memory");
        __builtin_amdgcn_s_barrier();
#undef SCAN_ISSUE
        return;
    }
    bf16* Orw = (bf16*)(F.ws + WS_ORW);
    const int fc = lane & 15, fg = lane >> 4;
    f32x4_ H[4];
#pragma unroll
    for (int mt = 0; mt < 4; ++mt) H[mt] = (f32x4_){0.f, 0.f, 0.f, 0.f};
    bf16x8 hb0 = {0, 0, 0, 0, 0, 0, 0, 0}, hb1 = hb0;
    bf16* orow = Orw + ((size_t)b * T + 4 * fg) * 512 + h * 64 + 16 * w + fc;
    for (int n = 0; n < NCHUNK; ++n) {
        LDS_WAIT(); __builtin_amdgcn_s_barrier(); asm volatile("" ::: "memory");
        const LAS unsigned char* sb = F.lds + RING_OFF + (n % SCAN_NS) * REC_BYTES;
        typedef unsigned u32x2_ __attribute__((ext_vector_type(2)));
        const bf16x8 wa0 = *(const LAS bf16x8*)(sb + REC_WA + lane * 16), wa1 = *(const LAS bf16x8*)(sb + REC_WA + 1024 + lane * 16);
        const u32x2_ mk = *(const LAS u32x2_*)(sb + REC_MAK + lane * 8);
        const bf16x8 ra0 = *(const LAS bf16x8*)(sb + REC_RA + lane * 16), ra1 = *(const LAS bf16x8*)(sb + REC_RA + 1024 + lane * 16), ar = *(const LAS bf16x8*)(sb + REC_AR + lane * 16);
        bf16x8 bk[4]; f32x4_ gm[4];
#pragma unroll
        for (int mt = 0; mt < 4; ++mt) { bk[mt] = *(const LAS bf16x8*)(sb + REC_BK + mt * 1024 + lane * 16); gm[mt] = *(const LAS f32x4_*)(sb + REC_G + fg * 64 + mt * 16); }
        const u32x2_ vt = *(const LAS u32x2_*)(sb + REC_VT + w * 512 + lane * 8);
        const bf16x8 vz = __builtin_bit_cast(bf16x8, (v4u){0u, 0u, vt.x, vt.y}), mak = __builtin_bit_cast(bf16x8, (v4u){0u, 0u, mk.x, mk.y});
        f32x4_ U = {0.f, 0.f, 0.f, 0.f}, O = {0.f, 0.f, 0.f, 0.f};
        U = __builtin_amdgcn_mfma_f32_16x16x32_bf16(wa0, hb0, U, 0, 0, 0);
        U = __builtin_amdgcn_mfma_f32_16x16x32_bf16(wa1, hb1, U, 0, 0, 0);
        U = __builtin_amdgcn_mfma_f32_16x16x32_bf16(mak, vz, U, 0, 0, 0);
        O = __builtin_amdgcn_mfma_f32_16x16x32_bf16(ra0, hb0, O, 0, 0, 0);
        O = __builtin_amdgcn_mfma_f32_16x16x32_bf16(ra1, hb1, O, 0, 0, 0);
#pragma unroll
        for (int mt = 0; mt < 4; ++mt) H[mt] = H[mt] * gm[mt];
        const bf16x8 uv = __builtin_bit_cast(bf16x8, (v4u){cvtpk(U[0], U[1]), cvtpk(U[2], U[3]), vt.x, vt.y});
#pragma unroll
        for (int mt = 0; mt < 4; ++mt) H[mt] = __builtin_amdgcn_mfma_f32_16x16x32_bf16(bk[mt], uv, H[mt], 0, 0, 0);
        O = __builtin_amdgcn_mfma_f32_16x16x32_bf16(ar, uv, O, 0, 0, 0);
        hb0 = __builtin_bit_cast(bf16x8, (v4u){cvtpk(H[0][0], H[0][1]), cvtpk(H[0][2], H[0][3]), cvtpk(H[1][0], H[1][1]), cvtpk(H[1][2], H[1][3])});
        hb1 = __builtin_bit_cast(bf16x8, (v4u){cvtpk(H[2][0], H[2][1]), cvtpk(H[2][2], H[2][3]), cvtpk(H[3][0], H[3][1]), cvtpk(H[3][2], H[3][3])});
        bf16* op = orow + (size_t)n * 16 * 512;
#pragma unroll
        for (int j = 0; j < 4; ++j) op[(size_t)j * 512] = (bf16)(cvtpk(O[j], 0.f) & 0xffffu);
    }
    LDS_WAIT(); __builtin_amdgcn_s_barrier();
}
__device__ __forceinline__ void p6_assemble(Frame& F) {
    const int gw = F.vcu * NWAVES + F.wave, NGW = F.G * NWAVES;
    const bf16* Orw = (const bf16*)(F.ws + WS_ORW); const bf16* Uvg = (const bf16*)(F.ws + WS_UVG); const bf16* Uqg = (const bf16*)(F.ws + WS_UQG); const bf16* O0 = (const bf16*)(F.ws + WS_URK); const bf16* O1 = O0 + 512;
    const float* BON = (const float*)(F.ws + WS_BONUS); bf16* Y = (bf16*)(F.ws + WS_Y);
    const float lam = __expf(wave_sum(F.in[I_LQ1][F.lane] * F.in[I_LK1][F.lane])) - __expf(wave_sum(F.in[I_LQ2][F.lane] * F.in[I_LK2][F.lane])) + LAMBDA_INIT;
    const int c0 = 8 * F.lane;
    float lw[8], lb[8], muv[8], sw[8];
#pragma unroll
    for (int i = 0; i < 8; ++i) { lw[i] = F.in[I_LNW][c0 + i]; lb[i] = F.in[I_LNB][c0 + i]; muv[i] = F.in[I_MU][1024 + c0 + i]; sw[i] = F.in[I_SUBLN][(c0 + i) & 127] * (1.f - LAMBDA_INIT); }
    for (int m = gw; m < M; m += NGW) {
        const bool first = (m % T == 0);
        const v4u ow = *(const GAS v4u*)(Orw + (size_t)m * 512 + c0), vw = *(const GAS v4u*)(Uvg + (size_t)m * UP + c0), gw_ = *(const GAS v4u*)(Uvg + (size_t)m * UP + 512 + c0);
        v4u pw = {0u, 0u, 0u, 0u}; if (!first) pw = *(const GAS v4u*)(Uvg + (size_t)(m - 1) * UP + c0);
        float o[8], v[8], g[8];
#pragma unroll
        for (int i = 0; i < 4; ++i) { o[2 * i] = bflo(ow[i]); o[2 * i + 1] = bfhi(ow[i]); g[2 * i] = bflo(gw_[i]); g[2 * i + 1] = bfhi(gw_[i]);
            v[2 * i] = tshift(bflo(vw[i]), bflo(pw[i]), muv[2 * i]); v[2 * i + 1] = tshift(bfhi(vw[i]), bfhi(pw[i]), muv[2 * i + 1]); }
        float s = 0.f;
#pragma unroll
        for (int i = 0; i < 8; ++i) s += o[i];
        s += __shfl_xor(s, 1); s += __shfl_xor(s, 2); s += __shfl_xor(s, 4);
        const float mean = s * (1.f / 64.f); float q = 0.f;
#pragma unroll
        for (int i = 0; i < 8; ++i) { o[i] -= mean; q += o[i] * o[i]; }
        q += __shfl_xor(q, 1); q += __shfl_xor(q, 2); q += __shfl_xor(q, 4);
        const float rstd = 1.f / sqrtf(q * (1.f / 64.f) + GN_EPS), bon = BON[m * 8 + (F.lane >> 3)];
        float y[8];
#pragma unroll
        for (int i = 0; i < 8; ++i) y[i] = (o[i] * rstd * lw[i] + lb[i] + bon * v[i]) * siluf_(g[i]);
        v4u yo; yo.x = pk2(y[0], y[1]); yo.y = pk2(y[2], y[3]); yo.z = pk2(y[4], y[5]); yo.w = pk2(y[6], y[7]);
        *(GAS v4u*)(Y + (size_t)m * D + c0) = yo;
        const v4u a0 = *(const GAS v4u*)(O0 + (size_t)m * 1024 + c0), a1 = *(const GAS v4u*)(O1 + (size_t)m * 1024 + c0), dgw = *(const GAS v4u*)(Uqg + (size_t)m * 1024 + 512 + c0);
        float d[8]; float ms = 0.f;
#pragma unroll
        for (int i = 0; i < 4; ++i) { d[2 * i] = bflo(a0[i]) - lam * bflo(a1[i]); d[2 * i + 1] = bfhi(a0[i]) - lam * bfhi(a1[i]); g[2 * i] = bflo(dgw[i]); g[2 * i + 1] = bfhi(dgw[i]); }
#pragma unroll
        for (int i = 0; i < 8; ++i) ms += d[i] * d[i];
        ms += __shfl_xor(ms, 1); ms += __shfl_xor(ms, 2); ms += __shfl_xor(ms, 4); ms += __shfl_xor(ms, 8);
        const float rs = 1.f / sqrtf(ms * (1.f / 128.f) + SUBLN_EPS);
#pragma unroll
        for (int i = 0; i < 8; ++i) y[i] = d[i] * rs * sw[i] * siluf_(g[i]);
        yo.x = pk2(y[0], y[1]); yo.y = pk2(y[2], y[3]); yo.z = pk2(y[4], y[5]); yo.w = pk2(y[6], y[7]);
        *(GAS v4u*)(Y + (size_t)m * D + 512 + c0) = yo;
    }
}
__device__ __forceinline__ void p67_fused(Frame& F) {
    typedef float f32x4_ __attribute__((ext_vector_type(4)));
    const bf16* Orw = (const bf16*)(F.ws + WS_ORW); const bf16* Uvg = (const bf16*)(F.ws + WS_UVG); const bf16* Uqg = (const bf16*)(F.ws + WS_UQG); const bf16* O0 = (const bf16*)(F.ws + WS_URK); const bf16* O1 = O0 + 512;
    const float* BON = (const float*)(F.ws + WS_BONUS); const unsigned char* Wimg = (const unsigned char*)(F.ws + WS_WOUT);
    const float* x = F.in[I_X]; const float* gpost = F.in[I_GPOST]; const float* mod = (const float*)(F.ws + WS_MOD);
    const int lane = F.lane, w = F.wave, fr = lane & 15, fq = lane >> 4;
    const float lam = __expf(wave_sum(F.in[I_LQ1][lane] * F.in[I_LK1][lane])) - __expf(wave_sum(F.in[I_LQ2][lane] * F.in[I_LK2][lane])) + LAMBDA_INIT;
    LAS unsigned char* A = F.lds + RING_OFF;
    {
        const int unit = F.vcu; const int r0 = unit * 64, bb = r0 / T;
        {
            const int c0 = 8 * lane;
            float lw[8], lb[8], muv[8], sw[8];
#pragma unroll
            for (int i = 0; i < 8; ++i) { lw[i] = F.in[I_LNW][c0 + i]; lb[i] = F.in[I_LNB][c0 + i]; muv[i] = F.in[I_MU][1024 + c0 + i]; sw[i] = F.in[I_SUBLN][(c0 + i) & 127] * (1.f - LAMBDA_INIT); }
            LAS unsigned char* arow = A + ((lane >> 2) * 4 + (w >> 1)) * 1024 + ((lane & 3) * 16 + 8 * (w & 1)) * 16;
#pragma unroll 2
            for (int j = 0; j < 8; ++j) { const int m = r0 + 8 * w + j; const bool first = (m % T == 0);
                const v4u ow = *(const GAS v4u*)(Orw + (size_t)m * 512 + c0), vw = *(const GAS v4u*)(Uvg + (size_t)m * UP + c0), gw_ = *(const GAS v4u*)(Uvg + (size_t)m * UP + 512 + c0);
                v4u pw = {0u, 0u, 0u, 0u}; if (!first) pw = *(const GAS v4u*)(Uvg + (size_t)(m - 1) * UP + c0);
                const v4u a0 = *(const GAS v4u*)(O0 + (size_t)m * 1024 + c0), a1 = *(const GAS v4u*)(O1 + (size_t)m * 1024 + c0), dgw = *(const GAS v4u*)(Uqg + (size_t)m * 1024 + 512 + c0);
                const float bon = BON[m * 8 + (lane >> 3)];
                float o[8], v[8], g[8];
#pragma unroll
                for (int i = 0; i < 4; ++i) { o[2 * i] = bflo(ow[i]); o[2 * i + 1] = bfhi(ow[i]); g[2 * i] = bflo(gw_[i]); g[2 * i + 1] = bfhi(gw_[i]);
                    v[2 * i] = tshift(bflo(vw[i]), bflo(pw[i]), muv[2 * i]); v[2 * i + 1] = tshift(bfhi(vw[i]), bfhi(pw[i]), muv[2 * i + 1]); }
                float s = 0.f;
#pragma unroll
                for (int i = 0; i < 8; ++i) s += o[i];
                s = sum8_dpp(s);
                const float mean = s * (1.f / 64.f); float q = 0.f;
#pragma unroll
                for (int i = 0; i < 8; ++i) { o[i] -= mean; q += o[i] * o[i]; }
                q = sum8_dpp(q);
                const float rstd = __builtin_amdgcn_rsqf(q * (1.f / 64.f) + GN_EPS);
                float y[8];
#pragma unroll
                for (int i = 0; i < 8; ++i) y[i] = (o[i] * rstd * lw[i] + lb[i] + bon * v[i]) * silu_fast(g[i]);
                *(LAS v4u*)(arow + j * 16) = (v4u){cvtpk(y[0], y[1]), cvtpk(y[2], y[3]), cvtpk(y[4], y[5]), cvtpk(y[6], y[7])};
                float d[8]; float ms = 0.f;
#pragma unroll
                for (int i = 0; i < 4; ++i) { d[2 * i] = bflo(a0[i]) - lam * bflo(a1[i]); d[2 * i + 1] = bfhi(a0[i]) - lam * bfhi(a1[i]); g[2 * i] = bflo(dgw[i]); g[2 * i + 1] = bfhi(dgw[i]); }
#pragma unroll
                for (int i = 0; i < 8; ++i) ms += d[i] * d[i];
                ms = sum16_dpp(ms);
                const float rs = __builtin_amdgcn_rsqf(ms * (1.f / 128.f) + SUBLN_EPS);
#pragma unroll
                for (int i = 0; i < 8; ++i) y[i] = d[i] * rs * sw[i] * silu_fast(g[i]);
                *(LAS v4u*)(arow + 65536 + j * 16) = (v4u){cvtpk(y[0], y[1]), cvtpk(y[2], y[3]), cvtpk(y[4], y[5]), cvtpk(y[6], y[7])}; }
        }
        __syncthreads();
        f32x4_ acc[4][8];
#pragma unroll
        for (int rt = 0; rt < 4; ++rt)
#pragma unroll
            for (int nt = 0; nt < 8; ++nt) acc[rt][nt] = (f32x4_){0.f, 0.f, 0.f, 0.f};
        const unsigned char* bp = Wimg + ((size_t)(8 * w) * 32 * 64 + lane) * 16;
        bf16x8 b0_[8], b1_[8];
#pragma unroll
        for (int nt = 0; nt < 8; ++nt) b0_[nt] = *(const bf16x8*)(bp + nt * 32768);
#define P67_STEP(BC, BN, ks_) do { \
            if ((ks_) + 1 < 32) { _Pragma("unroll") for (int nt = 0; nt < 8; ++nt) BN[nt] = *(const bf16x8*)(bp + nt * 32768 + ((ks_) + 1) * 1024); } \
            bf16x8 af[4]; _Pragma("unroll") for (int rt = 0; rt < 4; ++rt) af[rt] = *(const LAS bf16x8*)(A + ((ks_) * 4 + rt) * 1024 + lane * 16); \
            _Pragma("unroll") for (int nt = 0; nt < 8; ++nt) _Pragma("unroll") for (int rt = 0; rt < 4; ++rt) acc[rt][nt] = __builtin_amdgcn_mfma_f32_16x16x32_bf16(BC[nt], af[rt], acc[rt][nt], 0, 0, 0); } while (0)
        for (int ks = 0; ks < 32; ks += 2) { P67_STEP(b0_, b1_, ks); P67_STEP(b1_, b0_, ks + 1); }
#undef P67_STEP
        float ss[4];
#pragma unroll
        for (int rt = 0; rt < 4; ++rt) { float s_ = 0.f;
#pragma unroll
            for (int nt = 0; nt < 8; ++nt) { const f32x4_ a_ = acc[rt][nt]; s_ += (a_[0] * a_[0] + a_[1] * a_[1]) + (a_[2] * a_[2] + a_[3] * a_[3]); }
            s_ += __shfl_xor(s_, 16); s_ += __shfl_xor(s_, 32); ss[rt] = s_; }
        __syncthreads();
        LAS float* P = (LAS float*)A;
        if (fq == 0) {
#pragma unroll
            for (int rt = 0; rt < 4; ++rt) P[(rt * 16 + fr) * 8 + w] = ss[rt]; }
        __syncthreads();
        const float* grow = mod + (size_t)bb * 3072 + 2048;
        float rstd[4];
#pragma unroll
        for (int rt = 0; rt < 4; ++rt) { const int row = rt * 16 + fr; const f32x4_ p0_ = *(const LAS f32x4_*)(P + row * 8), p1_ = *(const LAS f32x4_*)(P + row * 8 + 4);
            rstd[rt] = 1.f / sqrtf(((p0_[0] + p0_[1]) + (p0_[2] + p0_[3]) + (p1_[0] + p1_[1]) + (p1_[2] + p1_[3])) * (1.f / D) + RMS_EPS); }
        LAS unsigned char* tb = A + 4096 + w * 8448;
        const int rr = lane >> 5, c4 = lane & 31, colr = 128 * w + 4 * c4;
        const f32x4_ cfr = *(const f32x4_*)(grow + colr) * *(const f32x4_*)(gpost + colr);
#pragma unroll
        for (int rt = 0; rt < 4; ++rt) {
            f32x4_ xr[8];
#pragma unroll
            for (int k = 0; k < 8; ++k) xr[k] = __builtin_nontemporal_load((const f32x4_*)(x + (size_t)(r0 + rt * 16 + 2 * k + rr) * D + colr));
#pragma unroll
            for (int nt = 0; nt < 8; ++nt) *(LAS f32x4_*)(tb + fr * 528 + (16 * nt + 4 * fq) * 4) = acc[rt][nt] * rstd[rt];
            LDS_WAIT(); asm volatile("" ::: "memory");
#pragma unroll
            for (int k = 0; k < 8; ++k) { const f32x4_ t_ = *(const LAS f32x4_*)(tb + (2 * k + rr) * 528 + c4 * 16);
                *(f32x4_*)(F.out + (size_t)(r0 + rt * 16 + 2 * k + rr) * D + colr) = xr[k] + t_ * cfr; }
            LDS_WAIT(); asm volatile("" ::: "memory");
        }
        __syncthreads();
    }
}
__device__ __forceinline__ void nan_rows_f32(Frame& F, float* out) {
    const int gw = F.vcu * NWAVES + F.wave, NGW = F.G * NWAVES; const float q = __builtin_nanf("");
    for (int m = gw; m < M; m += NGW) { GAS f32x4* o = (GAS f32x4*)(out + (size_t)m * D) + F.lane;
#pragma unroll
        for (int j = 0; j < 4; ++j) o[64 * j] = (f32x4){q, q, q, q}; }
}
__device__ __forceinline__ void wrong_grid_word(Frame& F) {
    if (blockIdx.x == 0 && F.tid == 0) { unsigned expect = 0u; __hip_atomic_compare_exchange_strong((unsigned*)(F.ctl + CW_CODE), &expect, 0x7f0u, __ATOMIC_RELAXED, __ATOMIC_RELAXED, __HIP_MEMORY_SCOPE_AGENT);
        __hip_atomic_store(F.ctl + CW_TMO, 1u, RLX_AGENT); }
}

struct Args { const float* in[23]; float* out; unsigned char* ws; int ph_lo, ph_hi, li, pad; };
__global__ void __launch_bounds__(NWAVES * 64, 2) skel_fwd(Args args) {
    extern __shared__ __attribute__((aligned(16))) unsigned char lds[];
    Frame F;
    F.lds = (LAS unsigned char*)lds;
    F.MISC = (volatile LAS unsigned*)(F.lds + MISC_OFF);
    F.tid = threadIdx.x; F.lane = F.tid & 63; F.wave = __builtin_amdgcn_readfirstlane(F.tid >> 6);
    F.G = gridDim.x; { const int bx = blockIdx.x; F.vcu = (F.G % 8 == 0) ? (bx % 8) * (F.G / 8) + bx / 8 : bx; }
#define GRID_BAR(seam) do { if (N_LAUNCHES == PER_PHASE) { if (F.tid == 0) __hip_atomic_store(F.ctl + CW_TMO, 0xBADBA0u | (unsigned)(seam), RLX_AGENT); } \
    else { xcd_barrier(bar); } } while (0)
    unsigned char* ws = args.ws; F.ws = ws;
    F.ctl = (gu32*)(ws + WS_CTL);
#pragma unroll
    for (int i = 0; i < 23; ++i) F.in[i] = args.in[i];
    F.out = args.out;
    for (int u = F.tid; u < (LDS_BYTES - LDSCTL_OFF) / 4; u += NWAVES * 64) ((LAS unsigned*)(F.lds + LDSCTL_OFF))[u] = 0u;
    __syncthreads();
    XcdBarrier bar; bar.bar = (unsigned*)(F.ctl + CW_BAR); bar.x = 0; bar.st = nullptr;
    if (N_LAUNCHES != PER_PHASE) bar = xcd_barrier_post((unsigned*)(F.ctl + CW_BAR), F.MISC + 8);

    const int lo = args.ph_lo, hi = args.ph_hi;
#define IN(k) (lo <= (k) && (k) < hi)
#define BOTH(k) (IN(k) && IN((k) + 1))

#ifndef PROBE_PHASE
#define PROBE_PHASE -1
#endif
#ifndef PROBE_REPS
#define PROBE_REPS 2
#endif
#define REPS(k) ((k) == PROBE_PHASE ? PROBE_REPS : 1)
    if (IN(0)) { for (int rep = 0; rep < REPS(0); ++rep) p0_prologue(F); if (BOTH(0)) GRID_BAR(0); }
    if (IN(1)) { for (int rep = 0; rep < REPS(1); ++rep) p1_rows(F); if (BOTH(1)) GRID_BAR(1); }
    if (PROBE_PHASE == 9) { for (int rep = 0; rep < 16; ++rep) GRID_BAR(9); }
    if (IN(2)) {
        pg8::Gemm g{(const pg8::bf16_t*)(ws + WS_XN), (const pg8::bf16_t*)(ws + WS_WIN), M, NMAIN, D}; pg8::StaticOrder S; S.init(M, NMAIN, F.G, (int)blockIdx.x);
        pg8::EpiU E{(pg8::bf16_t*)(ws + WS_URK), (pg8::bf16_t*)(ws + WS_UVG), (pg8::bf16_t*)(ws + WS_UQG), (pg8::bf16_t*)(ws + WS_KIMG), (pg8::bf16_t*)(ws + WS_VIMG), attn_body::C2, T};
        const bool lora_first = ((blockIdx.x >> 3) & 1) != 0;
        if (lora_first) p2_lora(F);
        for (int rep = 0; rep < REPS(2); ++rep) pg8::gemm_phase<pg8::EpiU, pg8::StaticOrder, PG8_ALIGN, PG8_SP2>(F.lds + RING_OFF, g, S, E);
        if (!lora_first) p2_lora(F);
        if (BOTH(2)) GRID_BAR(2);
    }
    if (IN(3)) { for (int rep = 0; rep < REPS(3); ++rep) p3_prep(F); if (BOTH(3)) GRID_BAR(3); }
    if (IN(4)) {
        for (int rep = 0; rep < REPS(4); ++rep) p4_scan(F);
        const attn_body::AttnTensors AT{(const attn_body::bf16*)(ws + WS_UQG), (const attn_body::bf16*)(ws + WS_KIMG), (const attn_body::bf16*)(ws + WS_VIMG), (attn_body::bf16*)(ws + WS_URK), (attn_body::bf16*)(ws + WS_URK) + 512};
        if (F.G == 256) attn_body::attn_phase_queue((char*)lds + RING_OFF, AT, (unsigned*)(F.ctl + CW_QUEUE), (int)(xb_xcc_id() & 7u), F.MISC + 16);
        if (PROBE_PHASE == 5) { GRID_BAR(5); attn_body::attn_phase_queue((char*)lds + RING_OFF, AT, (unsigned*)(F.ctl + CW_QUEUE + 512 + 64 * ((int)blockIdx.x & 7)), (int)blockIdx.x & 7, F.MISC + 16); }
        if (BOTH(4)) GRID_BAR(4);
    }
    if (IN(6)) { }
    if (IN(7)) { if (F.G == 256) p67_fused(F); else { nan_rows_f32(F, F.out); wrong_grid_word(F); } }
#undef IN
#undef BOTH
}

extern "C" void kernel_launch(void* const* d_in, const int* in_sizes, int n_in, void* d_out, int out_size, void* d_ws, size_t ws_size, hipStream_t stream) {
    static int grid = 0;
    if (grid == 0) {
        if (n_in != 23 || in_sizes[0] != M * D || out_size != M * D || ws_size < WS_END) { fprintf(stderr, "kernel_launch: built for 23 inputs, x and out of %d floats, >= %zu bytes of workspace; got n_in %d, in0 %d, out %d, ws %zu; nothing launched\n", M * D, (size_t)WS_END, n_in, n_in > 0 ? in_sizes[0] : -1, out_size, ws_size); grid = -1; return; }
        int dev = 0, cus = 0, per_cu = 0;
        if (hipGetDevice(&dev) != hipSuccess || hipDeviceGetAttribute(&cus, hipDeviceAttributeMultiprocessorCount, dev) != hipSuccess) { fprintf(stderr, "kernel_launch: hipGetDevice / hipDeviceGetAttribute failed; nothing launched\n"); grid = -1; return; }
        if (hipFuncSetAttribute((const void*)skel_fwd, hipFuncAttributeMaxDynamicSharedMemorySize, LDS_BYTES) != hipSuccess) { fprintf(stderr, "kernel_launch: hipFuncSetAttribute failed\n"); grid = -1; return; }
        if (hipOccupancyMaxActiveBlocksPerMultiprocessor(&per_cu, (const void*)skel_fwd, NWAVES * 64, LDS_BYTES) != hipSuccess || per_cu < 1)
            fprintf(stderr, "kernel_launch: note: the occupancy query reports %d workgroups per CU\n", per_cu);
        (void)hipGetLastError();
        grid = cus;
        if (grid != 256) fprintf(stderr, "kernel_launch: launching %d workgroups; the fused phases need exactly 256\n", grid);
    }
    if (grid < 0) return;
    if (hipMemsetAsync((char*)d_ws + WS_CTL, 0, CTL_ZERO_BYTES, stream) != hipSuccess) { fprintf(stderr, "kernel_launch: hipMemsetAsync of the control words failed; nothing launched\n"); return; }
    Args a{};
    for (int i = 0; i < 23; ++i) a.in[i] = (const float*)d_in[i];
    a.out = (float*)d_out; a.ws = (unsigned char*)d_ws;
    for (int li = 0; li < N_LAUNCHES; ++li) {
        a.ph_lo = (N_LAUNCHES == PER_PHASE) ? li : 0; a.ph_hi = (N_LAUNCHES == PER_PHASE) ? li + 1 : PER_PHASE; a.li = li;
        hipLaunchKernelGGL(skel_fwd, dim3(grid), dim3(NWAVES * 64), LDS_BYTES, stream, a);
        const hipError_t le = hipPeekAtLastError();
        if (le != hipSuccess) { fprintf(stderr, "kernel_launch: launch %d failed: %s\n", li, hipGetErrorName(le)); break; }
    }
}
```
